# Optimizing an MI355X kernel written in HIP

```python
import math
import jax
import jax.numpy as jnp
from jax import lax
import numpy as np

D_MODEL = 1024
BATCH = 16
SEQ = 2048
DEPTH = 2

GRID_W = 64
CTX_LEN = 256
N_EVEN = (DEPTH + 1) // 2
N_ODD = DEPTH // 2
HEAD_DIM = 64
A_WIDTH = D_MODEL // 2
B_Q_HEADS = (D_MODEL - A_WIDTH) // HEAD_DIM
B_KV_HEADS = max(1, B_Q_HEADS // 4)
HY_ORDER = 2
HY_BANDS = 16
HY_EMB = 1 + 2 * HY_BANDS
HY_HIDDEN = 64
HY_TARGET = 1e-2
HY_MAX_DECAY = math.log(1.0 / HY_TARGET) / 0.3
HY_MIN_DECAY = math.log(1.0 / HY_TARGET) / 1.5
SHORT_CONV = 3
MLA_HEADS = 8
MLA_NOPE = 64
MLA_ROPE = 32
MLA_V = 64
MLA_Q_RANK = D_MODEL // 4
MLA_KV_RANK = D_MODEL // 8
S5_WIDTH = D_MODEL - MLA_HEADS * MLA_V
S5_GROUP = 16
S5_GROUPS = S5_WIDTH // S5_GROUP
S5_STATE = 64
S5_DT_MIN = 1e-3
S5_DT_MAX = 1e-1
N_GROUPS = 4
EXPERTS_PER_GROUP = 8
N_EXPERTS = N_GROUPS * EXPERTS_PER_GROUP
TOP_K_INNER = 2
D_EXPERT = D_MODEL // 4
ROPE_THETA = 10000.0
Q_BLOCK = 128
EPS = 1e-6
EVEN_IN = 3 * A_WIDTH + (B_Q_HEADS + 2 * B_KV_HEADS) * HEAD_DIM
ODD_IN = MLA_Q_RANK + MLA_KV_RANK + MLA_ROPE + S5_WIDTH
F32 = jnp.float32

kernel_name = 'hybrid_diffusion_hyena_gqa_mla_s5_hmoe'


def _split(t, sizes):
    return jnp.split(t, [int(s) for s in np.cumsum(sizes)[:-1]], axis=-1)


def _heads(t, n):
    return t.reshape(t.shape[0], t.shape[1], n, -1)


def rmsnorm(t, g):
    tf = t.astype(F32)
    y = tf * lax.rsqrt(jnp.mean(tf * tf, axis=-1, keepdims=True) + EPS)
    return (y * g.astype(F32)).astype(t.dtype)


def modnorm(t, g, shift, scale):
    return rmsnorm(t, g) * (1.0 + scale) + shift


def grid_positions(n_tokens):
    rows_count = n_tokens // GRID_W
    rows = jnp.repeat(jnp.arange(rows_count, dtype=jnp.int32), GRID_W)
    cols = jnp.arange(rows_count * GRID_W, dtype=jnp.int32) % GRID_W
    return rows, cols


def rope_1d(t, pos):
    half = t.shape[-1] // 2
    freqs = ROPE_THETA ** (-jnp.arange(half, dtype=F32) / half)
    ang = pos.astype(F32)[:, None] * freqs
    cos = jnp.cos(ang)[:, None, :]
    sin = jnp.sin(ang)[:, None, :]
    t1 = t[..., :half].astype(F32)
    t2 = t[..., half:].astype(F32)
    return jnp.concatenate([t1 * cos - t2 * sin, t1 * sin + t2 * cos], axis=-1).astype(t.dtype)


def rope_2d(t, rows, cols):
    a = t.shape[-1] // 2
    return jnp.concatenate([rope_1d(t[..., :a], rows), rope_1d(t[..., a:], cols)], axis=-1)


def block_attention(q, k, v):
    bsz, lq, hq, dk = q.shape
    hkv = k.shape[2]
    rep = hq // hkv
    scale = dk ** -0.5
    qb = jnp.moveaxis(q.reshape(bsz, lq // Q_BLOCK, Q_BLOCK, hkv, rep, dk), 1, 0)

    def one_block(qblk):
        s = jnp.einsum('bqgrd,bkgd->bgrqk', qblk, k).astype(F32) * scale
        p = jax.nn.softmax(s, axis=-1).astype(v.dtype)
        return jnp.einsum('bgrqk,bkgd->bqgrd', p, v)

    o = lax.map(one_block, qb)
    return jnp.moveaxis(o, 0, 1).reshape(bsz, lq, hq * v.shape[-1])


def short_conv(u, w, b):
    up = jnp.pad(u, ((0, 0), (1, 1), (0, 0)))
    return up[:, :-2] * w[0] + up[:, 1:-1] * w[1] + up[:, 2:] * w[2] + b


def hyena_filter_rfft(n, w1, b1, w2, b2, w3, freq):
    t = jnp.arange(n, dtype=F32)
    t_norm = t / max(n - 1, 1)
    bands = jnp.linspace(1e-4, HY_BANDS - 1, HY_BANDS, dtype=F32)
    ang = (2.0 * math.pi / n) * t[:, None] * bands
    z = jnp.concatenate([t_norm[:, None], jnp.cos(ang), jnp.sin(ang)], axis=-1)
    fr = freq.astype(F32)
    hdn = jnp.sin(fr * (z @ w1.astype(F32) + b1.astype(F32)))
    hdn = jnp.sin(fr * (hdn @ w2.astype(F32) + b2.astype(F32)))
    taps = (hdn @ w3.astype(F32)).reshape(n, 2, HY_ORDER, A_WIDTH)
    deltas = jnp.linspace(HY_MIN_DECAY, HY_MAX_DECAY, A_WIDTH, dtype=F32)
    taps = taps * jnp.exp(-t_norm[:, None] * deltas)[:, None, None, :]
    fwd, bwd = taps[:, 0], taps[:, 1]
    circ = jnp.concatenate([fwd, jnp.zeros((1, HY_ORDER, A_WIDTH), F32), bwd[:0:-1]], axis=0)
    circ = circ * lax.rsqrt(jnp.sum(circ * circ, axis=0, keepdims=True) + EPS)
    return jnp.fft.rfft(circ, axis=0)


def long_conv(u, filt_f, bias):
    n = u.shape[1]
    uf = jnp.fft.rfft(u, n=2 * n, axis=1)
    y = jnp.fft.irfft(uf * filt_f[None], n=2 * n, axis=1)[:, :n]
    return y + u * bias


def hyena_mixer(u3, conv_w, conv_b, w1, b1, w2, b2, w3, freq, fbias):
    n = u3.shape[1]
    u3 = short_conv(u3, conv_w, conv_b).astype(F32)
    x1, x2, v = _split(u3, [A_WIDTH, A_WIDTH, A_WIDTH])
    filt = hyena_filter_rfft(n, w1, b1, w2, b2, w3, freq)
    fb = fbias.astype(F32)
    z = x1 * long_conv(v, filt[:, 0], fb[0])
    return x2 * long_conv(z, filt[:, 1], fb[1])


def s5_discretize(a_re, a_im, log_dt, b_re, b_im):
    a_re, a_im = a_re.astype(F32), a_im.astype(F32)
    dt = jnp.exp(log_dt.astype(F32))[:, None]
    mag = jnp.exp(a_re * dt)
    ab_re, ab_im = mag * jnp.cos(a_im * dt), mag * jnp.sin(a_im * dt)
    er, ei = ab_re - 1.0, ab_im
    den = a_re * a_re + a_im * a_im
    co_re = (er * a_re + ei * a_im) / den
    co_im = (ei * a_re - er * a_im) / den
    b_re, b_im = b_re.astype(F32), b_im.astype(F32)
    bb_re = co_re[..., None] * b_re - co_im[..., None] * b_im
    bb_im = co_re[..., None] * b_im + co_im[..., None] * b_re
    return ab_re, ab_im, bb_re, bb_im


def _lin_rec_op(e1, e2):
    a1r, a1i, b1r, b1i = e1
    a2r, a2i, b2r, b2i = e2
    return (a2r * a1r - a2i * a1i, a2r * a1i + a2i * a1r,
            a2r * b1r - a2i * b1i + b2r, a2r * b1i + a2i * b1r + b2i)


def s5_scan(u, ab_re, ab_im, bb_re, bb_im, h0, reverse):
    n = u.shape[1]
    bu_re = jnp.einsum('blgh,gph->lbgp', u, bb_re)
    bu_im = jnp.einsum('blgh,gph->lbgp', u, bb_im)
    a_re = jnp.broadcast_to(ab_re[None, None], (n, 1) + ab_re.shape)
    a_im = jnp.broadcast_to(ab_im[None, None], (n, 1) + ab_im.shape)
    pa_re, pa_im, s_re, s_im = lax.associative_scan(_lin_rec_op, (a_re, a_im, bu_re, bu_im), reverse=reverse, axis=0)
    if h0 is not None:
        h_re, h_im = h0
        s_re = s_re + pa_re * h_re - pa_im * h_im
        s_im = s_im + pa_re * h_im + pa_im * h_re
    return s_re, s_im


def s5_readout(s_re, s_im, c_re, c_im):
    return jnp.einsum('lbgp,ghp->blgh', s_re, c_re.astype(F32)) - jnp.einsum('lbgp,ghp->blgh', s_im, c_im.astype(F32))


def s5_mixer(u_lat, u_ctx, a_re, a_im, log_dt, b_re, b_im, c_re, c_im, d_skip, glu_w, glu_b, ctx_needed):
    def grouped(u):
        return u.astype(F32).reshape(u.shape[0], u.shape[1], S5_GROUPS, S5_GROUP)

    ul, uc = grouped(u_lat), grouped(u_ctx)
    dsk = d_skip.astype(F32).reshape(S5_GROUPS, S5_GROUP)
    y_lat = dsk * ul
    y_ctx = dsk * uc if ctx_needed else None
    for direction in range(2):
        reverse = direction == 1
        disc = s5_discretize(a_re[direction], a_im[direction], log_dt[direction], b_re[direction], b_im[direction])
        cr, ci = s5_scan(uc, *disc, None, reverse)
        end = 0 if reverse else -1
        lr, li = s5_scan(ul, *disc, (cr[end], ci[end]), reverse)
        y_lat = y_lat + s5_readout(lr, li, c_re[direction], c_im[direction])
        if ctx_needed:
            y_ctx = y_ctx + s5_readout(cr, ci, c_re[direction], c_im[direction])

    def glu(y):
        g = jax.nn.gelu(y.reshape(y.shape[0], y.shape[1], S5_WIDTH))
        return g * jax.nn.sigmoid(g @ glu_w.astype(F32) + glu_b.astype(F32))

    return glu(y_lat), (glu(y_ctx) if ctx_needed else None)


def even_mixer(p_lat, p_ctx, rows, cols, ctx_needed, conv_w, conv_b, w1, b1, w2, b2, w3, freq, fbias, qk_g):
    sizes = [3 * A_WIDTH, B_Q_HEADS * HEAD_DIM, B_KV_HEADS * HEAD_DIM, B_KV_HEADS * HEAD_DIM]
    hy_l, q_l, k_l, v_l = _split(p_lat, sizes)
    hy_c, q_c, k_c, v_c = _split(p_ctx, sizes)
    filt = (conv_w, conv_b, w1, b1, w2, b2, w3, freq, fbias)
    kc = rmsnorm(_heads(k_c, B_KV_HEADS), qk_g[1])
    vc = _heads(v_c, B_KV_HEADS)
    ql = rope_2d(rmsnorm(_heads(q_l, B_Q_HEADS), qk_g[0]), rows, cols)
    kl = rope_2d(rmsnorm(_heads(k_l, B_KV_HEADS), qk_g[1]), rows, cols)
    vl = _heads(v_l, B_KV_HEADS)
    att_l = block_attention(ql, jnp.concatenate([kc, kl], axis=1), jnp.concatenate([vc, vl], axis=1))
    out_l = jnp.concatenate([hyena_mixer(hy_l, *filt).astype(p_lat.dtype), att_l], axis=-1)
    if not ctx_needed:
        return out_l, None
    qc = rmsnorm(_heads(q_c, B_Q_HEADS), qk_g[0])
    att_c = block_attention(qc, kc, vc)
    out_c = jnp.concatenate([hyena_mixer(hy_c, *filt).astype(p_ctx.dtype), att_c], axis=-1)
    return out_l, out_c


def odd_mixer(p_lat, p_ctx, rows, cols, ctx_needed, q_norm_g, w_uq, kv_norm_g, w_ukv,
              a_re, a_im, log_dt, b_re, b_im, c_re, c_im, d_skip, glu_w, glu_b):
    sizes = [MLA_Q_RANK, MLA_KV_RANK, MLA_ROPE, S5_WIDTH]
    cq_l, ckv_l, kr_l, u_l = _split(p_lat, sizes)
    cq_c, ckv_c, kr_c, u_c = _split(p_ctx, sizes)

    def mla_kv(ckv, kr, use_rope):
        bsz, n = ckv.shape[:2]
        kvu = (rmsnorm(ckv, kv_norm_g) @ w_ukv).reshape(bsz, n, MLA_HEADS, MLA_NOPE + MLA_V)
        kr = kr[:, :, None, :]
        if use_rope:
            kr = rope_2d(kr, rows, cols)
        k = jnp.concatenate([kvu[..., :MLA_NOPE], jnp.broadcast_to(kr, (bsz, n, MLA_HEADS, MLA_ROPE))], axis=-1)
        return k, kvu[..., MLA_NOPE:]

    def mla_q(cq, use_rope):
        bsz, n = cq.shape[:2]
        q = (rmsnorm(cq, q_norm_g) @ w_uq).reshape(bsz, n, MLA_HEADS, MLA_NOPE + MLA_ROPE)
        if use_rope:
            q = jnp.concatenate([q[..., :MLA_NOPE], rope_2d(q[..., MLA_NOPE:], rows, cols)], axis=-1)
        return q

    kc, vc = mla_kv(ckv_c, kr_c, False)
    kl, vl = mla_kv(ckv_l, kr_l, True)
    att_l = block_attention(mla_q(cq_l, True), jnp.concatenate([kc, kl], axis=1), jnp.concatenate([vc, vl], axis=1))
    s5_l, s5_c = s5_mixer(u_l, u_c, a_re, a_im, log_dt, b_re, b_im, c_re, c_im, d_skip, glu_w, glu_b, ctx_needed)
    out_l = jnp.concatenate([att_l, s5_l.astype(p_lat.dtype)], axis=-1)
    if not ctx_needed:
        return out_l, None
    att_c = block_attention(mla_q(cq_c, False), kc, vc)
    return out_l, jnp.concatenate([att_c, s5_c.astype(p_ctx.dtype)], axis=-1)


def hier_moe(h, w_rg, w_re, w_gate, w_up, w_down):
    bsz, n, d = h.shape
    t = h.reshape(-1, d)
    pg = jax.nn.softmax((t @ w_rg).astype(F32), axis=-1)
    g_idx = jnp.argmax(pg, axis=-1)
    g_p = jnp.max(pg, axis=-1)
    le = (t @ w_re).astype(F32).reshape(-1, N_GROUPS, EXPERTS_PER_GROUP)
    le_sel = jnp.take_along_axis(le, g_idx[:, None, None], axis=1)[:, 0]
    top_p, top_i = lax.top_k(jax.nn.softmax(le_sel, axis=-1), TOP_K_INNER)
    top_p = top_p / jnp.sum(top_p, axis=-1, keepdims=True)
    inner = jnp.sum(jax.nn.one_hot(top_i, EXPERTS_PER_GROUP, dtype=F32) * top_p[..., None], axis=1)
    gates = (jax.nn.one_hot(g_idx, N_GROUPS, dtype=F32)[:, :, None]
             * (g_p[:, None] * inner)[:, None, :]).reshape(-1, N_EXPERTS).astype(t.dtype)
    y = jnp.zeros_like(t)
    for e in range(N_EXPERTS):
        hid = jax.nn.silu(t @ w_gate[e]) * (t @ w_up[e])
        y = y + gates[:, e:e + 1] * (hid @ w_down[e])
    return y.reshape(bsz, n, d)


def setup_inputs(seed: int = 0) -> dict:
    key = jax.random.key(seed)
    ks = iter(jax.random.split(key, 64))

    def nrm(shape, scale):
        return jax.random.normal(next(ks), shape, F32) * scale

    d = D_MODEL
    n_idx = jnp.arange(S5_STATE, dtype=F32)
    s5_shape = (N_ODD, 2, S5_GROUPS, S5_STATE)
    return {
        'x': nrm((BATCH, SEQ, d), 1.0),
        'c': nrm((BATCH, d), 1.0),
        'ctx': nrm((BATCH, CTX_LEN, d), 1.0),
        'c_ctx': nrm((d,), 1.0),
        'w_mod': nrm((DEPTH, d, 6 * d), 0.5 * d ** -0.5),
        'b_mod': nrm((DEPTH, 6 * d), 0.02),
        'norm_g': 1.0 + nrm((DEPTH, 2, d), 0.02),
        'e_w_in': nrm((N_EVEN, d, EVEN_IN), d ** -0.5),
        'e_hy_conv_w': nrm((N_EVEN, SHORT_CONV, 3 * A_WIDTH), SHORT_CONV ** -0.5),
        'e_hy_conv_b': nrm((N_EVEN, 3 * A_WIDTH), 0.02),
        'e_hy_w1': nrm((N_EVEN, HY_EMB, HY_HIDDEN), HY_EMB ** -0.5),
        'e_hy_b1': nrm((N_EVEN, HY_HIDDEN), 0.1),
        'e_hy_w2': nrm((N_EVEN, HY_HIDDEN, HY_HIDDEN), HY_HIDDEN ** -0.5),
        'e_hy_b2': nrm((N_EVEN, HY_HIDDEN), 0.1),
        'e_hy_w3': nrm((N_EVEN, HY_HIDDEN, 2 * HY_ORDER * A_WIDTH), HY_HIDDEN ** -0.5),
        'e_hy_freq': 1.0 + nrm((N_EVEN, HY_HIDDEN), 0.1),
        'e_hy_fbias': nrm((N_EVEN, HY_ORDER, A_WIDTH), 0.5),
        'e_qk_g': 1.0 + nrm((N_EVEN, 2, HEAD_DIM), 0.02),
        'e_w_out': nrm((N_EVEN, d, d), d ** -0.5),
        'o_w_in': nrm((N_ODD, d, ODD_IN), d ** -0.5),
        'o_q_norm_g': 1.0 + nrm((N_ODD, MLA_Q_RANK), 0.02),
        'o_w_uq': nrm((N_ODD, MLA_Q_RANK, MLA_HEADS * (MLA_NOPE + MLA_ROPE)), MLA_Q_RANK ** -0.5),
        'o_kv_norm_g': 1.0 + nrm((N_ODD, MLA_KV_RANK), 0.02),
        'o_w_ukv': nrm((N_ODD, MLA_KV_RANK, MLA_HEADS * (MLA_NOPE + MLA_V)), MLA_KV_RANK ** -0.5),
        'o_s5_a_re': -0.5 + nrm(s5_shape, 0.01),
        'o_s5_a_im': math.pi * n_idx + nrm(s5_shape, 0.01),
        'o_s5_log_dt': jax.random.uniform(next(ks), (N_ODD, 2, S5_GROUPS), F32, math.log(S5_DT_MIN), math.log(S5_DT_MAX)),
        'o_s5_b_re': nrm((N_ODD, 2, S5_GROUPS, S5_STATE, S5_GROUP), (2 * S5_GROUP) ** -0.5),
        'o_s5_b_im': nrm((N_ODD, 2, S5_GROUPS, S5_STATE, S5_GROUP), (2 * S5_GROUP) ** -0.5),
        'o_s5_c_re': nrm((N_ODD, 2, S5_GROUPS, S5_GROUP, S5_STATE), 0.5),
        'o_s5_c_im': nrm((N_ODD, 2, S5_GROUPS, S5_GROUP, S5_STATE), 0.5),
        'o_s5_d': nrm((N_ODD, S5_WIDTH), 0.5),
        'o_glu_w': nrm((N_ODD, S5_WIDTH, S5_WIDTH), S5_WIDTH ** -0.5),
        'o_glu_b': nrm((N_ODD, S5_WIDTH), 0.02),
        'o_w_out': nrm((N_ODD, d, d), d ** -0.5),
        'moe_w_rg': nrm((DEPTH, d, N_GROUPS), d ** -0.5),
        'moe_w_re': nrm((DEPTH, d, N_EXPERTS), d ** -0.5),
        'moe_w_gate': nrm((DEPTH, N_EXPERTS, d, D_EXPERT), d ** -0.5),
        'moe_w_up': nrm((DEPTH, N_EXPERTS, d, D_EXPERT), d ** -0.5),
        'moe_w_down': nrm((DEPTH, N_EXPERTS, D_EXPERT, d), D_EXPERT ** -0.5),
        'final_g': 1.0 + nrm((d,), 0.02),
    }


def reference(x, c, ctx, c_ctx, w_mod, b_mod, norm_g,
              e_w_in, e_hy_conv_w, e_hy_conv_b, e_hy_w1, e_hy_b1, e_hy_w2, e_hy_b2, e_hy_w3, e_hy_freq,
              e_hy_fbias, e_qk_g, e_w_out,
              o_w_in, o_q_norm_g, o_w_uq, o_kv_norm_g, o_w_ukv, o_s5_a_re, o_s5_a_im, o_s5_log_dt,
              o_s5_b_re, o_s5_b_im, o_s5_c_re, o_s5_c_im, o_s5_d, o_glu_w, o_glu_b, o_w_out,
              moe_w_rg, moe_w_re, moe_w_gate, moe_w_up, moe_w_down, final_g):
    n_ctx = ctx.shape[1]
    rows, cols = grid_positions(x.shape[1])
    xc = ctx
    for i in range(DEPTH):
        j = i // 2
        ctx_needed = i < DEPTH - 1
        sh1, sc1, g1, sh2, sc2, g2 = [m[:, None, :] for m in jnp.split(jax.nn.silu(c) @ w_mod[i] + b_mod[i], 6, axis=-1)]
        csh1, csc1, cg1, csh2, csc2, cg2 = jnp.split(jax.nn.silu(c_ctx) @ w_mod[i] + b_mod[i], 6, axis=-1)
        h_all = jnp.concatenate([modnorm(xc, norm_g[i, 0], csh1, csc1), modnorm(x, norm_g[i, 0], sh1, sc1)], axis=1)
        if i % 2 == 0:
            proj = h_all @ e_w_in[j]
            mix_l, mix_c = even_mixer(proj[:, n_ctx:], proj[:, :n_ctx], rows, cols, ctx_needed,
                                      e_hy_conv_w[j], e_hy_conv_b[j], e_hy_w1[j], e_hy_b1[j], e_hy_w2[j], e_hy_b2[j],
                                      e_hy_w3[j], e_hy_freq[j], e_hy_fbias[j], e_qk_g[j])
            w_out = e_w_out[j]
        else:
            proj = h_all @ o_w_in[j]
            mix_l, mix_c = odd_mixer(proj[:, n_ctx:], proj[:, :n_ctx], rows, cols, ctx_needed,
                                     o_q_norm_g[j], o_w_uq[j], o_kv_norm_g[j], o_w_ukv[j],
                                     o_s5_a_re[j], o_s5_a_im[j], o_s5_log_dt[j], o_s5_b_re[j], o_s5_b_im[j],
                                     o_s5_c_re[j], o_s5_c_im[j], o_s5_d[j], o_glu_w[j], o_glu_b[j])
            w_out = o_w_out[j]
        moe_p = (moe_w_rg[i], moe_w_re[i], moe_w_gate[i], moe_w_up[i], moe_w_down[i])
        if ctx_needed:
            out = jnp.concatenate([mix_c, mix_l], axis=1) @ w_out
            xc = xc + cg1 * out[:, :n_ctx]
            x = x + g1 * out[:, n_ctx:]
            f = hier_moe(jnp.concatenate([modnorm(xc, norm_g[i, 1], csh2, csc2),
                                          modnorm(x, norm_g[i, 1], sh2, sc2)], axis=1), *moe_p)
            xc = xc + cg2 * f[:, :n_ctx]
            x = x + g2 * f[:, n_ctx:]
        else:
            x = x + g1 * (mix_l @ w_out)
            x = x + g2 * hier_moe(modnorm(x, norm_g[i, 1], sh2, sc2), *moe_p)
    return rmsnorm(x, final_g)
```

```cpp
#include <hip/hip_runtime.h>
#include <cstdio>
#include <cstdint>

#ifndef PROBE_HF
#define PROBE_HF 1
#endif
#ifndef PROBE_KT
#define PROBE_KT 1
#endif
#ifndef WT_STORES
#define WT_STORES 0
#endif
#ifndef EARLY_WB
#define EARLY_WB 0
#endif
#ifndef MOE0_IN_P4
#define MOE0_IN_P4 1
#endif
#define LAS __attribute__((address_space(3)))
#define GAS __attribute__((address_space(1)))
#define DI __device__ __forceinline__
typedef unsigned short bf16_t;
typedef short bf16x8 __attribute__((ext_vector_type(8)));
typedef float f32x2 __attribute__((ext_vector_type(2)));
typedef float f32x4 __attribute__((ext_vector_type(4)));
typedef float f32x16 __attribute__((ext_vector_type(16)));
typedef unsigned u32x2 __attribute__((ext_vector_type(2)));
typedef unsigned u32x4 __attribute__((ext_vector_type(4)));
typedef __bf16 bf16x2_t __attribute__((ext_vector_type(2)));

constexpr int NB = 16, SEQ = 2048, CTX = 256, LT = 2304, T = NB * LT, DM = 1024;
constexpr int NPAN = T / 256;
constexpr float EPS = 1e-6f;
constexpr float LOG2E = 1.4426950408889634f;
constexpr int NWAVES = 8, NTHR = 512;
constexpr int MOE_ROWS = 82176;

enum { I_X = 0, I_C, I_CTX, I_CCTX, I_WMOD, I_BMOD, I_NORMG, I_EWIN, I_HCW, I_HCB, I_HW1, I_HB1, I_HW2, I_HB2, I_HW3, I_HFREQ, I_HFB, I_QKG, I_EWOUT,
       I_OWIN, I_QNG, I_WUQ, I_KVNG, I_WUKV, I_SARE, I_SAIM, I_SLDT, I_SBRE, I_SBIM, I_SCRE, I_SCIM, I_SD, I_GLUW, I_GLUB, I_OWOUT,
       I_WRG, I_WRE, I_WGATE, I_WUP, I_WDOWN, I_FINALG, N_IN };

constexpr size_t MiB = 1u << 20;
constexpr size_t WS_CTL = 0, CTL_ZERO_BYTES = 1 * MiB;
constexpr size_t WS_MODV = 1 * MiB;
constexpr size_t WS_ROPE0 = 2 * MiB;
constexpr size_t WS_ROPE1 = 2 * MiB + 512 * 1024;
constexpr size_t WS_NORMF = 2 * MiB + 768 * 1024;
constexpr size_t WS_S5PAR = 2 * MiB + 800 * 1024;
constexpr size_t WS_KTAB = 3 * MiB;
constexpr size_t WS_HYPART = 5 * MiB;
constexpr size_t WS_HYPARTC = 7 * MiB;
constexpr size_t WS_WIN0 = 12 * MiB;
constexpr size_t WS_WOUT0 = WS_WIN0 + 2304 * 1024 * 2;
constexpr size_t WS_WIN1 = WS_WOUT0 + 1024 * 1024 * 2;
constexpr size_t WS_WUQ = WS_WIN1 + 1024 * 1024 * 2;
constexpr size_t WS_WUKV = WS_WUQ + 768 * 256 * 2;
constexpr size_t WS_WGLU = WS_WUKV + 1024 * 128 * 2;
constexpr size_t WS_WOUT1 = WS_WGLU + 512 * 512 * 2;
constexpr size_t WS_WR = WS_WOUT1 + 1024 * 1024 * 2;
constexpr size_t WS_W_END_ = WS_WR + 2 * 256 * 1024 * 2;
static_assert(WS_W_END_ <= 28 * MiB, "weights region");
constexpr size_t WS_WGU = 28 * MiB;
constexpr size_t WS_WDN = 60 * MiB;
constexpr size_t WS_S5A = 76 * MiB;
constexpr size_t WS_S5W = 100 * MiB;
constexpr size_t WS_MOEL = 108 * MiB;
constexpr size_t WS_TOKE = WS_MOEL, WS_TOKW = WS_TOKE + (size_t)T * 8, WS_ROWTOK = WS_TOKW + (size_t)T * 8, WS_ROWDST = WS_ROWTOK + (size_t)MOE_ROWS * 4, WS_ROWW = WS_ROWDST + (size_t)MOE_ROWS * 4;
constexpr size_t WS_TOKPOS = WS_ROWW + (size_t)MOE_ROWS * 4;
static_assert(WS_TOKPOS + (size_t)T * 8 <= 112 * MiB, "moe lists");
constexpr size_t WS_RANKTOK = 112 * MiB;
constexpr size_t WS_RANKW = 117 * MiB;
static_assert(WS_RANKTOK + (size_t)32 * T * 4 <= WS_RANKW && WS_RANKW + (size_t)32 * T * 4 <= 128 * MiB, "rank tables");
constexpr size_t WS_H = 128 * MiB;
constexpr size_t WS_XS = 200 * MiB;
constexpr size_t WS_TMP = 272 * MiB;
constexpr size_t WS_HYT = WS_TMP;
constexpr size_t WS_Q0 = WS_TMP + 108 * MiB;
constexpr size_t WS_K0 = WS_Q0 + 36 * MiB;
constexpr size_t WS_V0 = WS_K0 + 9 * MiB;
constexpr size_t WS_HOT = WS_TMP + 168 * MiB;
constexpr size_t WS_GRAW = 494 * MiB;
constexpr size_t WS_GRAWC = 510 * MiB;
constexpr size_t WS_LOGIT = WS_TMP;
constexpr size_t WS_HID = WS_TMP;
constexpr size_t WS_Y2 = WS_TMP + 41 * MiB;
static_assert(WS_HID + (size_t)MOE_ROWS * 512 <= WS_Y2 && WS_Y2 + (size_t)MOE_ROWS * 2048 <= 494 * MiB, "moe tmp");
constexpr size_t WS_BMAT = WS_TMP;
constexpr size_t WS_S5S = WS_TMP + 60 * MiB;
constexpr size_t WS_Y = WS_S5S;
constexpr size_t WS_KN = WS_TMP + 100 * MiB;
constexpr size_t WS_VM = WS_TMP + 136 * MiB;
constexpr size_t WS_KR = WS_TMP + 172 * MiB;
constexpr size_t WS_CQ = WS_TMP + 175 * MiB;
constexpr size_t WS_CKV = WS_TMP + 193 * MiB;
constexpr size_t WS_QM = WS_H;
constexpr size_t WS_END = 512 * MiB;

constexpr int CW_BAR = 4096;
constexpr int CW_QUEUE = 131072;
constexpr int CW_CNT = 135168;

constexpr int CW_ROWSS = 150000;
static_assert((CW_ROWSS + 2 * T) * 4 <= (int)CTL_ZERO_BYTES, "rowss inside the zeroed region");
constexpr int LDS_BYTES = 147456;
constexpr int MISC_OFF = 146432;
constexpr int PTAB_OFF = MISC_OFF + 128;
constexpr int LDS_TAB_OFF = 131072 + 2048;

DI int bid_() { int b = (int)blockIdx.x; asm volatile("" : "+s"(b)); return b; }
DI int lane_id() { int r; asm volatile("v_mbcnt_lo_u32_b32 %0, -1, 0\n\tv_mbcnt_hi_u32_b32 %0, -1, %0" : "=v"(r)); return r; }
DI int gdim_() { int g = (int)gridDim.x; asm volatile("" : "+s"(g)); return g; }
DI unsigned f2bf(float f) { unsigned u = __builtin_bit_cast(unsigned, f); return (u + 0x7fffu + ((u >> 16) & 1u)) >> 16; }
DI unsigned pk2(float lo, float hi) { f32x2 v = {lo, hi}; bf16x2_t b = __builtin_convertvector(v, bf16x2_t); return __builtin_bit_cast(unsigned, b); }
DI float bf2f(unsigned short h) { return __builtin_bit_cast(float, (unsigned)h << 16); }
DI float bflo(unsigned w) { return __builtin_bit_cast(float, w << 16); }
DI float bfhi(unsigned w) { return __builtin_bit_cast(float, w & 0xffff0000u); }
DI float wave_sum(float v) {
#pragma unroll
    for (int o = 1; o < 64; o <<= 1) v += __shfl_xor(v, o);
    return v;
}
DI float silu_f(float x) { return x / (1.f + __expf(-x)); }
DI float gelu_tanh(float x) { const float u = 0.7978845608028654f * (x + 0.044715f * x * x * x); const float e = __expf(2.f * u); const float th = 1.f - 2.f / (e + 1.f); return 0.5f * x * (1.f + th); }
#define LDS_WAIT() asm volatile("s_waitcnt lgkmcnt(0)" ::: "memory")
#define VM_WAIT() asm volatile("s_waitcnt vmcnt(0)" ::: "memory")

#define XB_TMO      128
#define XB_XCNT(j)  (256  + 64 * (j))
#define XB_XSUB(j)  (1280 + 64 * (j))
#define XB_XGEN(j)  (2304 + 64 * (j))
#define XB_TOP      3328
#define XB_TOPGEN   3392
#define XCD_BAR_WORDS 3456
#define XB_SPIN_CAP (1u << 22)
__device__ __forceinline__ unsigned xb_ld(unsigned* p)              { return __hip_atomic_load(p, __ATOMIC_RELAXED, __HIP_MEMORY_SCOPE_AGENT); }
__device__ __forceinline__ unsigned xb_add(unsigned* p, unsigned v) { return __hip_atomic_fetch_add(p, v, __ATOMIC_RELAXED, __HIP_MEMORY_SCOPE_AGENT); }
__device__ __forceinline__ unsigned xb_xcc_id() { return (unsigned)__builtin_amdgcn_s_getreg((3 << 11) | 20) & 0xFu; }
#define XB_SPIN(cond, bar) do { unsigned _sp = 0; while (cond) { __builtin_amdgcn_s_sleep(1); \
    if ((++_sp & 255u) == 0u) { if (xb_ld(&(bar)[XB_TMO])) break; if (_sp > XB_SPIN_CAP) { atomicAdd(&(bar)[XB_TMO], 1u); break; } } } } while (0)
struct XcdBarrier { unsigned* bar; unsigned x; volatile LAS unsigned* st; };
__device__ __forceinline__ XcdBarrier xcd_barrier_post(unsigned* bar, volatile LAS unsigned* st) {
    XcdBarrier b; b.bar = bar; b.x = xb_xcc_id(); b.st = st;
    if (threadIdx.x == 0) (void)xb_add(&bar[XB_XCNT(b.x)], 1u);
    return b;
}
__device__ __forceinline__ void xcd_barrier_complete(unsigned* bar, unsigned x, unsigned& nloc, unsigned& nx) {
    const unsigned G = gridDim.x * gridDim.y * gridDim.z;
    unsigned sum, cnt, mine, sp = 0u;
    for (;;) {
        sum = 0u; cnt = 0u; mine = 0u;
#pragma unroll
        for (unsigned j = 0; j < 16; ++j) { const unsigned c = xb_ld(&bar[XB_XCNT(j)]); sum += c; cnt += (c > 0u) ? 1u : 0u; mine = (j == x) ? c : mine; }
        if (sum == G) break;
        __builtin_amdgcn_s_sleep(1);
        if ((++sp & 255u) == 0u) { if (xb_ld(&bar[XB_TMO])) break; if (sp > XB_SPIN_CAP) { atomicAdd(&bar[XB_TMO], 1u); break; } }
    }
    nloc = mine > 0u ? mine : 1u; nx = cnt > 0u ? cnt : 1u;
}
__device__ __forceinline__ void xcd_barrier(const XcdBarrier& b, int tid) {
    asm volatile("s_waitcnt vmcnt(0)" ::: "memory");
    __syncthreads();
    if (tid == 0) {
        unsigned* bar = b.bar;
        __builtin_amdgcn_s_waitcnt(0);
        unsigned nloc = b.st[0], nx = b.st[1];
        if (nloc == 0u) { xcd_barrier_complete(bar, b.x, nloc, nx); b.st[0] = nloc; b.st[1] = nx; }
#if EARLY_WB
        __builtin_amdgcn_fence(__ATOMIC_RELEASE, "agent");
        asm volatile("s_waitcnt vmcnt(0)" ::: "memory");
#endif
        const unsigned old = xb_add(&bar[XB_XSUB(b.x)], 1u);
        const unsigned gen = old / nloc;
        if (old + 1u == (gen + 1u) * nloc) {
            __builtin_amdgcn_fence(__ATOMIC_RELEASE, "agent");
            asm volatile("s_waitcnt vmcnt(0)" ::: "memory");
            const unsigned og = xb_add(&bar[XB_TOP], 1u);
            const unsigned tg = og / nx;
            if (og + 1u == (tg + 1u) * nx) xb_add(&bar[XB_TOPGEN], 1u);
            else XB_SPIN(xb_ld(&bar[XB_TOPGEN]) == tg, bar);
            __builtin_amdgcn_fence(__ATOMIC_ACQUIRE, "agent");
            xb_add(&bar[XB_XGEN(b.x)], 1u);
            asm volatile("s_waitcnt vmcnt(0)" ::: "memory");
        } else {
            XB_SPIN(xb_ld(&bar[XB_XGEN(b.x)]) == gen, bar);
            __builtin_amdgcn_fence(__ATOMIC_ACQUIRE, "agent");
            asm volatile("s_waitcnt vmcnt(0)" ::: "memory");
        }
    }
    __syncthreads();
}
namespace pg8 {
constexpr int BM = 256, BK = 64, HALF = 128, HTB = HALF * BK * 2, STAGE_BYTES = 8 * HTB, NXCD = 8, WGM = 8;
__host__ __device__ __forceinline__ int lds_byte(int r, int c) { const int st = (r >> 4) * 2 + (c >> 5), rr = r & 15, cc = c & 31, ob = rr * 64 + cc * 2; return st * 1024 + (ob ^ (((ob >> 9) & 1) << 5)); }
__host__ __device__ __forceinline__ void stage_rc(int b, int& R, int& C) { const int st = b / 1024, sb = b % 1024, swz = sb ^ (((sb >> 9) & 1) << 5); R = (st >> 1) * 16 + swz / 64; C = (st & 1) * 32 + (swz % 64) / 2; }
__host__ __device__ __forceinline__ int perm32(int rho) { const int n = rho >> 4, i = rho & 15; return 8 * (i >> 2) + 4 * n + (i & 3); }
struct Unit { int pm, pn, z; };

struct GridOrder {
    int nM, nN, nwg, G, c, wgm;
    DI void init(int nM_, int nN_, int G_, int c_, int wgm_ = WGM) { nM = nM_; nN = nN_; nwg = nM * nN; G = G_; c = c_; wgm = wgm_; }
    DI bool get(int i, int& pm, int& pn) const {
        const long L = (long)i * G + c; if (L >= nwg) return false;
        int wgid = (int)L; { const int q = nwg / NXCD, r = nwg % NXCD, xcd = wgid % NXCD, off = wgid / NXCD; wgid = (xcd < r ? xcd * (q + 1) : r * (q + 1) + (xcd - r) * q) + off; }
        const int nig = wgm * nN, gid = wgid / nig, fm = gid * wgm, gsz = (nM - fm) < wgm ? (nM - fm) : wgm;
        pm = fm + ((wgid % nig) % gsz); pn = (wgid % nig) / gsz; return true;
    }
};

template <class Prob, class Epi, bool ALIGN_EPI = true>
__device__ __forceinline__ void gemm_phase(LAS unsigned char* lds, int tid_in, const Prob& P, const Epi& E) {
    int tid_ = tid_in; asm volatile("" : "+v"(tid_));
    const int tid = tid_, wid = __builtin_amdgcn_readfirstlane(tid >> 6), lane = tid & 63, wr = wid >> 2, wc = wid & 3, fr = lane & 15, fq = lane >> 4;
    int K_ = P.K; asm volatile("" : "+s"(K_));
    const int K = K_, nt = K / BK;
    int sR[2], sC[2];
#pragma unroll
    for (int i = 0; i < 2; ++i) stage_rc(tid * 16 + i * 8192, sR[i], sC[i]);
    constexpr int NH = Prob::GATHER ? 2 : 1;
    unsigned vB[2], vaC[NH][2], vaN[NH][2];
#pragma unroll
    for (int i = 0; i < 2; ++i) vB[i] = P.b_voff(0, (sR[i] & ~31) + perm32(sR[i] & 31), sC[i]);
    const size_t hstepA = Prob::GATHER ? 0 : (size_t)P.a_voff(pg8::Unit{0, 0, 0}, 1, 0, 0), hstepB = (size_t)P.b_voff(1, 0, 0);
    const size_t kstep = (size_t)(BK * 2);
    const unsigned ldsw = (unsigned)wid * 1024u;
    const int aoff = lds_byte(wr * 64 + fr, fq * 8), boff = lds_byte(wc * 32 + fr, fq * 8);
#define PG8_SA(b, h) (((b) * 2 + (h)) * HTB)
#define PG8_SB(b, h) ((4 + (b) * 2 + (h)) * HTB)
#define PG8_STAGE_A(bufoff, gptr, VO, h) do { const char* gp_ = (gptr) + (h) * hstepA; \
        __builtin_amdgcn_global_load_lds((const unsigned*)(gp_ + VO[Prob::GATHER ? (h) : 0][0]), (LAS unsigned*)(lds + (bufoff) + ldsw), 16, 0, 0); \
        __builtin_amdgcn_global_load_lds((const unsigned*)(gp_ + VO[Prob::GATHER ? (h) : 0][1]), (LAS unsigned*)(lds + (bufoff) + ldsw + 8192), 16, 0, 0); } while (0)
#define PG8_STAGE_B(bufoff, gptr, h) do { const char* gp_ = (gptr) + (h) * hstepB; \
        __builtin_amdgcn_global_load_lds((const unsigned*)(gp_ + vB[0]), (LAS unsigned*)(lds + (bufoff) + ldsw), 16, 0, 0); \
        __builtin_amdgcn_global_load_lds((const unsigned*)(gp_ + vB[1]), (LAS unsigned*)(lds + (bufoff) + ldsw + 8192), 16, 0, 0); } while (0)
#define PG8_LDA(dst, b, h) do { _Pragma("unroll") for (int m = 0; m < 4; ++m) _Pragma("unroll") for (int k = 0; k < 2; ++k) dst[m][k] = *(const LAS bf16x8*)(lds + PG8_SA(b, h) + aoff + m * 2048 + k * 1024); } while (0)
#define PG8_LDB(dst, b, h) do { _Pragma("unroll") for (int n = 0; n < 2; ++n) _Pragma("unroll") for (int k = 0; k < 2; ++k) dst[n][k] = *(const LAS bf16x8*)(lds + PG8_SB(b, h) + boff + n * 2048 + k * 1024); } while (0)
#define PG8_MMA(ai, bj, At, Bt) do { __builtin_amdgcn_s_setprio(1); _Pragma("unroll") for (int m = 0; m < 4; ++m) _Pragma("unroll") for (int n = 0; n < 2; ++n) _Pragma("unroll") for (int k = 0; k < 2; ++k) \
        acc[ai][bj][m][n] = __builtin_amdgcn_mfma_f32_16x16x32_bf16(Bt[n][k], At[m][k], acc[ai][bj][m][n], 0, 0, 0); __builtin_amdgcn_s_setprio(0); } while (0)
#define PG8_WAIT_V(n) asm volatile("s_waitcnt vmcnt(" #n ")" ::: "memory")
#define PG8_WAIT_L(n) asm volatile("s_waitcnt lgkmcnt(" #n ")" ::: "memory")
#define PG8_BAR __builtin_amdgcn_s_barrier()
#define PG8_SCHED __builtin_amdgcn_sched_barrier(0)
    Unit cur, nxt; int ui = 0;
    if (!P.next(0, cur)) return;
    f32x4 acc[2][2][4][2];
#pragma unroll
    for (int a = 0; a < 2; ++a)
#pragma unroll
        for (int b = 0; b < 2; ++b)
#pragma unroll
            for (int m = 0; m < 4; ++m)
#pragma unroll
                for (int n = 0; n < 2; ++n) acc[a][b][m][n] = (f32x4){0.f, 0.f, 0.f, 0.f};
    bf16x8 At[4][2], B0[2][2], B1[2][2];
    const char* cA = P.a_base(cur); const char* cB = P.b_base(cur);
#pragma unroll
    for (int h = 0; h < NH; ++h)
#pragma unroll
        for (int i = 0; i < 2; ++i) { vaC[h][i] = P.a_voff(cur, h, sR[i], sC[i]); vaN[h][i] = vaC[h][i]; }
    PG8_STAGE_B(PG8_SB(0, 0), cB, 0); PG8_STAGE_B(PG8_SB(0, 1), cB, 1); PG8_STAGE_A(PG8_SA(0, 0), cA, vaC, 0); PG8_STAGE_A(PG8_SA(0, 1), cA, vaC, 1);
    if (wr == 1) PG8_BAR;
    PG8_WAIT_V(2); PG8_BAR;
    PG8_STAGE_B(PG8_SB(1, 0), cB + kstep, 0); PG8_STAGE_A(PG8_SA(1, 0), cA + kstep, vaC, 0); PG8_STAGE_B(PG8_SB(1, 1), cB + kstep, 1);
    PG8_WAIT_V(6); PG8_BAR;
    for (;;) {
        const bool has_next = P.next(ui + 1, nxt);
        const char* nA = has_next ? P.a_base(nxt) : cA; const char* nB = has_next ? P.b_base(nxt) : cB;
        if (Prob::GATHER) { if (has_next) {
#pragma unroll
            for (int h = 0; h < NH; ++h)
#pragma unroll
                for (int i = 0; i < 2; ++i) vaN[h][i] = P.a_voff(nxt, h, sR[i], sC[i]); } }
        for (int t = 0; t < nt; t += 2) {
            const bool last = (t == nt - 2);
            const char* a1 = cA + (size_t)(t + 1) * kstep;
            const char* a2 = last ? nA : cA + (size_t)(t + 2) * kstep; const char* b2 = last ? nB : cB + (size_t)(t + 2) * kstep;
            const char* a3 = a2 + kstep; const char* b3 = b2 + kstep;
            unsigned va2[NH][2];
#pragma unroll
            for (int h = 0; h < NH; ++h)
#pragma unroll
                for (int i = 0; i < 2; ++i) va2[h][i] = (Prob::GATHER && last) ? vaN[h][i] : vaC[h][i];
            PG8_LDB(B0, 0, 0); PG8_LDB(B1, 0, 1); PG8_SCHED; PG8_LDA(At, 0, 0); PG8_STAGE_A(PG8_SA(1, 1), a1, vaC, 1);
            PG8_WAIT_V(8); PG8_WAIT_L(0); PG8_BAR; PG8_MMA(0, 0, At, B0); PG8_MMA(0, 1, At, B1); PG8_BAR; PG8_SCHED;
            PG8_LDA(At, 0, 1); PG8_STAGE_B(PG8_SB(0, 0), b2, 0); PG8_STAGE_B(PG8_SB(0, 1), b2, 1); PG8_STAGE_A(PG8_SA(0, 0), a2, va2, 0);
            PG8_WAIT_V(8); PG8_WAIT_L(0); PG8_BAR; PG8_MMA(1, 0, At, B0); PG8_MMA(1, 1, At, B1); PG8_BAR; PG8_SCHED;
            PG8_LDB(B0, 1, 0); PG8_LDB(B1, 1, 1); PG8_SCHED; PG8_LDA(At, 1, 0); PG8_STAGE_A(PG8_SA(0, 1), a2, va2, 1);
            PG8_WAIT_V(8); PG8_WAIT_L(0); PG8_BAR; PG8_MMA(0, 0, At, B0); PG8_MMA(0, 1, At, B1); PG8_BAR; PG8_SCHED;
            PG8_LDA(At, 1, 1); PG8_STAGE_B(PG8_SB(1, 0), b3, 0); PG8_STAGE_B(PG8_SB(1, 1), b3, 1); PG8_STAGE_A(PG8_SA(1, 0), a3, va2, 0);
            PG8_WAIT_V(8); PG8_WAIT_L(0); PG8_BAR; PG8_MMA(1, 0, At, B0); PG8_MMA(1, 1, At, B1); PG8_BAR; PG8_SCHED;
        }
        if constexpr (ALIGN_EPI) { if (wr == 0) PG8_BAR; }
        { const int le_ = lane_id(); E(acc, cur, wr, wc, le_ & 15, le_ >> 4); }
        if (!has_next) break;
#pragma unroll
        for (int a = 0; a < 2; ++a)
#pragma unroll
            for (int b = 0; b < 2; ++b)
#pragma unroll
                for (int m = 0; m < 4; ++m)
#pragma unroll
                    for (int n = 0; n < 2; ++n) acc[a][b][m][n] = (f32x4){0.f, 0.f, 0.f, 0.f};
        cur = nxt; cA = nA; cB = nB; ++ui;
#pragma unroll
        for (int h = 0; h < NH; ++h)
#pragma unroll
            for (int i = 0; i < 2; ++i) vaC[h][i] = vaN[h][i];
        if constexpr (ALIGN_EPI) { if (wr == 1) PG8_BAR; }
    }
    PG8_WAIT_V(0);
    if constexpr (!ALIGN_EPI) { if (wr == 0) PG8_BAR; }
    PG8_BAR;
#undef PG8_SA
#undef PG8_SB
#undef PG8_STAGE_A
#undef PG8_STAGE_B
#undef PG8_LDA
#undef PG8_LDB
#undef PG8_MMA
#undef PG8_WAIT_V
#undef PG8_WAIT_L
#undef PG8_BAR
#undef PG8_SCHED
}
}
typedef pg8::Unit Unit;
typedef f32x4 AccT[2][2][4][2];
struct ProbDense {
    static constexpr bool GATHER = false;
    int K; const bf16_t* A; const bf16_t* B; int lda, ldb; pg8::GridOrder ord; int amap;
    DI void init(const bf16_t* A_, int lda_, int nM, const bf16_t* B_, int ldb_, int nN, int K_, int amap_, int wgm_ = pg8::WGM) { A = A_; B = B_; lda = lda_; ldb = ldb_; K = K_; amap = amap_; ord.init(nM, nN, gdim_(), bid_(), wgm_); }
    DI bool next(int i, Unit& u) const { int pm, pn; if (!ord.get(i, pm, pn)) return false; u.pm = amap ? (pm >> 3) * 9 + 1 + (pm & 7) : pm; u.pn = pn; u.z = 0; return true; }
    DI const char* a_base(const Unit& u) const { return (const char*)(A + (size_t)u.pm * 256 * lda); }
    DI const char* b_base(const Unit& u) const { return (const char*)(B + (size_t)u.pn * 256 * ldb); }
    DI unsigned a_voff(const Unit&, int h, int R, int C) const { return (unsigned)(((h * 128 + R) * lda + C) * 2); }
    DI unsigned b_voff(int h, int Rb, int C) const { return (unsigned)(((h * 128 + Rb) * ldb + C) * 2); }
};
struct ProbS5 {
    static constexpr bool GATHER = false;
    int K; const bf16_t* A; const bf16_t* B; size_t ags, bgs; int lda, ldb, nM, nN, arow0, gd, bi;
    DI bool next(int i, Unit& u) const { const int L = i * gd + bi; if (bi < 0 || L >= 32 * nM * nN) return false; u.z = L / (nM * nN); const int r = L % (nM * nN); u.pm = r / nN; u.pn = r % nN; return true; }
    DI const char* a_base(const Unit& u) const { return (const char*)(A + (size_t)u.z * ags + (size_t)(arow0 + u.pm * 256) * lda); }
    DI const char* b_base(const Unit& u) const { return (const char*)(B + (size_t)u.z * bgs + (size_t)u.pn * 256 * ldb); }
    DI unsigned a_voff(const Unit&, int h, int R, int C) const { return (unsigned)(((h * 128 + R) * lda + C) * 2); }
    DI unsigned b_voff(int h, int Rb, int C) const { return (unsigned)(((h * 128 + Rb) * ldb + C) * 2); }
};
DI int xcd_contig(int L, int n) { const int q = n >> 3, r = n & 7, x = L & 7, off = L >> 3; return (x < r ? x * (q + 1) : r * (q + 1) + (x - r) * q) + off; }
struct ProbMoeUp {
    static constexpr bool GATHER = true;
    int K; const bf16_t* A; const bf16_t* B; const int* rank_tok; const LAS int* tab;
    DI bool next(int i, Unit& u) const { const int L0 = i * gdim_() + bid_(), n = 2 * tab[0]; if (L0 >= n) return false; const int L = xcd_contig(L0, n); u.pm = L >> 1; u.pn = L & 1; u.z = tab[1 + u.pm] & 255; return true; }
    DI const char* a_base(const Unit&) const { return (const char*)A; }
    DI const char* b_base(const Unit& u) const { return (const char*)(B + (size_t)u.z * 512 * 1024 + (size_t)u.pn * 256 * 1024); }
    DI unsigned a_voff(const Unit& u, int h, int R, int C) const { const int rank = (tab[1 + u.pm] >> 8) * 256 + h * 128 + R;
        const int tk = rank < tab[400 + u.z] ? rank_tok[(size_t)u.z * T + rank] >> 1 : 0; return (unsigned)((tk * 1024 + C) * 2); }
    DI unsigned b_voff(int h, int Rb, int C) const { return (unsigned)(((h * 128 + Rb) * 1024 + C) * 2); }
};
struct ProbMoeDown {
    static constexpr bool GATHER = false;
    int K; const bf16_t* A; const bf16_t* B; const LAS int* tab;
    DI bool next(int i, Unit& u) const { const int L0 = i * gdim_() + bid_(), n = 4 * tab[0]; if (L0 >= n) return false; const int L = xcd_contig(L0, n); u.pm = L >> 2; u.pn = L & 3; u.z = tab[1 + u.pm] & 255; return true; }
    DI const char* a_base(const Unit& u) const { return (const char*)(A + (size_t)u.pm * 256 * 256); }
    DI const char* b_base(const Unit& u) const { return (const char*)(B + (size_t)u.z * 1024 * 256 + (size_t)u.pn * 256 * 256); }
    DI unsigned a_voff(const Unit&, int h, int R, int C) const { return (unsigned)(((h * 128 + R) * 256 + C) * 2); }
    DI unsigned b_voff(int h, int Rb, int C) const { return (unsigned)(((h * 128 + Rb) * 256 + C) * 2); }
};

#define EPI_ROW(u, ai, m) ((u).pm * 256 + (ai) * 128 + wr * 64 + (m) * 16 + fr)
#define EPI_COL(u, bj) ((u).pn * 256 + (bj) * 128 + wc * 32 + fq * 8)
#if WT_STORES
DI void st16_wt(void* p, const u32x4& v) { asm volatile("global_store_dwordx4 %0, %1, off sc1\n\ts_nop 1" :: "v"(p), "v"(v) : "memory"); }
#define ST16(addr, val) st16_wt((void*)(addr), (val))
#else
#define ST16(addr, val) (*(u32x4*)(addr) = (val))
#endif
DI u32x4 pack8(const f32x4& a, const f32x4& b) { u32x4 w; w.x = pk2(a[0], a[1]); w.y = pk2(a[2], a[3]); w.z = pk2(b[0], b[1]); w.w = pk2(b[2], b[3]); return w; }

struct EpiNull { float* sink;
    DI void operator()(const AccT& acc, const Unit& u, int wr, int wc, int fr, int fq) const { f32x4 s = {0.f, 0.f, 0.f, 0.f};
#pragma unroll
        for (int ai = 0; ai < 2; ++ai)
#pragma unroll
            for (int bj = 0; bj < 2; ++bj)
#pragma unroll
                for (int m = 0; m < 4; ++m) { s += acc[ai][bj][m][0]; s += acc[ai][bj][m][1]; }
        if (s.x + s.y + s.z + s.w == 12345.678f) sink[u.pm + wr + wc + fr + fq] = s.x; } };
struct EpiStore {
    bf16_t* O; size_t ldc;
    DI void operator()(const AccT& acc, const Unit& u, int wr, int wc, int fr, int fq) const {
#pragma unroll
        for (int ai = 0; ai < 2; ++ai)
#pragma unroll
            for (int m = 0; m < 4; ++m) { bf16_t* rp = O + (size_t)EPI_ROW(u, ai, m) * ldc;
#pragma unroll
                for (int bj = 0; bj < 2; ++bj) ST16(rp + EPI_COL(u, bj), pack8(acc[ai][bj][m][0], acc[ai][bj][m][1])); }
    }
};
struct EpiStoreNT {
    bf16_t* O; size_t ldc;
    DI void operator()(const AccT& acc, const Unit& u, int wr, int wc, int fr, int fq) const {
#pragma unroll
        for (int ai = 0; ai < 2; ++ai)
#pragma unroll
            for (int m = 0; m < 4; ++m) { bf16_t* rp = O + (size_t)EPI_ROW(u, ai, m) * ldc;
#pragma unroll
                for (int bj = 0; bj < 2; ++bj) __builtin_nontemporal_store(pack8(acc[ai][bj][m][0], acc[ai][bj][m][1]), (u32x4*)(rp + EPI_COL(u, bj))); }
    }
};
struct EpiQKV {
    bf16_t *Q, *Kb, *Vb; const float* qkg; const f32x2* rope; float qscale;
    DI void operator()(const AccT& acc, const Unit& u, int wr, int wc, int fr, int fq) const {
        const int kind = (u.pn < 2) ? 0 : (wc < 2 ? 1 : 2);
        const int hs = (u.pn < 2) ? u.pn * 4 + wc : (wc & 1);
        bf16_t* base = kind == 0 ? Q : (kind == 1 ? Kb : Vb); const int ld = kind == 0 ? 512 : 128;
        f32x4 gn[2][2];
        { const float* gp = qkg + (kind & 1) * 64 + 32 * (fq >> 1) + 8 * (fq & 1);
#pragma unroll
          for (int bj = 0; bj < 2; ++bj) { gn[bj][0] = *(const f32x4*)(gp + 16 * bj); gn[bj][1] = *(const f32x4*)(gp + 16 * bj + 4); } }
        const float osc = kind == 0 ? qscale : 1.f;
        const bool roped = kind < 2 && (u.pm % 9) != 0;
#pragma unroll
        for (int ai = 0; ai < 2; ++ai) {
            f32x2 cs[4][8];
            if (roped) {
#pragma unroll
                for (int m = 0; m < 4; ++m) { const int pos = EPI_ROW(u, ai, m) % LT; const f32x2* rp = rope + (size_t)(pos - CTX) * 32 + (fq >> 1) * 16 + (fq & 1) * 8;
#pragma unroll
                    for (int k = 0; k < 8; ++k) cs[m][k] = rp[k]; } }
            asm volatile("" ::: "memory");
#pragma unroll
            for (int m = 0; m < 4; ++m) {
                const int r = EPI_ROW(u, ai, m);
                f32x4 v[2][2];
#pragma unroll
                for (int bj = 0; bj < 2; ++bj) { v[bj][0] = acc[ai][bj][m][0]; v[bj][1] = acc[ai][bj][m][1]; }
                if (kind < 2) {
                    float ss = 0.f;
#pragma unroll
                    for (int bj = 0; bj < 2; ++bj)
#pragma unroll
                        for (int n = 0; n < 2; ++n)
#pragma unroll
                            for (int j = 0; j < 4; ++j) ss += v[bj][n][j] * v[bj][n][j];
                    ss += __shfl_xor(ss, 16); ss += __shfl_xor(ss, 32);
                    const float rstd = __builtin_amdgcn_rsqf(ss * (1.f / 64.f) + EPS);
#pragma unroll
                    for (int bj = 0; bj < 2; ++bj)
#pragma unroll
                        for (int n = 0; n < 2; ++n)
#pragma unroll
                            for (int j = 0; j < 4; ++j) v[bj][n][j] = v[bj][n][j] * rstd * gn[bj][n][j];
                    if (roped) {
#pragma unroll
                        for (int n = 0; n < 2; ++n)
#pragma unroll
                            for (int j = 0; j < 4; ++j) { const f32x2 c2 = cs[m][4 * n + j]; const float t1 = v[0][n][j], t2 = v[1][n][j]; v[0][n][j] = t1 * c2.x - t2 * c2.y; v[1][n][j] = t1 * c2.y + t2 * c2.x; }
                    }
                }
                bf16_t* rowp = base + (size_t)r * ld + hs * 64 + fq * 8;
#pragma unroll
                for (int bj = 0; bj < 2; ++bj) ST16(rowp + 32 * bj, pack8(v[bj][0] * osc, v[bj][1] * osc));
            }
            asm volatile("" ::: "memory");
        }
    }
};
struct EpiRes {
    const float* src_lat; const float* src_ctx; bf16_t* xs; const float* gate; int src_bf16;
    DI void operator()(const AccT& acc, const Unit& u, int wr, int wc, int fr, int fq) const {
        const int b = u.pm / 9; const bool isc = (u.pm % 9) == 0;
        const float* gp = gate + (isc ? 16 : b) * 6144;
        f32x4 gv[2][2];
#pragma unroll
        for (int bj = 0; bj < 2; ++bj) { const int c = EPI_COL(u, bj); gv[bj][0] = *(const f32x4*)(gp + c); gv[bj][1] = *(const f32x4*)(gp + c + 4); }
#pragma unroll
        for (int ai = 0; ai < 2; ++ai) {
            if (src_bf16) { u32x4 sv[4][2];
#pragma unroll
                for (int m = 0; m < 4; ++m)
#pragma unroll
                    for (int bj = 0; bj < 2; ++bj) sv[m][bj] = *(const u32x4*)(xs + (size_t)EPI_ROW(u, ai, m) * DM + EPI_COL(u, bj));
                asm volatile("" ::: "memory");
#pragma unroll
                for (int m = 0; m < 4; ++m) { bf16_t* dp = xs + (size_t)EPI_ROW(u, ai, m) * DM;
#pragma unroll
                    for (int bj = 0; bj < 2; ++bj) { const u32x4 s = sv[m][bj]; const f32x4 s0 = (f32x4){bflo(s.x), bfhi(s.x), bflo(s.y), bfhi(s.y)}, s1 = (f32x4){bflo(s.z), bfhi(s.z), bflo(s.w), bfhi(s.w)};
                        ST16(dp + EPI_COL(u, bj), pack8(s0 + gv[bj][0] * acc[ai][bj][m][0], s1 + gv[bj][1] * acc[ai][bj][m][1])); } }
            } else {
#pragma unroll
              for (int mh = 0; mh < 2; ++mh) { f32x4 sf[2][2][2];
#pragma unroll
                for (int mm = 0; mm < 2; ++mm) { const int r = EPI_ROW(u, ai, 2 * mh + mm); const int pos = r - b * LT;
                    const float* sp = isc ? src_ctx + (size_t)(b * CTX + pos) * DM : src_lat + (size_t)(b * SEQ + pos - CTX) * DM;
#pragma unroll
                    for (int bj = 0; bj < 2; ++bj) { const int c = EPI_COL(u, bj); sf[mm][bj][0] = *(const f32x4*)(sp + c); sf[mm][bj][1] = *(const f32x4*)(sp + c + 4); } }
                asm volatile("" ::: "memory");
#pragma unroll
                for (int mm = 0; mm < 2; ++mm) { const int m = 2 * mh + mm; bf16_t* dp = xs + (size_t)EPI_ROW(u, ai, m) * DM;
#pragma unroll
                    for (int bj = 0; bj < 2; ++bj) ST16(dp + EPI_COL(u, bj), pack8(sf[mm][bj][0] + gv[bj][0] * acc[ai][bj][m][0], sf[mm][bj][1] + gv[bj][1] * acc[ai][bj][m][1])); }
                asm volatile("" ::: "memory"); }
            }
            asm volatile("" ::: "memory");
        }
    }
};
struct EpiRouter {
    float* L;
    DI void operator()(const AccT& acc, const Unit& u, int wr, int wc, int fr, int fq) const {
        if (wc >= 2) return;
#pragma unroll
        for (int ai = 0; ai < 2; ++ai)
#pragma unroll
            for (int m = 0; m < 4; ++m) { float* rp = L + (size_t)EPI_ROW(u, ai, m) * 64 + wc * 32 + fq * 8; *(f32x4*)rp = acc[ai][0][m][0]; *(f32x4*)(rp + 4) = acc[ai][0][m][1]; }
    }
};
struct EpiGateUp {
    bf16_t* H;
    DI void operator()(const AccT& acc, const Unit& u, int wr, int wc, int fr, int fq) const {
#pragma unroll
        for (int ai = 0; ai < 2; ++ai)
#pragma unroll
            for (int m = 0; m < 4; ++m) { f32x4 o[2];
#pragma unroll
                for (int n = 0; n < 2; ++n)
#pragma unroll
                    for (int j = 0; j < 4; ++j) o[n][j] = silu_f(acc[ai][0][m][n][j]) * acc[ai][1][m][n][j];
                ST16(H + (size_t)EPI_ROW(u, ai, m) * 256 + u.pn * 128 + wc * 32 + fq * 8, pack8(o[0], o[1])); asm volatile("" ::: "memory"); }
    }
};
struct EpiDownSorted {
    bf16_t* Y2; const float* rank_w; const LAS int* tab;
    DI void operator()(const AccT& acc, const Unit& u, int wr, int wc, int fr, int fq) const {
        float wv[2][4];
        const int rk0 = (tab[1 + u.pm] >> 8) * 256, cnt = tab[400 + u.z]; const float* rw = rank_w + (size_t)u.z * T;
#pragma unroll
        for (int ai = 0; ai < 2; ++ai)
#pragma unroll
            for (int m = 0; m < 4; ++m) { const int rank = rk0 + ai * 128 + wr * 64 + m * 16 + fr; wv[ai][m] = rank < cnt ? rw[rank] : 0.f; }
        asm volatile("" ::: "memory");
#pragma unroll
        for (int ai = 0; ai < 2; ++ai)
#pragma unroll
            for (int m = 0; m < 4; ++m) { const int r = EPI_ROW(u, ai, m); const float w = wv[ai][m]; bf16_t* rp = Y2 + (size_t)r * 1024;
#pragma unroll
                for (int bj = 0; bj < 2; ++bj) ST16(rp + EPI_COL(u, bj), pack8(acc[ai][bj][m][0] * w, acc[ai][bj][m][1] * w)); asm volatile("" ::: "memory"); }
    }
};
struct EpiDown {
    bf16_t* Y2; const int* row_dst; const float* row_w;
    DI void operator()(const AccT& acc, const Unit& u, int wr, int wc, int fr, int fq) const {
#pragma unroll
        for (int ai = 0; ai < 2; ++ai)
#pragma unroll
            for (int m = 0; m < 4; ++m) { const int r = EPI_ROW(u, ai, m); const int d = row_dst[r]; const float w = row_w[r];
                if (d >= 0) { bf16_t* rp = Y2 + (size_t)d * 1024;
#pragma unroll
                    for (int bj = 0; bj < 2; ++bj) ST16(rp + EPI_COL(u, bj), pack8(acc[ai][bj][m][0] * w, acc[ai][bj][m][1] * w)); } asm volatile("" ::: "memory"); }
    }
};
struct EpiInproj1 {
    bf16_t *CQ, *CKV, *KR, *BM; float* rowss; const f32x2* rope;
    DI void operator()(const AccT& acc, const Unit& u, int wr, int wc, int fr, int fq) const {
#pragma unroll
        for (int ai = 0; ai < 2; ++ai)
#pragma unroll
            for (int m = 0; m < 4; ++m) { const int r = EPI_ROW(u, ai, m);
                if (u.pn == 0) { float ss = 0.f;
#pragma unroll
                    for (int bj = 0; bj < 2; ++bj) { ST16(CQ + (size_t)r * 256 + bj * 128 + wc * 32 + fq * 8, pack8(acc[ai][bj][m][0], acc[ai][bj][m][1]));
#pragma unroll
                        for (int n = 0; n < 2; ++n)
#pragma unroll
                            for (int j = 0; j < 4; ++j) ss += acc[ai][bj][m][n][j] * acc[ai][bj][m][n][j]; }
                    ss += __shfl_xor(ss, 16); ss += __shfl_xor(ss, 32);
                    if (fq == 0) atomicAdd(rowss + r, ss);
                } else if (u.pn < 3) {
                    const int b = r / LT, pos = r % LT, ch = pos >> 5, j = pos & 31;
#pragma unroll
                    for (int bj = 0; bj < 2; ++bj) { const int uc = (u.pn - 1) * 256 + bj * 128 + wc * 32 + fq * 8; const int g = uc >> 4, hi0 = uc & 15;
                        ST16(BM + ((size_t)g * 1280 + ch * 16 + b) * 768 + j * 16 + hi0, pack8(acc[ai][bj][m][0], acc[ai][bj][m][1])); }
                } else {
                    ST16(CKV + (size_t)r * 128 + wc * 32 + fq * 8, pack8(acc[ai][0][m][0], acc[ai][0][m][1]));
                    float ss = 0.f;
#pragma unroll
                    for (int n = 0; n < 2; ++n)
#pragma unroll
                        for (int j = 0; j < 4; ++j) ss += acc[ai][0][m][n][j] * acc[ai][0][m][n][j];
                    ss += __shfl_xor(ss, 16); ss += __shfl_xor(ss, 32);
                    if (fq == 0) atomicAdd(rowss + T + r, ss);
                    if (wc == 0) {
                        const int pos = r % LT; f32x4 v0 = acc[ai][1][m][0], v1 = acc[ai][1][m][1], p0, p1;
#pragma unroll
                        for (int j = 0; j < 4; ++j) { p0[j] = __shfl_xor(v0[j], 16); p1[j] = __shfl_xor(v1[j], 16); }
                        if (pos >= CTX) { const int g = fq >> 1, s = fq & 1; const f32x2* cp = rope + (size_t)(pos - CTX) * 16 + g * 8;
#pragma unroll
                            for (int j = 0; j < 4; ++j) { const f32x2 c0 = cp[j], c1 = cp[4 + j];
                                v0[j] = s ? (p0[j] * c0.y + v0[j] * c0.x) : (v0[j] * c0.x - p0[j] * c0.y);
                                v1[j] = s ? (p1[j] * c1.y + v1[j] * c1.x) : (v1[j] * c1.x - p1[j] * c1.y); } }
                        ST16(KR + (size_t)r * 32 + fq * 8, pack8(v0, v1)); }
                }
                asm volatile("" ::: "memory");
            }
    }
};
struct EpiQup {
    bf16_t* QM; const f32x2* rope; float qscale;
    DI void operator()(const AccT& acc, const Unit& u, int wr, int wc, int fr, int fq) const {
#pragma unroll
        for (int ai = 0; ai < 2; ++ai)
#pragma unroll
            for (int m = 0; m < 4; ++m) { const int r = EPI_ROW(u, ai, m); bf16_t* rp = QM + (size_t)r * 768;
                if (u.pn < 2) {
#pragma unroll
                    for (int bj = 0; bj < 2; ++bj) { const int v = u.pn * 256 + bj * 128 + wc * 32 + fq * 8; ST16(rp + (v >> 6) * 96 + (v & 63), pack8(acc[ai][bj][m][0] * qscale, acc[ai][bj][m][1] * qscale)); }
                } else {
                    const int pos = r % LT; const int head = 2 * wc + (fq >> 1), g = fq & 1;
                    const f32x2* cp = rope + (size_t)(pos - CTX) * 16 + g * 8;
                    f32x4 o[2][2];
#pragma unroll
                    for (int n = 0; n < 2; ++n)
#pragma unroll
                        for (int j = 0; j < 4; ++j) { const f32x2 cs = cp[4 * n + j]; const float t1 = acc[ai][0][m][n][j], t2 = acc[ai][1][m][n][j]; o[0][n][j] = (t1 * cs.x - t2 * cs.y) * qscale; o[1][n][j] = (t1 * cs.y + t2 * cs.x) * qscale; }
#pragma unroll
                    for (int s = 0; s < 2; ++s) ST16(rp + head * 96 + 64 + 16 * g + 8 * s, pack8(o[s][0], o[s][1]));
                }
                asm volatile("" ::: "memory");
            }
    }
};
struct EpiKVup {
    bf16_t *Kn, *Vm;
    DI void operator()(const AccT& acc, const Unit& u, int wr, int wc, int fr, int fq) const {
        bf16_t* base = u.pn < 2 ? Kn : Vm; const int ct = (u.pn & 1) * 256;
#pragma unroll
        for (int ai = 0; ai < 2; ++ai)
#pragma unroll
            for (int m = 0; m < 4; ++m) { bf16_t* rp = base + (size_t)EPI_ROW(u, ai, m) * 512 + ct + wc * 32 + fq * 8;
#pragma unroll
                for (int bj = 0; bj < 2; ++bj) ST16(rp + bj * 128, pack8(acc[ai][bj][m][0], acc[ai][bj][m][1])); }
    }
};
struct EpiS5G1 {
    float* S;
    DI void operator()(const AccT& acc, const Unit& u, int wr, int wc, int fr, int fq) const {
#pragma unroll
        for (int ai = 0; ai < 2; ++ai)
#pragma unroll
            for (int m = 0; m < 4; ++m) { float* rp = S + ((size_t)u.z * 1280 + EPI_ROW(u, ai, m)) * 256 + wc * 32 + fq * 8;
#pragma unroll
                for (int bj = 0; bj < 2; ++bj) { *(f32x4*)(rp + bj * 128) = acc[ai][bj][m][0]; *(f32x4*)(rp + bj * 128 + 4) = acc[ai][bj][m][1]; } }
    }
};
struct EpiS5G2 {
    bf16_t* Y;
    DI void operator()(const AccT& acc, const Unit& u, int wr, int wc, int fr, int fq) const {
#pragma unroll
        for (int ai = 0; ai < 2; ++ai)
#pragma unroll
            for (int m = 0; m < 4; ++m) { const int rl = EPI_ROW(u, ai, m); const int R = rl >> 4, b = rl & 15;
#pragma unroll
                for (int bj = 0; bj < 2; ++bj) { const int c = EPI_COL(u, bj); const int k = c >> 4, ho0 = c & 15; f32x4 o[2];
#pragma unroll
                    for (int n = 0; n < 2; ++n)
#pragma unroll
                        for (int j = 0; j < 4; ++j) o[n][j] = gelu_tanh(acc[ai][bj][m][n][j]);
                    ST16(Y + (size_t)(b * LT + CTX + 32 * R + k) * 512 + u.z * 16 + ho0, pack8(o[0], o[1])); } asm volatile("" ::: "memory"); }
    }
};
struct EpiGLU {
    const bf16_t* Y; const float* bias; bf16_t* MIX;
    DI void operator()(const AccT& acc, const Unit& u, int wr, int wc, int fr, int fq) const {
        f32x4 bv[2][2];
#pragma unroll
        for (int bj = 0; bj < 2; ++bj) { const int c = EPI_COL(u, bj); bv[bj][0] = *(const f32x4*)(bias + c); bv[bj][1] = *(const f32x4*)(bias + c + 4); }
#pragma unroll
        for (int ai = 0; ai < 2; ++ai) { u32x4 gw[4][2];
#pragma unroll
            for (int m = 0; m < 4; ++m)
#pragma unroll
                for (int bj = 0; bj < 2; ++bj) gw[m][bj] = *(const u32x4*)(Y + (size_t)EPI_ROW(u, ai, m) * 512 + EPI_COL(u, bj));
            asm volatile("" ::: "memory");
#pragma unroll
            for (int m = 0; m < 4; ++m) { const int r = EPI_ROW(u, ai, m);
#pragma unroll
                for (int bj = 0; bj < 2; ++bj) { const int c = EPI_COL(u, bj); const u32x4 q = gw[m][bj];
                    const float g[8] = {bflo(q.x), bfhi(q.x), bflo(q.y), bfhi(q.y), bflo(q.z), bfhi(q.z), bflo(q.w), bfhi(q.w)};
                    f32x4 o[2];
#pragma unroll
                    for (int n = 0; n < 2; ++n)
#pragma unroll
                        for (int j = 0; j < 4; ++j) { const float z = acc[ai][bj][m][n][j] + bv[bj][n][j]; o[n][j] = g[4 * n + j] / (1.f + __expf(-z)); }
                    ST16(MIX + (size_t)r * 1024 + 512 + c, pack8(o[0], o[1])); } }
            asm volatile("" ::: "memory"); }
    }
};
struct Frame {
    LAS unsigned char* lds;
    int tid, lane, wave, gw, NGW;
    float* out; unsigned char* ws; unsigned* ctl;
    DI const float* in_(int i) const { const LAS unsigned* p = (const LAS unsigned*)(lds + PTAB_OFF) + 2 * i; const unsigned lo = __builtin_amdgcn_readfirstlane(p[0]), hi = __builtin_amdgcn_readfirstlane(p[1]); return (const float*)(const GAS float*)(((unsigned long long)hi << 32) | lo); }
};

template <class F>
DI void tr_item(const float* W, int K, int N, bf16_t* WT, LAS float* scr, int item, int lane, F rowmap, const float* kscale = nullptr) {
    const int nblk = N / 32, kb = item / nblk, nb = item % nblk, k0 = 64 * kb, n0 = 32 * nb;
    { f32x4 v[8];
#pragma unroll
      for (int i = 0; i < 8; ++i) v[i] = *(const f32x4*)(W + (size_t)(k0 + 8 * i + (lane >> 3)) * N + n0 + 4 * (lane & 7));
#pragma unroll
      for (int i = 0; i < 8; ++i) { LAS float* d = scr + (8 * i + (lane >> 3)) * 33 + 4 * (lane & 7); d[0] = v[i].x; d[1] = v[i].y; d[2] = v[i].z; d[3] = v[i].w; } }
    LDS_WAIT(); asm volatile("" ::: "memory");
    const int c = lane & 7;
    float ks[8];
#pragma unroll
    for (int e = 0; e < 8; ++e) ks[e] = kscale ? kscale[k0 + 8 * c + e] : 1.f;
#pragma unroll
    for (int j = 0; j < 4; ++j) { const int n = (lane >> 3) + 8 * j; const LAS float* s = scr + (8 * c) * 33 + n;
        u32x4 o; o.x = pk2(s[0 * 33] * ks[0], s[1 * 33] * ks[1]); o.y = pk2(s[2 * 33] * ks[2], s[3 * 33] * ks[3]); o.z = pk2(s[4 * 33] * ks[4], s[5 * 33] * ks[5]); o.w = pk2(s[6 * 33] * ks[6], s[7 * 33] * ks[7]);
        const int row = rowmap(n0 + n);
        if (row >= 0) *(u32x4*)(WT + (size_t)row * K + k0 + 8 * c) = o; }
    LDS_WAIT(); asm volatile("" ::: "memory");
}
DI int map_win0(int col) {
    if (col < 1536) return col;
    const int cp = col - 1536, hs = cp >> 6, d = cp & 63, tile = hs >> 2, wc = hs & 3;
    int bj, fq, r;
    if (hs < 10) { const int g = d >> 5, s = (d >> 4) & 1, i = d & 15; fq = 2 * g + (i >> 3); bj = s; r = i & 7; }
    else { bj = d >> 5; fq = (d >> 3) & 3; r = d & 7; }
    return 1536 + 256 * tile + 128 * bj + 32 * wc + 8 * fq + r;
}
DI int map_win1(int col) { return col < 256 ? col : (col < 384 ? 768 + (col - 256) : (col < 416 ? 896 + (col - 384) : 256 + (col - 416))); }
DI int map_wuq(int col) { const int head = col / 96, dd = col % 96; if (dd < 64) return head * 64 + dd; const int e = dd - 64, g = e >> 4, s = (e >> 3) & 1, i = e & 7; return 512 + 64 * (head >> 1) + 32 * s + 8 * (2 * (head & 1) + g) + i; }
DI int map_wukv(int col) { const int head = col >> 7, dd = col & 127; return dd < 64 ? head * 64 + dd : 512 + head * 64 + (dd - 64); }
DI int map_gate(int col) { return 256 * (col >> 7) + (col & 127); }

DI void moe_weight_items(Frame& F, int layer, LAS float* scr, int wrank, int nwrank) {
    const float* wg = F.in_(I_WGATE) + (size_t)layer * 32 * 1024 * 256; const float* wu = F.in_(I_WUP) + (size_t)layer * 32 * 1024 * 256; const float* wd = F.in_(I_WDOWN) + (size_t)layer * 32 * 256 * 1024;
    bf16_t* Wgu = (bf16_t*)(F.ws + WS_WGU); bf16_t* Wdn = (bf16_t*)(F.ws + WS_WDN);
    constexpr int IG = 16 * 8, ID = 4 * 32;
    constexpr int NIT = 32 * (2 * IG + ID);
    for (int it = wrank; it < NIT; it += nwrank) {
        const int e = it / (2 * IG + ID); int r = it % (2 * IG + ID);
        if (r < IG) { tr_item(wg + (size_t)e * 1024 * 256, 1024, 256, Wgu + (size_t)e * 512 * 1024, scr, r, F.lane, [](int c) { return map_gate(c); }); continue; } r -= IG;
        if (r < IG) { tr_item(wu + (size_t)e * 1024 * 256, 1024, 256, Wgu + (size_t)e * 512 * 1024, scr, r, F.lane, [](int c) { return map_gate(c) + 128; }); continue; } r -= IG;
        tr_item(wd + (size_t)e * 256 * 1024, 256, 1024, Wdn + (size_t)e * 1024 * 256, scr, r, F.lane, [](int c) { return c; });
    }
}
DI void router_rg_item(Frame& F, int layer) {
    const float* w = F.in_(I_WRG) + (size_t)layer * 1024 * 4; bf16_t* d = (bf16_t*)(F.ws + WS_WR) + (size_t)layer * 256 * 1024;
    for (int e = F.lane; e < 4096; e += 64) { const int k = e >> 2, n = e & 3; d[n * 1024 + k] = (bf16_t)f2bf(w[e]); }
}
DI void dense_weight_items_l0(Frame& F, LAS float* scr, int wrank, int nwrank) {
    constexpr int N0 = 16 * 72, N1 = 16 * 32, N7 = 16;
    constexpr int NIT = N0 + N1 + N7 + 1;
    for (int it = wrank; it < NIT; it += nwrank) {
        int r = it;
        if (r < N0) { tr_item(F.in_(I_EWIN), 1024, 2304, (bf16_t*)(F.ws + WS_WIN0), scr, r, F.lane, [](int c) { return map_win0(c); }); continue; } r -= N0;
        if (r < N1) { tr_item(F.in_(I_EWOUT), 1024, 1024, (bf16_t*)(F.ws + WS_WOUT0), scr, r, F.lane, [](int c) { return c; }); continue; } r -= N1;
        if (r < N7) { tr_item(F.in_(I_WRE), 1024, 32, (bf16_t*)(F.ws + WS_WR), scr, r, F.lane, [](int c) { return 4 + c; }); continue; }
        router_rg_item(F, 0);
    }
}
DI void dense_weight_items_l1(Frame& F, LAS float* scr, int wrank, int nwrank) {
    constexpr int N2 = 16 * 29, N3 = 4 * 24, N4 = 2 * 32, N5 = 8 * 16, N6 = 16 * 32, N8 = 16;
    constexpr int NIT = N2 + N3 + N4 + N5 + N6 + N8 + 1;
    for (int it = wrank; it < NIT; it += nwrank) {
        int r = it;
        if (r < N2) { tr_item(F.in_(I_OWIN), 1024, 928, (bf16_t*)(F.ws + WS_WIN1), scr, r, F.lane, [](int c) { return map_win1(c); }); continue; } r -= N2;
        if (r < N3) { tr_item(F.in_(I_WUQ), 256, 768, (bf16_t*)(F.ws + WS_WUQ), scr, r, F.lane, [](int c) { return map_wuq(c); }, F.in_(I_QNG)); continue; } r -= N3;
        if (r < N4) { tr_item(F.in_(I_WUKV), 128, 1024, (bf16_t*)(F.ws + WS_WUKV), scr, r, F.lane, [](int c) { return map_wukv(c); }, F.in_(I_KVNG)); continue; } r -= N4;
        if (r < N5) { tr_item(F.in_(I_GLUW), 512, 512, (bf16_t*)(F.ws + WS_WGLU), scr, r, F.lane, [](int c) { return c; }); continue; } r -= N5;
        if (r < N6) { tr_item(F.in_(I_OWOUT), 1024, 1024, (bf16_t*)(F.ws + WS_WOUT1), scr, r, F.lane, [](int c) { return c; }); continue; } r -= N6;
        if (r < N8) { tr_item(F.in_(I_WRE) + 1024 * 32, 1024, 32, (bf16_t*)(F.ws + WS_WR) + 256 * 1024, scr, r, F.lane, [](int c) { return 4 + c; }); continue; }
        router_rg_item(F, 1);
    }
}

DI void mod_block(Frame& F) {
    const int bx = bid_(); if (bx >= 192) return;
    const int layer = bx / 96, cg = bx % 96;
    LAS float* sc = (LAS float*)F.lds;
    LAS float* red = (LAS float*)(F.lds + 17 * 1024 * 4);
    const float* W = F.in_(I_WMOD) + (size_t)layer * 1024 * 6144 + cg * 64 + F.lane;
    const int kb = F.wave * 128;
    float wv[32];
#pragma unroll
    for (int j = 0; j < 32; ++j) wv[j] = W[(size_t)(kb + j) * 6144];
    for (int e = F.tid; e < 17 * 1024; e += NTHR) { const int b = e >> 10, k = e & 1023; const float v = b < 16 ? F.in_(I_C)[b * 1024 + k] : F.in_(I_CCTX)[k]; sc[e] = silu_f(v); }
    __syncthreads();
    float acc[17];
#pragma unroll
    for (int b = 0; b < 17; ++b) acc[b] = 0.f;
#pragma unroll 1
    for (int k0 = 0; k0 < 128; k0 += 32) { float wc[32];
#pragma unroll
        for (int j = 0; j < 32; ++j) wc[j] = wv[j];
        if (k0 + 32 < 128) {
#pragma unroll
            for (int j = 0; j < 32; ++j) wv[j] = W[(size_t)(kb + k0 + 32 + j) * 6144]; }
#pragma unroll
        for (int j = 0; j < 32; ++j)
#pragma unroll
            for (int b = 0; b < 17; ++b) acc[b] += sc[b * 1024 + kb + k0 + j] * wc[j]; }
#pragma unroll
    for (int b = 0; b < 17; ++b) red[(F.wave * 17 + b) * 64 + F.lane] = acc[b];
    __syncthreads();
    for (int e = F.tid; e < 17 * 64; e += NTHR) { const int b = e >> 6, l = e & 63; float s = 0.f;
#pragma unroll
        for (int w = 0; w < 8; ++w) s += red[(w * 17 + b) * 64 + l];
        const int col = cg * 64 + l; ((float*)(F.ws + WS_MODV))[((size_t)layer * 17 + b) * 6144 + col] = s + F.in_(I_BMOD)[layer * 6144 + col]; }
    __syncthreads();
}

DI float red2pi(float x) { const float k = rintf(x * 0.15915494309189535f); float r = fmaf(-k, 6.28318548202514648f, x); r = fmaf(-k, -1.7484556e-7f, r); return r * 0.15915494309189535f; }
DI float sin_hw(float x) { return __builtin_amdgcn_sinf(red2pi(x)); }
DI float cos_hw(float x) { return __builtin_amdgcn_cosf(red2pi(x)); }
DI void lds_addf(LAS float* p, float v) { (void)__hip_atomic_fetch_add(p, v, __ATOMIC_RELAXED, __HIP_MEMORY_SCOPE_WORKGROUP); }
DI void hyena_filter_block72(Frame& F) {
    const int bx = bid_(), tg = bx >> 3, cg = bx & 7, tid = F.tid, r = F.wave, hh = tid & 63;
    LAS float* w3s = (LAS float*)F.lds;
    LAS float* w2s = w3s + 16384;
    LAS float* bfs = w2s + 4096;
    LAS float* h1 = bfs + 192;
    LAS float* w1s = h1 + 4608;
    LAS float* zz = w1s + 2112;
    LAS float* h2t = w1s;
    LAS float* ost = w3s;
    LAS float* sums = h1;
    const float* w1 = F.in_(I_HW1); const float* w2 = F.in_(I_HW2); const float* w3 = F.in_(I_HW3);
    { f32x4 a3[8], a2[2], a1[2]; float ab = 0.f;
#pragma unroll
      for (int k = 0; k < 8; ++k) { const int idx = tid + 512 * k; a3[k] = *(const f32x4*)(w3 + (size_t)(idx >> 6) * 2048 + cg * 256 + (idx & 63) * 4); }
#pragma unroll
      for (int k = 0; k < 2; ++k) a2[k] = *(const f32x4*)(w2 + (tid + 512 * k) * 4);
      a1[0] = *(const f32x4*)(w1 + tid * 4); a1[1] = tid < 16 ? *(const f32x4*)(w1 + (512 + tid) * 4) : (f32x4){0.f, 0.f, 0.f, 0.f};
      if (tid < 192) ab = tid < 64 ? F.in_(I_HB1)[tid] : tid < 128 ? F.in_(I_HB2)[tid - 64] : F.in_(I_HFREQ)[tid - 128];
#pragma unroll 1
      for (int e = tid; e < 72 * 33; e += NTHR) { const int tt = e / 33, f = e % 33; const int n = tt < 64 ? 2048 : 256; const float t = (float)(tt < 64 ? tg * 64 + tt : tg * 8 + tt - 64); float v;
          if (f == 0) v = t / (float)(n - 1); else { const int kk = (f - 1) & 15; const float band = 1e-4f + (float)kk * ((15.f - 1e-4f) / 15.f); const float ang = (6.283185307179586f / (float)n) * t * band; v = (f <= 16) ? cos_hw(ang) : sin_hw(ang); }
          zz[tt * 36 + f] = v; }
#pragma unroll
      for (int k = 0; k < 8; ++k) *(LAS f32x4*)(w3s + (tid + 512 * k) * 4) = a3[k];
#pragma unroll
      for (int k = 0; k < 2; ++k) *(LAS f32x4*)(w2s + (tid + 512 * k) * 4) = a2[k];
      *(LAS f32x4*)(w1s + tid * 4) = a1[0]; if (tid < 16) *(LAS f32x4*)(w1s + (512 + tid) * 4) = a1[1];
      if (tid < 192) bfs[tid] = ab; }
    __syncthreads();
    { float s[9];
#pragma unroll
      for (int k = 0; k < 9; ++k) s[k] = bfs[hh];
#pragma unroll 2
      for (int f = 0; f < 32; f += 4) { const float wa = w1s[f * 64 + hh], wb = w1s[(f + 1) * 64 + hh], wc_ = w1s[(f + 2) * 64 + hh], wd = w1s[(f + 3) * 64 + hh];
#pragma unroll
          for (int k = 0; k < 9; ++k) { const f32x4 z = *(const LAS f32x4*)(zz + (r + 8 * k) * 36 + f); s[k] += z.x * wa + z.y * wb + z.z * wc_ + z.w * wd; } }
      { const float w = w1s[32 * 64 + hh];
#pragma unroll
        for (int k = 0; k < 9; ++k) s[k] += zz[(r + 8 * k) * 36 + 32] * w; }
#pragma unroll
      for (int k = 0; k < 9; ++k) h1[(r + 8 * k) * 64 + hh] = s[k];
      const float fq_ = bfs[128 + hh];
#pragma unroll 1
      for (int k = 0; k < 9; ++k) { LAS float* q = h1 + (r + 8 * k) * 64 + hh; *q = sin_hw(fq_ * *q); } }
    __syncthreads();
    { float s[9];
#pragma unroll
      for (int k = 0; k < 9; ++k) s[k] = bfs[64 + hh];
#pragma unroll 2
      for (int f = 0; f < 64; f += 4) { const float wa = w2s[f * 64 + hh], wb = w2s[(f + 1) * 64 + hh], wc_ = w2s[(f + 2) * 64 + hh], wd = w2s[(f + 3) * 64 + hh];
#pragma unroll
          for (int k = 0; k < 9; ++k) { const f32x4 z = *(const LAS f32x4*)(h1 + (r + 8 * k) * 64 + f); s[k] += z.x * wa + z.y * wb + z.z * wc_ + z.w * wd; } }
      __syncthreads();
      const float fq_ = bfs[128 + hh];
#pragma unroll
      for (int k = 0; k < 9; ++k) { const int tt = r + 8 * k; h2t[hh * 96 + (tt / 9) * 12 + tt % 9] = s[k]; }
#pragma unroll 1
      for (int k = 0; k < 9; ++k) { const int tt = r + 8 * k; LAS float* q = h2t + hh * 96 + (tt / 9) * 12 + tt % 9; *q = sin_hw(fq_ * *q); } }
    sums[tid] = 0.f;
    __syncthreads();
    const int c4 = tid & 63;
    f32x4 acc[9];
#pragma unroll
    for (int i = 0; i < 9; ++i) acc[i] = (f32x4){0.f, 0.f, 0.f, 0.f};
#pragma unroll 2
    for (int h = 0; h < 64; ++h) { const f32x4 wv = *(const LAS f32x4*)(w3s + h * 256 + c4 * 4);
        const f32x4 ha = *(const LAS f32x4*)(h2t + h * 96 + r * 12), hb = *(const LAS f32x4*)(h2t + h * 96 + r * 12 + 4); const float hc = h2t[h * 96 + r * 12 + 8];
        acc[0] += wv * ha.x; acc[1] += wv * ha.y; acc[2] += wv * ha.z; acc[3] += wv * ha.w; acc[4] += wv * hb.x; acc[5] += wv * hb.y; acc[6] += wv * hb.z; acc[7] += wv * hb.w; acc[8] += wv * hc; }
    __syncthreads();
    const int dir = cg >> 2, o = (cg >> 1) & 1, cb = (cg & 1) * 256;
    const float dmin = 3.0701134573253945f, dmax = 15.350567286626973f;
    { f32x4 ssl = (f32x4){0.f, 0.f, 0.f, 0.f}, ssc = (f32x4){0.f, 0.f, 0.f, 0.f};
#pragma unroll
      for (int i = 0; i < 9; ++i) { const int tt = r * 9 + i; const bool lat = tt < 64; const int n = lat ? 2048 : 256; const int t = lat ? tg * 64 + tt : tg * 8 + tt - 64; const float tn = (float)t / (float)(n - 1);
          const bool live = !(dir == 1 && t == 0);
#pragma unroll
          for (int q = 0; q < 4; ++q) { const float delta = dmin + (float)(cb + c4 * 4 + q) * ((dmax - dmin) / 511.f); const float v = live ? acc[i][q] * __expf(-tn * delta) : 0.f;
              ost[(c4 * 4 + q) * 73 + tt] = v; if (lat) ssl[q] += v * v; else ssc[q] += v * v; } }
#pragma unroll
      for (int q = 0; q < 4; ++q) { lds_addf(sums + c4 * 4 + q, ssl[q]); if (r == 7) lds_addf(sums + 256 + c4 * 4 + q, ssc[q]); } }
    __syncthreads();
    { float* graw = (float*)(F.ws + WS_GRAW); float* grawc = (float*)(F.ws + WS_GRAWC); const int lane = tid & 63;
#pragma unroll 4
      for (int jj = 0; jj < 32; ++jj) { const int j = r * 32 + jj; const int t = tg * 64 + lane; float* gp = graw + ((size_t)o * 512 + cb + j) * 4096; const float v = ost[j * 73 + lane];
          if (dir == 0) gp[2048 - t] = v; else if (t > 0) gp[2048 + t] = v; }
#pragma unroll
      for (int k = 0; k < 4; ++k) { const int j = r * 32 + k * 8 + (lane >> 3), i = lane & 7; const int t = tg * 8 + i; float* gp = grawc + ((size_t)o * 512 + cb + j) * 512; const float v = ost[j * 73 + 64 + i];
          if (dir == 0) gp[256 - t] = v; else if (t > 0) gp[256 + t] = v; }
      if (tid < 256) ((float*)(F.ws + WS_HYPART))[(size_t)tg * 2048 + cg * 256 + tid] = sums[tid];
      else ((float*)(F.ws + WS_HYPARTC))[(size_t)tg * 2048 + cg * 256 + tid - 256] = sums[tid];
      if (tg == 0 && dir == 0 && tid < 256) { graw[((size_t)o * 512 + cb + tid) * 4096] = 0.f; grawc[((size_t)o * 512 + cb + tid) * 512] = 0.f; } }
    __syncthreads();
}

DI void s5_ktab_block(Frame& F) {
    const int bx = bid_(), g = bx >> 3, d = bx & 1, m0 = ((bx >> 1) & 3) * 8;
    LAS float* par = (LAS float*)F.lds;
    LAS float* bb = par + 256;
    LAS float* cc = bb + 2048;
    LAS float* lam = cc + 2048;
    const int dg = d * 32 + g;
    if (F.tid < 64) { const int p = F.tid; const float are = F.in_(I_SARE)[dg * 64 + p], aim = F.in_(I_SAIM)[dg * 64 + p]; const float dt = __expf(F.in_(I_SLDT)[dg]);
        const float lr = are * dt, th = aim * dt; float sn, cs; sincosf(th, &sn, &cs); const float em1 = expm1f(lr); const float sh = sinf(0.5f * th);
        const float er = em1 * cs - 2.f * sh * sh, ei = (em1 + 1.f) * sn; const float den = are * are + aim * aim;
        const float cor = (er * are + ei * aim) / den, coi = (ei * are - er * aim) / den;
        par[p * 4 + 0] = lr; par[p * 4 + 1] = th; par[p * 4 + 2] = cor; par[p * 4 + 3] = coi;
        if (m0 == 0) *(f32x4*)((float*)(F.ws + WS_S5PAR) + (size_t)(dg * 64 + p) * 4) = (f32x4){lr, th, cor, coi}; }
    __syncthreads();
    for (int e = F.tid; e < 1024; e += NTHR) { const int p = e >> 4, hi = e & 15; const float br = F.in_(I_SBRE)[(size_t)(dg * 64 + p) * 16 + hi], bi = F.in_(I_SBIM)[(size_t)(dg * 64 + p) * 16 + hi];
        const float cor = par[p * 4 + 2], coi = par[p * 4 + 3]; bb[e * 2] = cor * br - coi * bi; bb[e * 2 + 1] = cor * bi + coi * br; }
    for (int e = F.tid; e < 1024; e += NTHR) { const int ho = e >> 6, p = e & 63; cc[e * 2] = F.in_(I_SCRE)[(size_t)(dg * 16 + ho) * 64 + p]; cc[e * 2 + 1] = F.in_(I_SCIM)[(size_t)(dg * 16 + ho) * 64 + p]; }
    { const int ml = F.tid >> 6, p = F.tid & 63; const float m = (float)(m0 + ml); const float mg = __expf(m * par[p * 4]); float sn, cs; sincosf(m * par[p * 4 + 1], &sn, &cs); lam[F.tid * 2] = mg * cs; lam[F.tid * 2 + 1] = mg * sn; }
    __syncthreads();
    float* kt = (float*)(F.ws + WS_KTAB) + ((size_t)dg * 32 + m0) * 256;
    for (int e = F.tid; e < 2048; e += NTHR) { const int ml = e >> 8, ho = (e >> 4) & 15, hi = e & 15; float s = 0.f;
        for (int p = 0; p < 64; ++p) { const float lr = lam[(ml * 64 + p) * 2], li = lam[(ml * 64 + p) * 2 + 1], br = bb[(p * 16 + hi) * 2], bi = bb[(p * 16 + hi) * 2 + 1];
            const float wr_ = lr * br - li * bi, wi_ = lr * bi + li * br; s += cc[(ho * 64 + p) * 2] * wr_ - cc[(ho * 64 + p) * 2 + 1] * wi_; }
        kt[e] = s; }
    __syncthreads();
}

DI void rope_table1(Frame& F, int gt, int NG) {
    f32x2* r1 = (f32x2*)(F.ws + WS_ROPE1);
    for (int e = gt; e < 2048 * 16; e += NG) { const int p = e >> 4, g = (e >> 3) & 1, i = e & 7; const float pos = (float)(g ? (p & 63) : (p >> 6)); const float fr = exp2f(-(float)i * (13.287712379549449f / 8.f)); float sn, cs; sincosf(pos * fr, &sn, &cs); r1[e] = (f32x2){cs, sn}; }
}
DI void rope_tables(Frame& F) {
    const int gt = bid_() * NTHR + F.tid, NG = gdim_() * NTHR;
    f32x2* r0 = (f32x2*)(F.ws + WS_ROPE0);
    for (int e = gt; e < 2048 * 32; e += NG) { const int p = e >> 5, g = (e >> 4) & 1, i = e & 15; const float pos = (float)(g ? (p & 63) : (p >> 6)); const float fr = exp2f(-(float)i * (13.287712379549449f / 16.f)); float sn, cs; sincosf(pos * fr, &sn, &cs); r0[e] = (f32x2){cs, sn}; }
}

DI void p0_compute_part(Frame& F) {
    hyena_filter_block72(F);
#if PROBE_HF > 1
    hyena_filter_block72(F);
#endif
    s5_ktab_block(F);
#if PROBE_KT > 1
    s5_ktab_block(F);
#endif
    rope_tables(F);
}
DI void p0_weight_part(Frame& F) {
    __syncthreads();
    LAS float* scr = (LAS float*)(F.lds + F.wave * 16384);
    dense_weight_items_l0(F, scr, F.gw, F.NGW);
#if !MOE0_IN_P4
    moe_weight_items(F, 0, scr, F.gw, F.NGW);
#endif
    __syncthreads();
}

DI void normf_items(Frame& F, int gt) {
    if (gt < 2048) { const int seg = gt >> 10, oc = gt & 1023; const float* part = (const float*)(F.ws + (seg ? WS_HYPARTC : WS_HYPART)); float s = 0.f;
        for (int b = 0; b < 256; ++b) s += part[(size_t)b * 2048 + oc] + part[(size_t)b * 2048 + 1024 + oc];
        ((float*)(F.ws + WS_NORMF))[gt] = 1.f / sqrtf(s + EPS); }
}
DI void s5_expand(Frame& F, int gt, int NG) {
    const float* ktab = (const float*)(F.ws + WS_KTAB); const f32x4* par = (const f32x4*)(F.ws + WS_S5PAR);
    bf16_t* SA = (bf16_t*)(F.ws + WS_S5A); bf16_t* SW = (bf16_t*)(F.ws + WS_S5W);
    for (int it = gt; it < 32 * 512 * 96; it += NG) {
        const int g = it / (512 * 96), rem = it % (512 * 96), row = rem / 96, c8 = (rem % 96) * 8; const int k = row >> 4, ho = row & 15;
        float v[8];
        if (c8 < 512) { const int j = c8 >> 4, hi0 = c8 & 15;
            if (k > j) { const float* kp = ktab + (((size_t)(0 * 32 + g) * 32 + (k - j)) * 16 + ho) * 16 + hi0;
#pragma unroll
                for (int e = 0; e < 8; ++e) v[e] = kp[e]; }
            else if (k < j) { const float* kp = ktab + (((size_t)(1 * 32 + g) * 32 + (j - k)) * 16 + ho) * 16 + hi0;
#pragma unroll
                for (int e = 0; e < 8; ++e) v[e] = kp[e]; }
            else { const float* k0 = ktab + (((size_t)(0 * 32 + g) * 32) * 16 + ho) * 16 + hi0; const float* k1 = ktab + (((size_t)(1 * 32 + g) * 32) * 16 + ho) * 16 + hi0; const float dsk = F.in_(I_SD)[g * 16 + ho];
#pragma unroll
                for (int e = 0; e < 8; ++e) v[e] = k0[e] + k1[e] + ((hi0 + e) == ho ? dsk : 0.f); }
        } else { const int cc = c8 - 512, d = cc >> 7, im = (cc >> 6) & 1, p0 = cc & 63; const int dg = d * 32 + g; const float pw = d == 0 ? (float)(k + 1) : (float)(32 - k);
#pragma unroll
            for (int e = 0; e < 8; ++e) { const int p = p0 + e; const f32x4 pr = par[dg * 64 + p]; const float mg = __expf(pw * pr.x); float sn, cs; sincosf(pw * pr.y, &sn, &cs); const float lr = mg * cs, li = mg * sn;
                const float cr = F.in_(I_SCRE)[(size_t)(dg * 16 + ho) * 64 + p], ci = F.in_(I_SCIM)[(size_t)(dg * 16 + ho) * 64 + p];
                v[e] = im ? -(cr * li + ci * lr) : (cr * lr - ci * li); }
        }
        u32x4 o; o.x = pk2(v[0], v[1]); o.y = pk2(v[2], v[3]); o.z = pk2(v[4], v[5]); o.w = pk2(v[6], v[7]);
        *(u32x4*)(SA + ((size_t)g * 512 + row) * 768 + c8) = o;
    }
    for (int it = gt; it < 32 * 256 * 64; it += NG) {
        const int g = it / (256 * 64), rem = it % (256 * 64), n = rem >> 6, c8 = (rem & 63) * 8; const int d = n >> 7, im = (n >> 6) & 1, p = n & 63, j = c8 >> 4, hi0 = c8 & 15; const int dg = d * 32 + g;
        const f32x4 pr = par[dg * 64 + p]; const float pw = d == 0 ? (float)(31 - j) : (float)j; const float mg = __expf(pw * pr.x); float sn, cs; sincosf(pw * pr.y, &sn, &cs); const float lr = mg * cs, li = mg * sn;
        float v[8];
#pragma unroll
        for (int e = 0; e < 8; ++e) { const float br = F.in_(I_SBRE)[(size_t)(dg * 64 + p) * 16 + hi0 + e], bi = F.in_(I_SBIM)[(size_t)(dg * 64 + p) * 16 + hi0 + e];
            const float Br = pr.z * br - pr.w * bi, Bi = pr.z * bi + pr.w * br; v[e] = im ? (lr * Bi + li * Br) : (lr * Br - li * Bi); }
        u32x4 o; o.x = pk2(v[0], v[1]); o.y = pk2(v[2], v[3]); o.z = pk2(v[4], v[5]); o.w = pk2(v[6], v[7]);
        *(u32x4*)(SW + ((size_t)g * 256 + n) * 512 + c8) = o;
    }
}
#define MFMA16(a, b, c) __builtin_amdgcn_mfma_f32_16x16x32_bf16((a), (b), (c), 0, 0, 0)
#define MFMA32(a, b, c) __builtin_amdgcn_mfma_f32_32x32x16_bf16((a), (b), (c), 0, 0, 0)
DI int lds_add(LAS int* p, int v) { return __hip_atomic_fetch_add(p, v, __ATOMIC_RELAXED, __HIP_MEMORY_SCOPE_WORKGROUP); }
DI int lat_row(int tl) { return (tl >> 11) * LT + CTX + (tl & 2047); }

template <int RPW = 3>
DI void modnorm_phase(Frame& F, int layer, int which, bool lat_only, const float* lat, const float* ctx, bf16_t* H) {
    const float* ng = F.in_(I_NORMG) + (layer * 2 + which) * 1024; const float* mv = (const float*)(F.ws + WS_MODV) + (size_t)layer * 17 * 6144 + (which ? 3072 : 0);
    const int nrows = lat_only ? NB * SEQ : T;
    f32x4 g4[4];
#pragma unroll
    for (int j = 0; j < 4; ++j) g4[j] = *(const f32x4*)(ng + 4 * F.lane + 256 * j);
    for (int i0 = F.gw; i0 < nrows; i0 += RPW * F.NGW) {
        f32x4 v[RPW][4]; const float* mrow[RPW]; int rr[RPW];
#pragma unroll
        for (int u = 0; u < RPW; ++u) { const int i = i0 + u * F.NGW; const int ic = i < nrows ? i : i0;
            const int r = lat_only ? lat_row(ic) : ic; const int b = r / LT, pos = r % LT; const bool isc = pos < CTX; rr[u] = i < nrows ? r : -1;
            const float* src = isc ? ctx + (size_t)(b * CTX + pos) * DM : lat + (size_t)(b * SEQ + pos - CTX) * DM; mrow[u] = mv + (isc ? 16 : b) * 6144;
#pragma unroll
            for (int j = 0; j < 4; ++j) v[u][j] = *(const f32x4*)(src + 4 * F.lane + 256 * j); }
#pragma unroll
        for (int u = 0; u < RPW; ++u) { float ss = 0.f;
#pragma unroll
            for (int j = 0; j < 4; ++j) ss += (v[u][j].x * v[u][j].x + v[u][j].y * v[u][j].y) + (v[u][j].z * v[u][j].z + v[u][j].w * v[u][j].w);
            const float rstd = 1.f / sqrtf(wave_sum(ss) * (1.f / DM) + EPS);
            if (rr[u] >= 0) {
#pragma unroll
                for (int j = 0; j < 4; ++j) { const f32x4 sh = *(const f32x4*)(mrow[u] + 4 * F.lane + 256 * j), sc = *(const f32x4*)(mrow[u] + 1024 + 4 * F.lane + 256 * j);
                    const f32x4 y = v[u][j] * rstd * g4[j] * (sc + 1.f) + sh;
                    *(u32x2*)(H + (size_t)rr[u] * DM + 4 * F.lane + 256 * j) = (u32x2){pk2(y.x, y.y), pk2(y.z, y.w)}; } } }
    }
}

template <bool FINAL>
DI void combine_phase(Frame& F, int layer, bf16_t* XS, float* out, const bf16_t* Y2, bf16_t* H) {
    const float* mvg = (const float*)(F.ws + WS_MODV) + (size_t)layer * 17 * 6144 + 5120;
    const float* mvn = (const float*)(F.ws + WS_MODV) + (size_t)(layer + 1) * 17 * 6144;
    const float* ng = FINAL ? F.in_(I_FINALG) : F.in_(I_NORMG) + ((layer + 1) * 2) * 1024;
    const int nrows = FINAL ? NB * SEQ : T;
    const LAS int* ttab = (const LAS int*)(F.lds + LDS_TAB_OFF);
    f32x4 g4[4];
#pragma unroll
    for (int j = 0; j < 4; ++j) g4[j] = *(const f32x4*)(ng + 4 * F.lane + 256 * j);
    for (int i0 = F.gw; i0 < nrows; i0 += 2 * F.NGW) {
        u32x2 xv[2][4], ya[2][4], yb[2][4]; int rr[2], mb[2], rc[2];
#pragma unroll
        for (int u = 0; u < 2; ++u) { const int i = i0 + u * F.NGW; const int ic = i < nrows ? i : i0;
            const int r = FINAL ? lat_row(ic) : ic; const int b = r / LT, pos = r % LT; rr[u] = i < nrows ? r : -1; rc[u] = r; mb[u] = pos < CTX ? 16 : b;
            const int* tp = (const int*)(F.ws + WS_TOKPOS) + (size_t)r * 2; const int t0 = tp[0], t1 = tp[1];
            const bf16_t* px = XS + (size_t)r * DM; const bf16_t* pa = Y2 + (size_t)(256 * ttab[432 + (t0 >> 16)] + (t0 & 0xffff)) * DM; const bf16_t* pb = Y2 + (size_t)(256 * ttab[432 + (t1 >> 16)] + (t1 & 0xffff)) * DM;
#pragma unroll
            for (int j = 0; j < 4; ++j) { const int c = 4 * F.lane + 256 * j; xv[u][j] = *(const u32x2*)(px + c); ya[u][j] = *(const u32x2*)(pa + c); yb[u][j] = *(const u32x2*)(pb + c); } }
#pragma unroll
        for (int u = 0; u < 2; ++u) { const float* grow = mvg + mb[u] * 6144; f32x4 v[4]; float ss = 0.f;
#pragma unroll
            for (int j = 0; j < 4; ++j) { const int c = 4 * F.lane + 256 * j; const f32x4 g = *(const f32x4*)(grow + c); const u32x2 a = ya[u][j], bb = yb[u][j], xx = xv[u][j];
                f32x4 m; m.x = bflo(a.x) + bflo(bb.x); m.y = bfhi(a.x) + bfhi(bb.x); m.z = bflo(a.y) + bflo(bb.y); m.w = bfhi(a.y) + bfhi(bb.y);
                const f32x4 x = {bflo(xx.x), bfhi(xx.x), bflo(xx.y), bfhi(xx.y)};
                v[j] = x + g * m; ss += (v[j].x * v[j].x + v[j].y * v[j].y) + (v[j].z * v[j].z + v[j].w * v[j].w); }
            const float rstd = 1.f / sqrtf(wave_sum(ss) * (1.f / DM) + EPS);
            if (rr[u] >= 0) {
                if (FINAL) { const int r = rc[u]; float* orow = out + (size_t)((r / LT) * SEQ + (r % LT) - CTX) * DM;
#pragma unroll
                    for (int j = 0; j < 4; ++j) *(f32x4*)(orow + 4 * F.lane + 256 * j) = v[j] * rstd * g4[j];
                } else {
                    const float* mrow = mvn + mb[u] * 6144; bf16_t* px = XS + (size_t)rc[u] * DM;
#pragma unroll
                    for (int j = 0; j < 4; ++j) { const int c = 4 * F.lane + 256 * j; *(u32x2*)(px + c) = (u32x2){pk2(v[j].x, v[j].y), pk2(v[j].z, v[j].w)};
                        const f32x4 sh = *(const f32x4*)(mrow + c), sc = *(const f32x4*)(mrow + 1024 + c); const f32x4 y = v[j] * rstd * g4[j] * (sc + 1.f) + sh;
                        *(u32x2*)(H + (size_t)rc[u] * DM + c) = (u32x2){pk2(y.x, y.y), pk2(y.z, y.w)}; }
                } } }
    }
}

#ifndef PROBE_NOROUTE
#define PROBE_NOROUTE 0
#endif
DI void norm2_route_phase(Frame& F, int layer, bool lat_only, const bf16_t* XS, bf16_t* H, bool dry = false) {
    int tid_ = F.tid; asm volatile("" : "+v"(tid_));
    const int tid = tid_, w = __builtin_amdgcn_readfirstlane(tid_ >> 6), l = tid_ & 63, r16 = l & 15, kq = l >> 4;
    LAS float* ssp = (LAS float*)F.lds;
    LAS float* lgp = ssp + 128;
    LAS float* lgs = lgp + 8 * 16 * 48;
    LAS int* hist = (LAS int*)(lgs + 16 * 49);
    LAS int* rbase = hist + 32;
    LAS int* lk = hist + 64;
    LAS float* lw = (LAS float*)(lk + 320);
    if (tid < 32) hist[tid] = 0;
    const int kb = 128 * w + 4 * kq;
    bf16x8 wf[3][4];
    { const bf16_t* WR = (const bf16_t*)(F.ws + WS_WR) + (size_t)layer * 256 * 1024 + kb;
#pragma unroll
      for (int cb = 0; cb < 3; ++cb)
#pragma unroll
          for (int s2 = 0; s2 < 4; ++s2) { const bf16_t* p = WR + (size_t)(16 * cb + r16) * 1024 + 32 * s2; const u32x2 b0 = *(const u32x2*)p, b1 = *(const u32x2*)(p + 16);
              wf[cb][s2] = __builtin_bit_cast(bf16x8, (u32x4){b0.x, b0.y, b1.x, b1.y}); } }
    f32x4 gq[4][2];
    { const float* ng = F.in_(I_NORMG) + (layer * 2 + 1) * 1024 + kb;
#pragma unroll
      for (int s2 = 0; s2 < 4; ++s2) { gq[s2][0] = *(const f32x4*)(ng + 32 * s2); gq[s2][1] = *(const f32x4*)(ng + 32 * s2 + 16); } }
    const float* mv = (const float*)(F.ws + WS_MODV) + (size_t)layer * 17 * 6144 + 3072 + kb;
    const int ngroups = (lat_only ? NB * SEQ : T) / 16, G = gdim_(), per = (ngroups + G - 1) / G;
    const int g_lo = bid_() * per, g_hi = (g_lo + per < ngroups) ? g_lo + per : ngroups;
    u32x2 xn[4][2];
    int gi = g_lo;
    if (gi < g_hi) { const int r0 = lat_only ? lat_row(gi * 16) : gi * 16; const bf16_t* xr = XS + (size_t)(r0 + r16) * DM + kb;
#pragma unroll
        for (int s2 = 0; s2 < 4; ++s2) { xn[s2][0] = *(const u32x2*)(xr + 32 * s2); xn[s2][1] = *(const u32x2*)(xr + 32 * s2 + 16); } }
    f32x4 gsv[4][2], shv[4][2]; int cur_m = -1;
    __syncthreads();
#pragma unroll 1
    for (; gi < g_hi; ++gi) {
        const int r0 = lat_only ? lat_row(gi * 16) : gi * 16; const int b = r0 / LT; const bool isc = (r0 % LT) < CTX; const int mi = isc ? 16 : b;
        u32x2 xc[4][2];
#pragma unroll
        for (int s2 = 0; s2 < 4; ++s2) { xc[s2][0] = xn[s2][0]; xc[s2][1] = xn[s2][1]; }
        if (gi + 1 < g_hi) { const int r1 = lat_only ? lat_row((gi + 1) * 16) : (gi + 1) * 16; const bf16_t* xr = XS + (size_t)(r1 + r16) * DM + kb;
#pragma unroll
            for (int s2 = 0; s2 < 4; ++s2) { xn[s2][0] = *(const u32x2*)(xr + 32 * s2); xn[s2][1] = *(const u32x2*)(xr + 32 * s2 + 16); } }
        if (mi != cur_m) { cur_m = mi; const float* mrow = mv + mi * 6144;
#pragma unroll
            for (int s2 = 0; s2 < 4; ++s2)
#pragma unroll
                for (int q = 0; q < 2; ++q) { const f32x4 sc = *(const f32x4*)(mrow + 1024 + 32 * s2 + 16 * q); shv[s2][q] = *(const f32x4*)(mrow + 32 * s2 + 16 * q); gsv[s2][q] = gq[s2][q] * (sc + 1.f); } }
        f32x4 xv[4][2]; float ss = 0.f;
#pragma unroll
        for (int s2 = 0; s2 < 4; ++s2)
#pragma unroll
            for (int q = 0; q < 2; ++q) { const u32x2 v = xc[s2][q]; xv[s2][q] = (f32x4){bflo(v.x), bfhi(v.x), bflo(v.y), bfhi(v.y)};
                ss += (xv[s2][q].x * xv[s2][q].x + xv[s2][q].y * xv[s2][q].y) + (xv[s2][q].z * xv[s2][q].z + xv[s2][q].w * xv[s2][q].w); }
        ss += __shfl_xor(ss, 16); ss += __shfl_xor(ss, 32);
        if (kq == 0) ssp[w * 16 + r16] = ss;
        __syncthreads();
        float tot = 0.f;
#pragma unroll
        for (int q = 0; q < 8; ++q) tot += ssp[q * 16 + r16];
        const float rstd = 1.f / sqrtf(tot * (1.f / DM) + EPS);
        f32x4 acc[3];
#pragma unroll
        for (int cb = 0; cb < 3; ++cb) acc[cb] = (f32x4){0.f, 0.f, 0.f, 0.f};
        bf16_t* hrow = H + (size_t)(r0 + r16) * DM + kb;
#pragma unroll
        for (int s2 = 0; s2 < 4; ++s2) { const int c0 = 32 * s2;
            const f32x4 y0 = xv[s2][0] * rstd * gsv[s2][0] + shv[s2][0], y1 = xv[s2][1] * rstd * gsv[s2][1] + shv[s2][1];
            const u32x4 hv = pack8(y0, y1);
            *(u32x2*)(hrow + c0) = (u32x2){hv.x, hv.y}; *(u32x2*)(hrow + c0 + 16) = (u32x2){hv.z, hv.w};
            const bf16x8 af = __builtin_bit_cast(bf16x8, hv);
#pragma unroll
            for (int cb = 0; cb < 3; ++cb) acc[cb] = MFMA16(af, wf[cb][s2], acc[cb]); }
#pragma unroll
        for (int cb = 0; cb < 3; ++cb)
#pragma unroll
            for (int i = 0; i < 4; ++i) lgp[(w * 16 + 4 * kq + i) * 48 + 16 * cb + r16] = acc[cb][i];
        __syncthreads();
        { const int row = tid >> 5, col = tid & 31; float a0 = 0.f, a1 = 0.f;
#pragma unroll
          for (int q = 0; q < 8; ++q) { a0 += lgp[(q * 16 + row) * 48 + col]; if (col < 4) a1 += lgp[(q * 16 + row) * 48 + 32 + col]; }
          lgs[row * 49 + col] = a0; if (col < 4) lgs[row * 49 + 32 + col] = a1; }
        __syncthreads();
        if (tid < 16 && !(dry && PROBE_NOROUTE)) {
            const int r = r0 + tid; const LAS float* lg = lgs + tid * 49;
            int gidx = 0; float gm = lg[0];
#pragma unroll
            for (int q = 1; q < 4; ++q) if (lg[q] > gm) { gm = lg[q]; gidx = q; }
            const float gp = 1.f / (__expf(lg[0] - gm) + __expf(lg[1] - gm) + __expf(lg[2] - gm) + __expf(lg[3] - gm));
            const LAS float* ev = lg + 4 + 8 * gidx;
            int i1 = 0; float l1 = ev[0];
#pragma unroll
            for (int q = 1; q < 8; ++q) if (ev[q] > l1) { l1 = ev[q]; i1 = q; }
            int i2 = -1; float l2 = -3.0e38f;
#pragma unroll
            for (int q = 0; q < 8; ++q) if (q != i1 && ev[q] > l2) { l2 = ev[q]; i2 = q; }
            const float w1 = 1.f / (1.f + __expf(l2 - l1)), w2 = 1.f - w1;
            int* te = (int*)(F.ws + WS_TOKE) + (size_t)r * 2; float* tw = (float*)(F.ws + WS_TOKW) + (size_t)r * 2;
            if (!dry) { te[0] = 8 * gidx + i1; te[1] = 8 * gidx + i2; tw[0] = gp * w1; tw[1] = gp * w2;
                const int ka = lds_add(&hist[8 * gidx + i1], 1), kb_ = lds_add(&hist[8 * gidx + i2], 1); const int tl = (gi - g_lo) * 16 + tid;
                lk[2 * tl] = (8 * gidx + i1) | (ka << 8); lk[2 * tl + 1] = (8 * gidx + i2) | (kb_ << 8); lw[2 * tl] = gp * w1; lw[2 * tl + 1] = gp * w2; }
        }
    }
    __syncthreads();
    if (!dry && tid < 32) rbase[tid] = hist[tid] ? (int)atomicAdd(F.ctl + CW_CNT + layer * 256 + tid, (unsigned)hist[tid]) : 0;
    __syncthreads();
    if (!dry && g_lo < g_hi) { const int ntl = (g_hi - g_lo) * 16;
        if (tid < 2 * ntl) { const int tl = tid >> 1, k = tid & 1; const int gi_ = g_lo + (tl >> 4); const int r = (lat_only ? lat_row(gi_ * 16) : gi_ * 16) + (tl & 15);
            const int v = lk[tid]; const int e = v & 255, rank = rbase[e] + (v >> 8);
            ((int*)(F.ws + WS_RANKTOK))[(size_t)e * T + rank] = 2 * r + k; ((float*)(F.ws + WS_RANKW))[(size_t)e * T + rank] = lw[tid];
            ((int*)(F.ws + WS_TOKPOS))[(size_t)r * 2 + k] = (e << 16) | rank; } }
    __syncthreads();
}

DI void route_phase(Frame& F, int layer, bool lat_only) {
    LAS int* hist = (LAS int*)F.lds;
    if (F.tid < 32) hist[F.tid] = 0;
    __syncthreads();
    const int gt = bid_() * NTHR + F.tid; const int ntok = lat_only ? NB * SEQ : T;
    if (gt < ntok) {
        const int r = lat_only ? lat_row(gt) : gt; const float* lg = (const float*)(F.ws + WS_LOGIT) + (size_t)r * 64;
        const f32x4 gl = *(const f32x4*)lg; int gi = 0; float gm = gl.x;
        if (gl.y > gm) { gm = gl.y; gi = 1; } if (gl.z > gm) { gm = gl.z; gi = 2; } if (gl.w > gm) { gm = gl.w; gi = 3; }
        const float gp = 1.f / (__expf(gl.x - gm) + __expf(gl.y - gm) + __expf(gl.z - gm) + __expf(gl.w - gm));
        const f32x4 e0 = *(const f32x4*)(lg + 4 + 8 * gi), e1 = *(const f32x4*)(lg + 8 + 8 * gi);
        const float ev[8] = {e0.x, e0.y, e0.z, e0.w, e1.x, e1.y, e1.z, e1.w};
        int i1 = 0; float l1 = ev[0];
#pragma unroll
        for (int i = 1; i < 8; ++i) if (ev[i] > l1) { l1 = ev[i]; i1 = i; }
        int i2 = -1; float l2 = -3.0e38f;
#pragma unroll
        for (int i = 0; i < 8; ++i) if (i != i1 && ev[i] > l2) { l2 = ev[i]; i2 = i; }
        const float w1 = 1.f / (1.f + __expf(l2 - l1)), w2 = 1.f - w1;
        int* te = (int*)(F.ws + WS_TOKE) + (size_t)r * 2; float* tw = (float*)(F.ws + WS_TOKW) + (size_t)r * 2;
        te[0] = 8 * gi + i1; te[1] = 8 * gi + i2; tw[0] = gp * w1; tw[1] = gp * w2;
        lds_add(&hist[8 * gi + i1], 1); lds_add(&hist[8 * gi + i2], 1);
    }
    __syncthreads();
    if (F.tid < 32 && hist[F.tid]) atomicAdd(F.ctl + CW_CNT + layer * 256 + F.tid, (unsigned)hist[F.tid]);
    __syncthreads();
}
DI void assign_phase(Frame& F, int layer, bool lat_only) {
    LAS int* hist = (LAS int*)F.lds; LAS int* offs = hist + 32; LAS int* base = hist + 64; LAS int* cnts = hist + 96;
    unsigned* cnt = F.ctl + CW_CNT + layer * 256; unsigned* cur = cnt + 128;
    if (F.tid < 32) { hist[F.tid] = 0; cnts[F.tid] = (int)__hip_atomic_load(cnt + F.tid, __ATOMIC_RELAXED, __HIP_MEMORY_SCOPE_AGENT); }
    __syncthreads();
    if (F.tid == 0) { int o = 0; for (int e = 0; e < 32; ++e) { offs[e] = o; o += (cnts[e] + 255) & ~255; } }
    const int gt = bid_() * NTHR + F.tid; const int ntok = lat_only ? NB * SEQ : T;
    int r = -1, e0 = 0, e1 = 0, k0 = 0, k1 = 0; float w0 = 0.f, w1 = 0.f;
    if (gt < ntok) { r = lat_only ? lat_row(gt) : gt; const int* te = (const int*)(F.ws + WS_TOKE) + (size_t)r * 2; const float* tw = (const float*)(F.ws + WS_TOKW) + (size_t)r * 2;
        e0 = te[0]; e1 = te[1]; w0 = tw[0]; w1 = tw[1]; k0 = lds_add(&hist[e0], 1); k1 = lds_add(&hist[e1], 1); }
    __syncthreads();
    if (F.tid < 32) base[F.tid] = hist[F.tid] ? (int)atomicAdd(cur + F.tid, (unsigned)hist[F.tid]) : 0;
    __syncthreads();
    int* rt = (int*)(F.ws + WS_ROWTOK); int* rd = (int*)(F.ws + WS_ROWDST); float* rw = (float*)(F.ws + WS_ROWW);
    if (r >= 0) { const int p0 = offs[e0] + base[e0] + k0, p1 = offs[e1] + base[e1] + k1;
        rt[p0] = r; rd[p0] = 2 * r; rw[p0] = w0; rt[p1] = r; rd[p1] = 2 * r + 1; rw[p1] = w1;
        int* tp = (int*)(F.ws + WS_TOKPOS) + (size_t)r * 2; tp[0] = p0; tp[1] = p1; }
    if (bid_() >= 128 && bid_() < 160) { const int e = bid_() - 128; const int lo = offs[e] + cnts[e], hi = offs[e] + ((cnts[e] + 255) & ~255);
        for (int p = lo + F.tid; p < hi; p += NTHR) { rt[p] = 0; rd[p] = -1; rw[p] = 0.f; } }
    __syncthreads();
}
DI const LAS int* moe_tile_table(Frame& F, int layer) {
    LAS int* tab = (LAS int*)(F.lds + LDS_TAB_OFF);
    __syncthreads();
    if (F.tid < 64) {
        const unsigned* cnt = F.ctl + CW_CNT + layer * 256; const int e = F.tid & 31;
        const int c = (int)__hip_atomic_load(cnt + e, __ATOMIC_RELAXED, __HIP_MEMORY_SCOPE_AGENT); const int nt = (c + 255) >> 8;
        int inc = nt;
#pragma unroll
        for (int o = 1; o < 32; o <<= 1) { const int v = __shfl_up(inc, o, 64); if ((F.tid & 31) >= o) inc += v; }
        if (F.tid < 32) { const int start = inc - nt; for (int i = 0; i < nt; ++i) tab[1 + start + i] = e | (i << 8); if (e == 31) tab[0] = inc; tab[400 + e] = c; tab[432 + e] = start; }
    }
    __syncthreads();
    return tab;
}

DI void l1_norm_phase(Frame& F) {
    bf16_t* CQ = (bf16_t*)(F.ws + WS_CQ); bf16_t* CKV = (bf16_t*)(F.ws + WS_CKV); bf16_t* KR = (bf16_t*)(F.ws + WS_KR);
    const f32x4 gq = *(const f32x4*)(F.in_(I_QNG) + 4 * F.lane); const f32x2 gk = *(const f32x2*)(F.in_(I_KVNG) + 2 * F.lane);
    const f32x2* rope = (const f32x2*)(F.ws + WS_ROPE1);
    const int g = (F.lane >> 3) & 1, i = F.lane & 7;
    for (int r0 = F.gw * 4; r0 < T; r0 += F.NGW * 4) {
        u32x2 a[4]; unsigned c[4]; unsigned short k0[4], k1[4];
#pragma unroll
        for (int u = 0; u < 4; ++u) { const int r = r0 + u; a[u] = *((const u32x2*)(CQ + (size_t)r * 256) + F.lane); c[u] = *((const unsigned*)(CKV + (size_t)r * 128) + F.lane);
            const bf16_t* kp = KR + (size_t)r * 32 + 16 * g + i; k0[u] = kp[0]; k1[u] = kp[8]; }
#pragma unroll
        for (int u = 0; u < 4; ++u) { const int r = r0 + u; const int pos = r % LT;
            { const float x0 = bflo(a[u].x), x1 = bfhi(a[u].x), x2 = bflo(a[u].y), x3 = bfhi(a[u].y);
              const float rstd = 1.f / sqrtf(wave_sum(x0 * x0 + x1 * x1 + x2 * x2 + x3 * x3) * (1.f / 256.f) + EPS);
              *((u32x2*)(CQ + (size_t)r * 256) + F.lane) = (u32x2){pk2(x0 * rstd * gq.x, x1 * rstd * gq.y), pk2(x2 * rstd * gq.z, x3 * rstd * gq.w)}; }
            { const float x0 = bflo(c[u]), x1 = bfhi(c[u]);
              const float rstd = 1.f / sqrtf(wave_sum(x0 * x0 + x1 * x1) * (1.f / 128.f) + EPS);
              *((unsigned*)(CKV + (size_t)r * 128) + F.lane) = pk2(x0 * rstd * gk.x, x1 * rstd * gk.y); }
            if (pos >= CTX && F.lane < 16) { bf16_t* kp = KR + (size_t)r * 32 + 16 * g + i;
                const float t1 = bf2f(k0[u]), t2 = bf2f(k1[u]); const f32x2 cs = rope[(size_t)(pos - CTX) * 16 + g * 8 + i];
                kp[0] = (bf16_t)f2bf(t1 * cs.x - t2 * cs.y); kp[8] = (bf16_t)f2bf(t1 * cs.y + t2 * cs.x); } }
    }
}

DI void s5_scan_phase(Frame& F) {
    const int gt = bid_() * NTHR + F.tid; if (gt >= 65536) return;
    const int p = gt & 63, d = (gt >> 6) & 1, b = (gt >> 7) & 15, g = gt >> 11;
    const f32x4 pr = ((const f32x4*)(F.ws + WS_S5PAR))[(d * 32 + g) * 64 + p];
    const float mg = __expf(32.f * pr.x); float sn, cs; sincosf(32.f * pr.y, &sn, &cs); const float lr = mg * cs, li = mg * sn;
    const float* S = (const float*)(F.ws + WS_S5S) + (size_t)g * 1280 * 256 + d * 128 + p; bf16_t* BM = (bf16_t*)(F.ws + WS_BMAT) + (size_t)g * 1280 * 768 + 512 + d * 128 + p;
    float xr = 0.f, xi = 0.f;
#pragma unroll 1
    for (int s0 = 0; s0 < 72; s0 += 24) {
        float sr[24], si[24];
#pragma unroll
        for (int q = 0; q < 24; ++q) { const int s = s0 + q; const int c = d == 0 ? s : (s < 8 ? 7 - s : 79 - s); const float* sp = S + (size_t)(c * 16 + b) * 256; sr[q] = sp[0]; si[q] = sp[64]; }
#pragma unroll
        for (int q = 0; q < 24; ++q) { const int s = s0 + q; const int c = d == 0 ? s : (s < 8 ? 7 - s : 79 - s); bf16_t* bp = BM + (size_t)(c * 16 + b) * 768;
            bp[0] = (bf16_t)f2bf(xr); bp[64] = (bf16_t)f2bf(xi);
            const float nr = lr * xr - li * xi + sr[q], ni = lr * xi + li * xr + si[q]; xr = nr; xi = ni; }
    }
}

template <bool CM, int PM = 0>
DI void hyena_unit(Frame& F, int c0) {
    constexpr int n = CM ? 256 : 2048, UP = n + 8, NCH = n / 8, GC = 2 * n + 8;
    int tid_ = F.tid; asm volatile("" : "+v"(tid_));
    const int w = __builtin_amdgcn_readfirstlane(tid_ >> 6), l = tid_ & 63, c = CM ? c0 + w : c0, seg0 = CM ? 0 : CTX, tw = CM ? 0 : 256 * w;
    LAS bf16_t* U = (LAS bf16_t*)F.lds + (CM ? w * (16 * UP) : 0);
    LAS bf16_t* G = (LAS bf16_t*)(F.lds + (CM ? 8 * 16 * UP * 2 : 16 * UP * 2)) + (CM ? w * (8 * GC) : 0);
    const bf16_t* HyT = (const bf16_t*)(F.ws + WS_HYT); bf16_t* HoT = (bf16_t*)(F.ws + WS_HOT);
    const float* cw = F.in_(I_HCW); const float* cb = F.in_(I_HCB);
    const float* grbase = (const float*)(F.ws + (CM ? WS_GRAWC : WS_GRAW)) + (size_t)c * (2 * n);
    const int j0 = (CM ? l : tid_) * 8;
    f32x4 gq[4];
#define HY_LOAD_FILTER(o_) do { const float* gr_ = grbase + (size_t)(o_) * 512 * (2 * n); \
        _Pragma("unroll") for (int q = 0; q < 4; ++q) { const int jj = (j0 + 4 * q) < 2 * n ? j0 + 4 * q : 0; gq[q] = *(const f32x4*)(gr_ + jj); } } while (0)
    HY_LOAD_FILTER(0);
    { const int ch = 1024 + c; const float w0 = cw[ch], w1 = cw[1536 + ch], w2 = cw[3072 + ch], bs = cb[ch];
      u32x4 raw[8]; unsigned short pvr[8], nvr[8];
#pragma unroll
      for (int i = 0; i < 8; ++i) { const int q = CM ? l + 64 * i : tid_ + 512 * i; const int b = q / NCH, s0 = (q % NCH) * 8;
          const bf16_t* src = HyT + (size_t)ch * T + b * LT + seg0;
          raw[i] = *(const u32x4*)(src + s0); pvr[i] = src[s0 > 0 ? s0 - 1 : 0]; nvr[i] = src[s0 + 8 < n ? s0 + 8 : n - 1]; }
#pragma unroll
      for (int i = 0; i < 8; ++i) { const int q = CM ? l + 64 * i : tid_ + 512 * i; const int b = q / NCH, s0 = (q % NCH) * 8;
          const float pv = s0 > 0 ? bf2f(pvr[i]) : 0.f, nv = s0 + 8 < n ? bf2f(nvr[i]) : 0.f;
          const float v[10] = {pv, bflo(raw[i].x), bfhi(raw[i].x), bflo(raw[i].y), bfhi(raw[i].y), bflo(raw[i].z), bfhi(raw[i].z), bflo(raw[i].w), bfhi(raw[i].w), nv};
          float o[8];
#pragma unroll
          for (int e = 0; e < 8; ++e) o[e] = w0 * v[e] + w1 * v[e + 1] + w2 * v[e + 2] + bs;
          *(LAS u32x4*)(U + b * UP + s0) = (u32x4){pk2(o[0], o[1]), pk2(o[2], o[3]), pk2(o[4], o[5]), pk2(o[6], o[7])}; } }
#pragma unroll 1
    for (int o = 0; o < 2; ++o) {
        int ll = l; asm volatile("" : "+v"(ll));
        const int lb = n + 8 * (ll >> 4) - (ll & 15);
        const int rr = lb & 7, gl = rr * GC + lb - rr;
        const int j0l = CM ? ll * 8 : (w * 64 + ll) * 8;
        if (o == 1) { const float* gr_ = grbase + (size_t)512 * (2 * n);
#pragma unroll
            for (int q = 0; q < 4; ++q) { const int jj = (j0l + 4 * q) < 2 * n ? j0l + 4 * q : 0; gq[q] = *(const f32x4*)(gr_ + jj); } }
        { float nfs = 0.f;
          { const float* part = (const float*)(F.ws + (CM ? WS_HYPARTC : WS_HYPART)) + o * 512 + c;
            nfs = part[(size_t)(ll >> 1) * 2048 + (ll & 1) * 1024]; }
          const float nf = 1.f / sqrtf(wave_sum(nfs) + EPS); float gv[16];
#pragma unroll
          for (int q = 0; q < 4; ++q) { const bool ok = (j0l + 4 * q) < 2 * n; const f32x4 a = ok ? gq[q] : (f32x4){0.f, 0.f, 0.f, 0.f};
              gv[4 * q] = a.x * nf; gv[4 * q + 1] = a.y * nf; gv[4 * q + 2] = a.z * nf; gv[4 * q + 3] = a.w * nf; }
          unsigned pe[8], po[7];
#pragma unroll
          for (int i = 0; i < 8; ++i) pe[i] = pk2(gv[2 * i], gv[2 * i + 1]);
#pragma unroll
          for (int i = 0; i < 7; ++i) po[i] = pk2(gv[2 * i + 1], gv[2 * i + 2]);
#pragma unroll
          for (int r = 0; r < 8; ++r) { const int h2 = r >> 1; const u32x4 val = (r & 1) ? (u32x4){po[h2], po[h2 + 1], po[h2 + 2], po[h2 + 3]} : (u32x4){pe[h2], pe[h2 + 1], pe[h2 + 2], pe[h2 + 3]};
              *(LAS u32x4*)(G + r * GC + j0l) = val; } }
        const int xch = o == 0 ? c : 512 + c;
        const int lq = ll >> 4;
        const int b = ll & 15;
        const bf16_t* xs = HyT + (size_t)xch * T + b * LT + seg0;
        u32x2 xraw[16];
#pragma unroll
        for (int I = 0; I < 16; ++I) xraw[I] = *(const u32x2*)(xs + tw + 16 * I + 4 * lq);
        const unsigned short xe_prev = xs[tw > 0 ? tw - 1 : 0], xe_next = xs[tw + 256 < n ? tw + 256 : n - 1];
        __syncthreads();
        f32x4 acc[16];
#pragma unroll
        for (int I = 0; I < 16; ++I) acc[I] = (f32x4){0.f, 0.f, 0.f, 0.f};
        bf16x8 Fw[16];
        const LAS bf16_t* gb = G + gl - tw;
#pragma unroll
        for (int I = 0; I < 16; ++I) Fw[I] = *(const LAS bf16x8*)(gb - 16 * I);
        const LAS bf16_t* ub = U + (ll & 15) * UP + 8 * (ll >> 4);
        bf16x8 bfr = *(const LAS bf16x8*)ub;
#pragma unroll 1
        for (int K0 = 0; K0 < (PM == 2 ? 256 : n); K0 += 256) {
#pragma unroll
            for (int s = 0; s < 8; ++s) {
                const int k0 = K0 + 32 * s;
                const int kk = (k0 + 32 < n) ? k0 + 32 : k0;
                const bf16x8 bnx = *(const LAS bf16x8*)(ub + kk);
                const bf16x8 n0 = *(const LAS bf16x8*)(gb + kk), n1 = *(const LAS bf16x8*)(gb + kk - 16);
#pragma unroll
                for (int I = 0; I < 16; ++I) acc[I] = MFMA16(Fw[(I - 2 * s) & 15], bfr, acc[I]);
                Fw[(14 - 2 * s) & 15] = n0; Fw[(15 - 2 * s) & 15] = n1; bfr = bnx;
                __builtin_amdgcn_sched_barrier(0);
            }
        }
        __syncthreads();
        const float fb = F.in_(I_HFB)[o * 512 + c];
        const float w0 = cw[xch], w1 = cw[1536 + xch], w2 = cw[3072 + xch], bs = cb[xch];
        unsigned spm1 = (unsigned)xe_prev, sn_cur = (unsigned)__shfl((int)(xraw[0].x & 0xffffu), (ll + 16) & 63);
#pragma unroll
        for (int I = 0; I < 16; ++I) { const int t = tw + 16 * I + 4 * lq;
            const u32x2 raw = xraw[I];
            const unsigned sp_cur = (unsigned)__shfl((int)(raw.y >> 16), (ll - 16) & 63);
            const unsigned sn_next = I < 15 ? (unsigned)__shfl((int)(xraw[I < 15 ? I + 1 : 15].x & 0xffffu), (ll + 16) & 63) : (unsigned)xe_next;
            const unsigned pvb = lq > 0 ? sp_cur : spm1, nvb = lq < 3 ? sn_cur : sn_next;
            spm1 = sp_cur; sn_cur = sn_next;
            const float pv = t > 0 ? bf2f((unsigned short)pvb) : 0.f, nv = t + 4 < n ? bf2f((unsigned short)nvb) : 0.f;
            const float v[6] = {pv, bflo(raw.x), bfhi(raw.x), bflo(raw.y), bfhi(raw.y), nv};
            const u32x2 uu = *(const LAS u32x2*)(U + b * UP + t); const float uf[4] = {bflo(uu.x), bfhi(uu.x), bflo(uu.y), bfhi(uu.y)};
            float r[4];
#pragma unroll
            for (int e = 0; e < 4; ++e) { const float xc = w0 * v[e] + w1 * v[e + 1] + w2 * v[e + 2] + bs; r[e] = xc * (acc[I][e] + uf[e] * fb); }
            if (o == 0) *(LAS u32x2*)(U + b * UP + t) = (u32x2){pk2(r[0], r[1]), pk2(r[2], r[3])};
            else if (PM != 1) *(u32x2*)(HoT + (size_t)c * T + b * LT + seg0 + t) = (u32x2){pk2(r[0], r[1]), pk2(r[2], r[3])};
            if ((I & 3) == 3) __builtin_amdgcn_sched_barrier(0); }
        __syncthreads();
    }
#undef HY_LOAD_FILTER
}

DI void hot_transpose_phase(Frame& F) {
    const bf16_t* HoT = (const bf16_t*)(F.ws + WS_HOT); bf16_t* MIX = (bf16_t*)F.out;
    LAS unsigned* scr = (LAS unsigned*)(F.lds + F.wave * 16384);
    const int l = F.lane, lr = l >> 3, lc = l & 7;
    constexpr int NIT = 8 * (T / 64);
    u32x4 vn[8];
    if (F.gw < NIT) { const int c0 = (F.gw & 7) * 64, t0 = (F.gw >> 3) * 64;
#pragma unroll
        for (int i = 0; i < 8; ++i) vn[i] = *(const u32x4*)(HoT + (size_t)(c0 + 8 * i + lr) * T + t0 + 8 * lc); }
    for (int it = F.gw; it < NIT; it += F.NGW) {
        const int c0 = (it & 7) * 64, t0 = (it >> 3) * 64;
        u32x4 v[8];
#pragma unroll
        for (int i = 0; i < 8; ++i) v[i] = vn[i];
        if (it + F.NGW < NIT) { const int itn = it + F.NGW; const int c1 = (itn & 7) * 64, t1 = (itn >> 3) * 64;
#pragma unroll
            for (int i = 0; i < 8; ++i) vn[i] = *(const u32x4*)(HoT + (size_t)(c1 + 8 * i + lr) * T + t1 + 8 * lc); }
#pragma unroll
        for (int i = 0; i < 8; ++i) { LAS unsigned* p = scr + (8 * i + lr) * 33 + 4 * lc; p[0] = v[i].x; p[1] = v[i].y; p[2] = v[i].z; p[3] = v[i].w; }
        LDS_WAIT(); asm volatile("" ::: "memory");
#pragma unroll
        for (int i = 0; i < 8; ++i) { const int tt = 8 * i + lr; const LAS unsigned short* q = (const LAS unsigned short*)scr + tt + (8 * lc) * 66;
            unsigned e[8];
#pragma unroll
            for (int k = 0; k < 8; ++k) e[k] = q[k * 66];
            *(u32x4*)(MIX + (size_t)(t0 + tt) * DM + c0 + 8 * lc) = (u32x4){e[0] | (e[1] << 16), e[2] | (e[3] << 16), e[4] | (e[5] << 16), e[6] | (e[7] << 16)}; }
        LDS_WAIT(); asm volatile("" ::: "memory");
    }
}

DI float max3f(float a, float b, float c) { float r; asm("v_max3_f32 %0, %1, %2, %3" : "=v"(r) : "v"(a), "v"(b), "v"(c)); return r; }
typedef short s16x4 __attribute__((ext_vector_type(4)));
DI bf16x8 vtr8(const LAS bf16_t* p0, const LAS bf16_t* p1) {
    const s16x4 a = __builtin_bit_cast(s16x4, __builtin_amdgcn_ds_read_tr16_b64_v4i16((LAS s16x4*)p0)), b = __builtin_bit_cast(s16x4, __builtin_amdgcn_ds_read_tr16_b64_v4i16((LAS s16x4*)p1));
    return (bf16x8){a[0], a[1], a[2], a[3], b[0], b[1], b[2], b[3]};
}
template <int DK, bool MLA, int APM = 0>
DI void attn_unit(Frame& F, const bf16_t* Q, int ldq, int qcol, const bf16_t* Kp, int ldk, int kcol, const bf16_t* KRp, const bf16_t* Vp, int ldv, int vcol,
                  bf16_t* O, int ocol, int qrow0, int krow0, int nkeys) {
    constexpr int KP = DK + 8, VP = 96, KS = DK / 16;
    int tid_ = F.tid; asm volatile("" : "+v"(tid_));
    const int tid = tid_, w = __builtin_amdgcn_readfirstlane(tid_ >> 6), l = tid_ & 63, n = l & 31, h = l >> 5;
    LAS bf16_t* Kb = (LAS bf16_t*)F.lds;
    LAS bf16_t* Vt = Kb + 2 * 64 * KP;
    bf16x8 qf[KS];
    { const bf16_t* qp = Q + (size_t)(qrow0 + 32 * w + n) * ldq + qcol + 8 * h;
#pragma unroll
      for (int ks = 0; ks < KS; ++ks) qf[ks] = *(const bf16x8*)(qp + 16 * ks); }
    const int kkey = tid >> 3, kch = tid & 7, rkey = tid >> 2, rch = tid & 3;
    const bf16_t* kg = Kp + (size_t)(krow0 + kkey) * ldk + kcol + 8 * kch;
    const bf16_t* rg = MLA ? KRp + (size_t)(krow0 + (rkey & 63)) * 32 + 8 * rch : nullptr;
    const bf16_t* vg = Vp + (size_t)(krow0 + kkey) * ldv + vcol + 8 * kch;
    const int pim = 16 * (n >> 4) + 8 * ((n >> 2) & 1) + 4 * ((n >> 3) & 1) + (n & 3);
    const int nt = nkeys >> 6;
    const int vtr_off = (8 * h + ((l >> 2) & 3)) * VP + 16 * ((l >> 4) & 1) + 4 * (l & 3);
    u32x4 kA, rA = (u32x4){0, 0, 0, 0}, vA, kB, rB = (u32x4){0, 0, 0, 0}, vB;
#define ATT_LOAD(KR_, RR_, VR_, tile) do { const size_t ko_ = (size_t)(tile) * 64; KR_ = *(const u32x4*)(kg + ko_ * ldk); if (MLA && tid < 256) RR_ = *(const u32x4*)(rg + ko_ * 32); VR_ = *(const u32x4*)(vg + ko_ * ldv); } while (0)
#define ATT_STAGE(buf, KR_, RR_, VR_) do { \
        *(LAS u32x4*)(Kb + (buf) * 64 * KP + kkey * KP + 8 * kch) = KR_; \
        if (MLA && tid < 256) *(LAS u32x4*)(Kb + (buf) * 64 * KP + rkey * KP + 64 + 8 * rch) = RR_; \
        *(LAS u32x4*)(Vt + (buf) * 64 * VP + kkey * VP + 8 * kch) = VR_; } while (0)
    ATT_LOAD(kA, rA, vA, 0);
    if (nt > 1) ATT_LOAD(kB, rB, vB, 1);
    __syncthreads();
    ATT_STAGE(0, kA, rA, vA);
    __syncthreads();
    f32x16 O0, O1, negm;
#pragma unroll
    for (int i = 0; i < 16; ++i) { O0[i] = 0.f; O1[i] = 0.f; negm[i] = 0.f; }
    float lrun = 0.f;
#define ATT_TILE(buf) do { \
        f32x16 S0, S1; \
        const LAS bf16_t* kb0 = Kb + (buf) * 64 * KP + pim * KP + 8 * h; \
        bf16x8 ka[KS], kc[KS];                   \
        _Pragma("unroll") for (int ks = 0; ks < KS; ++ks) { ka[ks] = *(const LAS bf16x8*)(kb0 + 16 * ks); kc[ks] = *(const LAS bf16x8*)(kb0 + 32 * KP + 16 * ks); } \
        const LAS bf16_t* vb = Vt + (buf) * 64 * VP + vtr_off; \
        bf16x8 va[2][2], vc[2][2];               \
        _Pragma("unroll") for (int kb = 0; kb < 2; ++kb) \
            _Pragma("unroll") for (int s = 0; s < 2; ++s) { const LAS bf16_t* vq = vb + (32 * kb + 16 * s) * VP; va[kb][s] = vtr8(vq, vq + 4 * VP); vc[kb][s] = vtr8(vq + 32, vq + 4 * VP + 32); } \
        __builtin_amdgcn_sched_barrier(0); \
        if (APM != 2) { S0 = MFMA32(ka[0], qf[0], negm); S1 = MFMA32(kc[0], qf[0], negm); \
        _Pragma("unroll") for (int ks = 1; ks < KS; ++ks) { S0 = MFMA32(ka[ks], qf[ks], S0); S1 = MFMA32(kc[ks], qf[ks], S1); } } \
        else { _Pragma("unroll") for (int i = 0; i < 16; ++i) { S0[i] = __builtin_bit_cast(float, (unsigned)ka[i % KS][0] & 0x3f800000u); S1[i] = __builtin_bit_cast(float, (unsigned)kc[i % KS][1] & 0x3f800000u); } } \
        asm volatile("s_nop 15\n\ts_nop 15" : "+v"(S0), "+v"(S1));       \
        if (APM != 1) { \
        float mx = max3f(S0[0], S1[0], S0[1]), mx2 = max3f(S1[1], S0[2], S1[2]); \
        _Pragma("unroll") for (int i = 3; i < 15; i += 2) { mx = max3f(mx, S0[i], S1[i]); mx2 = max3f(mx2, S0[i + 1], S1[i + 1]); } \
        mx = max3f(mx, S0[15], S1[15]); mx = max3f(mx, mx2, __shfl_xor(max3f(mx, mx2, mx2), 32)); \
        if (__any(mx > 8.f || mx < -24.f)) { \
            const float sc = __builtin_amdgcn_exp2f(-mx); \
            _Pragma("unroll") for (int i = 0; i < 16; ++i) { S0[i] -= mx; S1[i] -= mx; O0[i] *= sc; O1[i] *= sc; negm[i] -= mx; } \
            lrun *= sc; \
        } \
        float rs = 0.f; \
        _Pragma("unroll") for (int i = 0; i < 16; ++i) { S0[i] = __builtin_amdgcn_exp2f(S0[i]); S1[i] = __builtin_amdgcn_exp2f(S1[i]); rs += S0[i] + S1[i]; } \
        lrun += rs; } \
        bf16x8 pf[2][2]; \
        _Pragma("unroll") for (int s = 0; s < 2; ++s) { \
            pf[0][s] = __builtin_bit_cast(bf16x8, (u32x4){pk2(S0[8 * s], S0[8 * s + 1]), pk2(S0[8 * s + 2], S0[8 * s + 3]), pk2(S0[8 * s + 4], S0[8 * s + 5]), pk2(S0[8 * s + 6], S0[8 * s + 7])}); \
            pf[1][s] = __builtin_bit_cast(bf16x8, (u32x4){pk2(S1[8 * s], S1[8 * s + 1]), pk2(S1[8 * s + 2], S1[8 * s + 3]), pk2(S1[8 * s + 4], S1[8 * s + 5]), pk2(S1[8 * s + 6], S1[8 * s + 7])}); } \
        _Pragma("unroll") for (int kb = 0; kb < 2; ++kb) \
            _Pragma("unroll") for (int s = 0; s < 2; ++s) { if (APM != 2) { O0 = MFMA32(va[kb][s], pf[kb][s], O0); O1 = MFMA32(vc[kb][s], pf[kb][s], O1); } else { O0[kb * 2 + s] += __builtin_bit_cast(float, (unsigned)(va[kb][s][0] ^ pf[kb][s][1]) & 0x3f800000u); O1[kb * 2 + s] += __builtin_bit_cast(float, (unsigned)(vc[kb][s][0] ^ pf[kb][s][2]) & 0x3f800000u); } } \
    } while (0)
#pragma unroll 1
    for (int t = 0; t < nt; t += 2) {
        if (t + 2 < nt) ATT_LOAD(kA, rA, vA, t + 2);
        ATT_TILE(0);
        ATT_STAGE(1, kB, rB, vB);
        __syncthreads();
        if (t + 3 < nt) ATT_LOAD(kB, rB, vB, t + 3);
        ATT_TILE(1);
        if (t + 2 < nt) ATT_STAGE(0, kA, rA, vA);
        __syncthreads();
    }
#undef ATT_LOAD
#undef ATT_STAGE
#undef ATT_TILE
    const float inv = 1.f / (lrun + __shfl_xor(lrun, 32));
    if (APM != 0 && inv != 12345.678f) return;
    bf16_t* op = O + (size_t)(qrow0 + 32 * w + n) * DM + ocol + 4 * h;
#pragma unroll
    for (int jj = 0; jj < 4; ++jj) {
        *(u32x2*)(op + 8 * jj) = (u32x2){pk2(O0[4 * jj] * inv, O0[4 * jj + 1] * inv), pk2(O0[4 * jj + 2] * inv, O0[4 * jj + 3] * inv)};
        *(u32x2*)(op + 32 + 8 * jj) = (u32x2){pk2(O1[4 * jj] * inv, O1[4 * jj + 1] * inv), pk2(O1[4 * jj + 2] * inv, O1[4 * jj + 3] * inv)}; }
}

template <int K, int NCH, int SKP = 0, class Epi>
DI void skinny_unit(Frame& F, int tid_in, const bf16_t* Arow0, int lda, const bf16_t* Bg, const Epi& epi) {
    int tid = tid_in; asm volatile("" : "+v"(tid));
    constexpr int KPD = K + 8, CH = 64, BSZ = CH * KPD, NS = K / 32, NPC = (CH * K / 8) / NTHR;
    const int w = __builtin_amdgcn_readfirstlane(tid >> 6), l = tid & 63, r16 = l & 15, fq = l >> 4;
    LAS bf16_t* Bs = (LAS bf16_t*)F.lds;
    int s_goff[NPC], s_loff[NPC];
#pragma unroll
    for (int j = 0; j < NPC; ++j) { const int e = tid + NTHR * j, cc = e / (K / 8), kc = e % (K / 8); const int rho = 16 * (2 * (cc >> 5) + ((cc >> 2) & 1)) + 4 * ((cc >> 3) & 3) + (cc & 3);
        s_goff[j] = cc * K + 8 * kc; s_loff[j] = rho * KPD + 8 * kc; }
    bf16x8 af[2][NS];
#pragma unroll
    for (int rb = 0; rb < 2; ++rb) { const bf16_t* ap = Arow0 + (size_t)(32 * w + 16 * rb + r16) * lda + 8 * fq;
#pragma unroll
        for (int s2 = 0; s2 < NS; ++s2) af[rb][s2] = *(const bf16x8*)(ap + 32 * s2); }
    u32x4 st[2][NPC];
#define SK_LOAD(set, chunk) do { _Pragma("unroll") for (int j = 0; j < NPC; ++j) st[set][j] = *(const u32x4*)(Bg + (size_t)(chunk) * CH * K + s_goff[j]); } while (0)
#define SK_STAGE(set, buf_) do { _Pragma("unroll") for (int j = 0; j < NPC; ++j) *(LAS u32x4*)(Bs + (buf_) * BSZ + s_loff[j]) = st[set][j]; } while (0)
    SK_LOAD(0, 0); SK_LOAD(1, 1);
    __syncthreads();
    SK_STAGE(0, 0); if (2 < NCH) SK_LOAD(0, 2);
    __syncthreads();
#define SK_STEP(ch, nset) do { \
        const int buf = (ch) & 1; \
        f32x4 acc[2][4]; \
        _Pragma("unroll") for (int rb = 0; rb < 2; ++rb) _Pragma("unroll") for (int cg = 0; cg < 4; ++cg) acc[rb][cg] = (f32x4){0.f, 0.f, 0.f, 0.f}; \
        const LAS bf16_t* bb = Bs + buf * BSZ + r16 * KPD + 8 * fq; \
        if (SKP != 1 && SKP != 3) { constexpr int NG = 4 * (NS / 4); bf16x8 bfr[2][4];            \
          _Pragma("unroll") for (int s2 = 0; s2 < 4; ++s2) bfr[0][s2] = *(const LAS bf16x8*)(bb + 32 * s2); \
          _Pragma("unroll") for (int g = 0; g < NG; ++g) { const int cg = g / (NS / 4), sh = 4 * (g % (NS / 4)); \
            if (g + 1 < NG) { const int cg1 = (g + 1) / (NS / 4), sh1 = 4 * ((g + 1) % (NS / 4)); \
                _Pragma("unroll") for (int s2 = 0; s2 < 4; ++s2) bfr[(g + 1) & 1][s2] = *(const LAS bf16x8*)(bb + (16 * cg1) * KPD + 32 * (sh1 + s2)); } \
            __builtin_amdgcn_sched_barrier(0); \
            _Pragma("unroll") for (int s2 = 0; s2 < 4; ++s2) { acc[0][cg] = MFMA16(bfr[g & 1][s2], af[0][sh + s2], acc[0][cg]); acc[1][cg] = MFMA16(bfr[g & 1][s2], af[1][sh + s2], acc[1][cg]); } \
            __builtin_amdgcn_sched_barrier(0); } } \
        if (SKP != 2 && SKP != 3) { _Pragma("unroll") for (int rb = 0; rb < 2; ++rb) _Pragma("unroll") for (int cp = 0; cp < 2; ++cp) epi(rb, (ch), cp, acc[rb][2 * cp], acc[rb][2 * cp + 1]); } \
        else { float sx_ = 0.f; _Pragma("unroll") for (int rb = 0; rb < 2; ++rb) _Pragma("unroll") for (int cg = 0; cg < 4; ++cg) sx_ += acc[rb][cg][0] + acc[rb][cg][1] + acc[rb][cg][2] + acc[rb][cg][3]; if (sx_ == 12345.678f) epi(0, (ch), 0, acc[0][0], acc[0][1]); } \
        if ((ch) + 1 < NCH) { SK_STAGE(nset, buf ^ 1); if ((ch) + 3 < NCH) SK_LOAD(nset, (ch) + 3); } \
        __syncthreads(); \
    } while (0)
#pragma unroll 1
    for (int c2 = 0; c2 < NCH; c2 += 2) { SK_STEP(c2, 1); SK_STEP(c2 + 1, 0); }
#undef SK_LOAD
#undef SK_STAGE
#undef SK_STEP
}
template <int SKP = 0>
DI void moe_down_phase(Frame& F, int layer, const LAS int* tab) {
    int tid_ = F.tid; asm volatile("" : "+v"(tid_));
    const int tid = tid_, w = __builtin_amdgcn_readfirstlane(tid_ >> 6), r16 = tid_ & 15, fq = (tid_ & 63) >> 4;
    const bf16_t* HID = (const bf16_t*)(F.ws + WS_HID); const bf16_t* WDN = (const bf16_t*)(F.ws + WS_WDN); bf16_t* Y2 = (bf16_t*)(F.ws + WS_Y2);
    const float* row_w = (const float*)(F.ws + WS_ROWW);
    const int nunits = 2 * tab[0]; (void)layer;
#pragma unroll 1
    for (int u = bid_(); u < nunits; u += gdim_()) {
        const int tile = u >> 1, nh = u & 1, e = tab[1 + tile];
        float wg[2];
#pragma unroll
        for (int rb = 0; rb < 2; ++rb) { const int r = tile * 256 + 32 * w + 16 * rb + r16; wg[rb] = row_w[r]; }
        auto epi = [&](int rb, int ch, int cp, const f32x4& v0, const f32x4& v1) {
            *(u32x4*)(Y2 + (size_t)(tile * 256 + 32 * w + 16 * rb + r16) * 1024 + 512 * nh + 64 * ch + 32 * cp + 8 * fq) = pack8(v0 * wg[rb], v1 * wg[rb]); };
        skinny_unit<256, 8, SKP>(F, tid, HID + (size_t)tile * 256 * 256, 256, WDN + (size_t)e * 1024 * 256 + (size_t)(512 * nh) * 256, epi);
    }
}
DI int queue_next(Frame& F, unsigned* qw) {
    LAS int* slot = (LAS int*)(F.lds + MISC_OFF + 64);
    __syncthreads();
    if (F.tid == 0) *slot = (int)atomicAdd(qw, 1u);
    __syncthreads();
    return *slot;
}
DI unsigned queue_issue(Frame& F, unsigned* qw) { unsigned v = 0u; if (F.tid == 0) v = atomicAdd(qw, 1u); return v; }
DI int queue_take(Frame& F, unsigned v) { LAS int* slot = (LAS int*)(F.lds + MISC_OFF + 64); __syncthreads(); if (F.tid == 0) *slot = (int)v; __syncthreads(); return *slot; }
DI void l1_upproj_phase(Frame& F) {
    int tid_ = F.tid; asm volatile("" : "+v"(tid_));
    const int tid = tid_, w = __builtin_amdgcn_readfirstlane(tid_ >> 6), r16 = tid_ & 15, fq = (tid_ & 63) >> 4;
    const bf16_t* CQ = (const bf16_t*)(F.ws + WS_CQ); const bf16_t* CKV = (const bf16_t*)(F.ws + WS_CKV);
    bf16_t* QM = (bf16_t*)(F.ws + WS_QM); bf16_t* KN = (bf16_t*)(F.ws + WS_KN); bf16_t* VM = (bf16_t*)(F.ws + WS_VM);
    const f32x2* rope = (const f32x2*)(F.ws + WS_ROPE1); const float qs = 0.10206207261596575f * LOG2E;
    const float* rowss = (const float*)(F.ctl + CW_ROWSS);
    constexpr int NQ = 128 * 3, NKV = NPAN * 2;
#pragma unroll 1
    for (int u = bid_(); u < NQ + NKV; u += gdim_()) {
        if (u < NQ) {
            const int pl = u / 3, nt3 = u % 3, panel = (pl >> 3) * 9 + 1 + (pl & 7), row0 = panel * 256;
            float rq[2];
#pragma unroll
            for (int rb = 0; rb < 2; ++rb) rq[rb] = qs / sqrtf(rowss[row0 + 32 * w + 16 * rb + r16] * (1.f / 256.f) + EPS);
            auto epi = [&](int rb, int ch, int cp, const f32x4& v0, const f32x4& v1) {
                const int r = row0 + 32 * w + 16 * rb + r16; bf16_t* rp = QM + (size_t)r * 768;
                if (nt3 < 2) { const int v = nt3 * 256 + 64 * ch + 32 * cp + 8 * fq; *(u32x4*)(rp + (v >> 6) * 96 + (v & 63)) = pack8(v0 * rq[rb], v1 * rq[rb]); }
                else { (void)v0; (void)v1; } };
            if (nt3 < 2) skinny_unit<256, 4>(F, tid, CQ + (size_t)row0 * 256, 256, (const bf16_t*)(F.ws + WS_WUQ) + (size_t)(nt3 * 256) * 256, epi);
            else {
                f32x4 keep[2][2];
                auto epr = [&](int rb, int ch, int cp, const f32x4& v0, const f32x4& v1) {
                    if (cp == 0) { keep[rb][0] = v0; keep[rb][1] = v1; return; }
                    const int r = row0 + 32 * w + 16 * rb + r16, pos = r % LT; const int head = 2 * ch + (fq >> 1), g = fq & 1;
                    const f32x2* cpn = rope + (size_t)(pos - CTX) * 16 + g * 8; f32x4 o[2][2];
#pragma unroll
                    for (int j = 0; j < 8; ++j) { const f32x2 cs = cpn[j]; const float t1 = keep[rb][j >> 2][j & 3], t2 = (j < 4 ? v0 : v1)[j & 3];
                        o[0][j >> 2][j & 3] = (t1 * cs.x - t2 * cs.y) * rq[rb]; o[1][j >> 2][j & 3] = (t1 * cs.y + t2 * cs.x) * rq[rb]; }
                    bf16_t* rp = QM + (size_t)r * 768 + head * 96 + 64 + 16 * g;
                    *(u32x4*)rp = pack8(o[0][0], o[0][1]); *(u32x4*)(rp + 8) = pack8(o[1][0], o[1][1]); };
                skinny_unit<256, 4>(F, tid, CQ + (size_t)row0 * 256, 256, (const bf16_t*)(F.ws + WS_WUQ) + (size_t)512 * 256, epr);
            }
        } else {
            const int uu = u - NQ, panel = uu >> 1, nh = uu & 1, row0 = panel * 256; bf16_t* base = nh ? VM : KN;
            float rk[2];
#pragma unroll
            for (int rb = 0; rb < 2; ++rb) rk[rb] = 1.f / sqrtf(rowss[T + row0 + 32 * w + 16 * rb + r16] * (1.f / 128.f) + EPS);
            auto epi = [&](int rb, int ch, int cp, const f32x4& v0, const f32x4& v1) {
                *(u32x4*)(base + (size_t)(row0 + 32 * w + 16 * rb + r16) * 512 + 64 * ch + 32 * cp + 8 * fq) = pack8(v0 * rk[rb], v1 * rk[rb]); };
            skinny_unit<128, 8>(F, tid, CKV + (size_t)row0 * 128, 128, (const bf16_t*)(F.ws + WS_WUKV) + (size_t)(512 * nh) * 128, epi);
        }
    }
}

struct Args { const float* in[N_IN]; float* out; unsigned char* ws; int ph_lo, ph_hi, li, pad; };
static_assert(sizeof(Args) == N_IN * 8 + 16 + 16, "Args has no padding holes");
constexpr int NPH = 26;
#ifndef REP_P0
#define REP_P0 1
#endif
#ifndef REP_P1
#define REP_P1 1
#endif
#ifndef REP_P2
#define REP_P2 1
#endif
#ifndef REP_P12
#define REP_P12 1
#endif
#ifndef REP_P14
#define REP_P14 1
#endif
#ifndef REP_P17
#define REP_P17 1
#endif
#ifndef REP_OUT
#define REP_OUT 1
#endif
#ifndef REP_NORM
#define REP_NORM 1
#endif
#ifndef REP_ROUTER
#define REP_ROUTER 1
#endif
#ifndef REP_UP
#define REP_UP 1
#endif
#ifndef REP_DOWN
#define REP_DOWN 1
#endif
#ifndef PROBE_HY_MODE
#define PROBE_HY_MODE 0
#endif
#ifndef PROBE_EXTRA_HY
#define PROBE_EXTRA_HY 0
#endif
#ifndef PROBE_APM
#define PROBE_APM 3
#endif
#ifndef PROBE_NK
#define PROBE_NK LT
#endif
#ifndef PROBE_GEMM
#define PROBE_GEMM 0
#endif
#ifndef SKPV
#define SKPV 0
#endif
#ifndef DOWN_SKINNY_PROBE
#define DOWN_SKINNY_PROBE 0
#endif
#ifndef DOWN_SKINNY
#define DOWN_SKINNY 0
#endif
#ifndef PROBE_P1C
#define PROBE_P1C 1
#endif
#ifndef PROBE_P1W
#define PROBE_P1W 1
#endif
#ifndef QKV_WGM
#define QKV_WGM 8
#endif
#ifndef FILLER_FIRST
#define FILLER_FIRST 1
#endif
#ifndef DESYNC_OUT
#define DESYNC_OUT 0
#endif
#ifndef DESYNC_DOWN
#define DESYNC_DOWN 127
#endif
#ifndef DESYNC_GROUPS
#define DESYNC_GROUPS 2
#endif
#ifndef PROBE_XBAR
#define PROBE_XBAR 0
#endif
#ifndef REP_P3
#define REP_P3 1
#endif
#ifndef REP_P16
#define REP_P16 1
#endif

DI bool ph_in(int k, int lo, int hi) { asm volatile("" : "+s"(lo), "+s"(hi)); return lo <= k && k < hi; }
__global__ void __launch_bounds__(NTHR, 2) mega_fwd(Args args) {
    extern __shared__ __attribute__((aligned(16))) unsigned char lds_raw[];
    Frame F;
    F.lds = (LAS unsigned char*)lds_raw;
    F.tid = threadIdx.x; F.lane = F.tid & 63; F.wave = __builtin_amdgcn_readfirstlane(F.tid >> 6); const int wave0 = F.wave;
    F.gw = bid_() * NWAVES + F.wave; F.NGW = gdim_() * NWAVES;
    F.out = args.out; F.ws = args.ws; F.ctl = (unsigned*)(args.ws + WS_CTL);
    volatile LAS unsigned* MISC = (volatile LAS unsigned*)(F.lds + MISC_OFF);
    if (F.tid < 32) MISC[F.tid] = 0u;
    if (F.tid == 64) { LAS unsigned long long* pt = (LAS unsigned long long*)(F.lds + PTAB_OFF);
#pragma unroll
        for (int i = 0; i < N_IN; ++i) pt[i] = (unsigned long long)args.in[i]; }
    __syncthreads();
    XcdBarrier bar = xcd_barrier_post(F.ctl + CW_BAR + args.li * XCD_BAR_WORDS, MISC + 8);
    const int lo = args.ph_lo, hi = args.ph_hi;
    const unsigned ws_lo0 = __builtin_amdgcn_readfirstlane((unsigned)(unsigned long long)args.ws), ws_hi0 = __builtin_amdgcn_readfirstlane((unsigned)((unsigned long long)args.ws >> 32));
    const unsigned out_lo0 = __builtin_amdgcn_readfirstlane((unsigned)(unsigned long long)args.out), out_hi0 = __builtin_amdgcn_readfirstlane((unsigned)((unsigned long long)args.out >> 32));
#ifndef PHMASK
#define PHMASK 0xFFFFFFFFu
#endif
#define IN(k) (((PHMASK >> (k)) & 1u) && ph_in((k), lo, hi))
#define PB() do { F.lane = lane_id(); asm volatile("" : "+v"(F.lane)); { int w_ = wave0; asm volatile("" : "+s"(w_)); F.wave = w_; } F.tid = F.wave * 64 + F.lane; F.gw = bid_() * NWAVES + F.wave; { unsigned lo_ = ws_lo0, hi_ = ws_hi0, ol_ = out_lo0, oh_ = out_hi0; asm volatile("" : "+s"(lo_), "+s"(hi_), "+s"(ol_), "+s"(oh_)); F.ws = (unsigned char*)(GAS unsigned char*)(((unsigned long long)hi_ << 32) | lo_); F.out = (float*)(GAS float*)(((unsigned long long)oh_ << 32) | ol_); } F.ctl = (unsigned*)F.ws; ws = F.ws; } while (0)
#define SEAM(k) do { if (IN(k) && IN((k) + 1)) { XcdBarrier bb_ = bar; asm volatile("" : "+s"(bb_.x)); asm volatile("" : "+s"(bb_.bar)); xcd_barrier(bb_, wave0 * 64 + lane_id()); } } while (0)
    unsigned char* ws = F.ws;
#define H ((bf16_t*)(ws + WS_H))
#define MIX ((bf16_t*)F.out)
#define XS ((bf16_t*)(ws + WS_XS))
#define MODV ((const float*)(ws + WS_MODV))

    if (IN(0)) { PB(); mod_block(F); }
    SEAM(0);
    if (IN(1)) { PB();
        if (bid_() & 1) { for (int r_ = 0; r_ < PROBE_P1C; ++r_) { p0_compute_part(F); PB(); __syncthreads(); } for (int r_ = 0; r_ < PROBE_P1W; ++r_) { p0_weight_part(F); PB(); } modnorm_phase(F, 0, 0, false, F.in_(I_X), F.in_(I_CTX), H); }
        else { modnorm_phase(F, 0, 0, false, F.in_(I_X), F.in_(I_CTX), H); PB(); for (int r_ = 0; r_ < PROBE_P1W; ++r_) { p0_weight_part(F); PB(); } for (int r_ = 0; r_ < PROBE_P1C; ++r_) { __syncthreads(); p0_compute_part(F); PB(); } }
#if PROBE_P1ALL > 1
        __syncthreads(); PB();
        if (bid_() & 1) { p0_compute_part(F); PB(); __syncthreads(); p0_weight_part(F); PB(); modnorm_phase(F, 0, 0, false, F.in_(I_X), F.in_(I_CTX), H); }
        else { modnorm_phase(F, 0, 0, false, F.in_(I_X), F.in_(I_CTX), H); PB(); p0_weight_part(F); PB(); __syncthreads(); p0_compute_part(F); PB(); }
#endif
    }
    SEAM(1);
    for (int xb_ = 0; xb_ < PROBE_XBAR; ++xb_) { XcdBarrier bb_ = bar; asm volatile("" : "+s"(bb_.x)); asm volatile("" : "+s"(bb_.bar)); xcd_barrier(bb_, wave0 * 64 + lane_id()); }
#pragma unroll 1
    for (int layer = 0; layer < 2; ++layer) {
        if (layer == 0) {
            if (IN(2)) { PB(); for (int rep_ = 0; rep_ < REP_P2; ++rep_) {
                { ProbDense p; p.init((const bf16_t*)(ws + WS_WIN0), 1024, 6, H, 1024, NPAN, 1024, 0); EpiStore e{(bf16_t*)(ws + WS_HYT), (size_t)T}; pg8::gemm_phase(F.lds, F.tid, p, e); }
#if PROBE_GEMM == 1
                { ProbDense p; p.init((const bf16_t*)(ws + WS_WIN0), 1024, 6, H, 1024, NPAN, 1024, 0); EpiStore e{(bf16_t*)(ws + WS_HYT), (size_t)T}; pg8::gemm_phase(F.lds, F.tid, p, e); }
#elif PROBE_GEMM == 3
                { ProbDense p; p.init((const bf16_t*)(ws + WS_WIN0), 1024, 6, H, 1024, NPAN, 1024, 0); EpiStoreNT e{(bf16_t*)(ws + WS_HYT), (size_t)T}; pg8::gemm_phase(F.lds, F.tid, p, e); }
#elif PROBE_GEMM == 2
                { ProbDense p; p.init((const bf16_t*)(ws + WS_WIN0), 1024, 6, H, 1024, NPAN, 1024, 0); EpiNull e{(float*)(ws + WS_HYT)}; pg8::gemm_phase(F.lds, F.tid, p, e); }
#endif
#if PROBE_GEMM == 5
                if (rep_ > 0) { ProbDense p; p.init(H, 1024, NPAN, (const bf16_t*)(ws + WS_WIN0) + 1536 * 1024, 1024, 3, 1024, 0); EpiNull e{(float*)(ws + WS_HYT)}; pg8::gemm_phase(F.lds, F.tid, p, e); } else
#endif
                { ProbDense p; p.init(H, 1024, NPAN, (const bf16_t*)(ws + WS_WIN0) + 1536 * 1024, 1024, 3, 1024, 0, QKV_WGM);
                  EpiQKV e{(bf16_t*)(ws + WS_Q0), (bf16_t*)(ws + WS_K0), (bf16_t*)(ws + WS_V0), F.in_(I_QKG), (const f32x2*)(ws + WS_ROPE0), 0.125f * LOG2E}; pg8::gemm_phase(F.lds, F.tid, p, e); }
#if PROBE_GEMM == 4
                { ProbDense p; p.init(H, 1024, NPAN, (const bf16_t*)(ws + WS_WIN0) + 1536 * 1024, 1024, 3, 1024, 0);
                  EpiQKV e{(bf16_t*)(ws + WS_Q0), (bf16_t*)(ws + WS_K0), (bf16_t*)(ws + WS_V0), F.in_(I_QKG), (const f32x2*)(ws + WS_ROPE0), 0.125f * LOG2E}; pg8::gemm_phase(F.lds, F.tid, p, e); }
#endif
            }
                { const int c_ = bid_(); if (c_ >= 96) { PB(); const int rk = c_ - 96; dense_weight_items_l1(F, (LAS float*)(F.lds + F.wave * 16384), rk * NWAVES + F.wave, 160 * NWAVES); rope_table1(F, rk * NTHR + F.tid, 160 * NTHR); s5_expand(F, rk * NTHR + F.tid, 160 * NTHR); } }
            }
            SEAM(2);
            if (IN(3)) { PB();
                const bf16_t* Q0 = (const bf16_t*)(ws + WS_Q0); const bf16_t* K0 = (const bf16_t*)(ws + WS_K0); const bf16_t* V0 = (const bf16_t*)(ws + WS_V0);
                for (int rep_ = 0; rep_ < REP_P3; ++rep_)
                for (unsigned nx_ = queue_issue(F, F.ctl + CW_QUEUE + 128 * rep_);;) { const int item = queue_take(F, nx_); if (item >= 1728 + PROBE_EXTRA_HY) break;
                    nx_ = queue_issue(F, F.ctl + CW_QUEUE + 128 * rep_);
                    if (item >= 1728) { hyena_unit<false, PROBE_HY_MODE>(F, item - 1728); continue; }
                    if (item >= 1024 && item < 1536) hyena_unit<false>(F, item - 1024);
                    else if (item < 1664) { int b, head, qrow0, nk;
                        if (item < 1024) { const int idx = item; b = idx >> 6; head = (idx >> 3) & 7; qrow0 = b * LT + CTX + 256 * (idx & 7); nk = LT; }
                        else { const int idx = item - 1536; b = idx >> 3; head = idx & 7; qrow0 = b * LT; nk = CTX; }
                        attn_unit<64, false>(F, Q0, 512, head * 64, K0, 128, (head >> 2) * 64, nullptr, V0, 128, (head >> 2) * 64, MIX, 512 + head * 64, qrow0, b * LT, nk); }
                    else hyena_unit<true>(F, (item - 1664) * 8); }
            }
            SEAM(3);
        } else {
            if (IN(12)) { PB();
#if FILLER_FIRST
                const bool ff_ = bid_() >= 64 && ((bid_() >> 3) & 1);
                if (ff_) { moe_weight_items(F, 1, (LAS float*)(F.lds + F.wave * 16384), (bid_() - 64) * NWAVES + F.wave, 192 * NWAVES); __syncthreads(); PB(); }
#else
                const bool ff_ = false;
#endif
                for (int rep_ = 0; rep_ < REP_P12; ++rep_) { ProbDense p; p.init(H, 1024, NPAN, (const bf16_t*)(ws + WS_WIN1), 1024, 4, 1024, 0);
                EpiInproj1 e{(bf16_t*)(ws + WS_CQ), (bf16_t*)(ws + WS_CKV), (bf16_t*)(ws + WS_KR), (bf16_t*)(ws + WS_BMAT), (float*)(F.ctl + CW_ROWSS), (const f32x2*)(ws + WS_ROPE1)}; pg8::gemm_phase(F.lds, F.tid, p, e); }
                { const int c_ = bid_(); if (c_ >= 64 && !ff_) { PB(); moe_weight_items(F, 1, (LAS float*)(F.lds + F.wave * 16384), (c_ - 64) * NWAVES + F.wave, 192 * NWAVES); } } }
            SEAM(12);
            if (IN(14)) { PB(); for (int rep_ = 0; rep_ < REP_P14; ++rep_) {
                l1_upproj_phase(F); PB();
                { ProbS5 p{512, (const bf16_t*)(ws + WS_BMAT), (const bf16_t*)(ws + WS_S5W), (size_t)1280 * 768, (size_t)256 * 512, 768, 512, 5, 1, 0, gdim_(), bid_()};
                  EpiS5G1 e{(float*)(ws + WS_S5S)}; pg8::gemm_phase(F.lds, F.tid, p, e); }
            } }
            SEAM(14);
            if (IN(15)) { PB(); s5_scan_phase(F); }
            SEAM(15);
            if (IN(16)) { PB();
                { ProbS5 p{768, (const bf16_t*)(ws + WS_BMAT), (const bf16_t*)(ws + WS_S5A), (size_t)1280 * 768, (size_t)512 * 768, 768, 768, 4, 2, 128, gdim_(), bid_()};
                  EpiS5G2 e{(bf16_t*)(ws + WS_Y)}; pg8::gemm_phase(F.lds, F.tid, p, e); }
                const bf16_t* QM = (const bf16_t*)(ws + WS_QM); const bf16_t* KN = (const bf16_t*)(ws + WS_KN); const bf16_t* KR = (const bf16_t*)(ws + WS_KR); const bf16_t* VM = (const bf16_t*)(ws + WS_VM);
                for (int rep_ = 0; rep_ < REP_P16; ++rep_)
                for (unsigned nx_ = queue_issue(F, F.ctl + CW_QUEUE + 64 + 128 * rep_);;) { const int item = queue_take(F, nx_); if (item >= 1024) break;
                    nx_ = queue_issue(F, F.ctl + CW_QUEUE + 64 + 128 * rep_);
                    const int b = item >> 6, head = (item >> 3) & 7, qb = item & 7;
                    if (rep_ == 0) attn_unit<96, true>(F, QM, 768, head * 96, KN, 512, head * 64, KR, VM, 512, head * 64, MIX, head * 64, b * LT + CTX + 256 * qb, b * LT, LT);
                    else attn_unit<96, true, PROBE_APM>(F, QM, 768, head * 96, KN, 512, head * 64, KR, VM, 512, head * 64, MIX, head * 64, b * LT + CTX + 256 * qb, b * LT, PROBE_NK); }
            }
            SEAM(16);
            if (IN(17)) { PB(); for (int rep_ = 0; rep_ < REP_P17; ++rep_) { ProbDense p; p.init((const bf16_t*)(ws + WS_Y), 512, 128, (const bf16_t*)(ws + WS_WGLU), 512, 2, 512, 1);
                EpiGLU e{(const bf16_t*)(ws + WS_Y), F.in_(I_GLUB), MIX}; pg8::gemm_phase(F.lds, F.tid, p, e); } }
            SEAM(17);
        }
        const int tb = layer == 0 ? 4 : 18;
        const bool lat_only = layer == 1;
        if (IN(tb)) { PB();
            if (layer == 0) { hot_transpose_phase(F); XcdBarrier bb_ = bar; asm volatile("" : "+s"(bb_.x)); asm volatile("" : "+s"(bb_.bar)); xcd_barrier(bb_, wave0 * 64 + lane_id()); PB(); }
            if ((bid_() >> 3) & 1) { for (int s_ = 0; s_ < DESYNC_OUT; ++s_) __builtin_amdgcn_s_sleep(127); }
#if MOE0_IN_P4 && FILLER_FIRST
            const bool ff_ = layer == 0 && bid_() >= 64 && ((bid_() >> 3) & 1);
            if (ff_) { PB(); moe_weight_items(F, 0, (LAS float*)(F.lds + F.wave * 16384), (bid_() - 64) * NWAVES + F.wave, 192 * NWAVES); __syncthreads(); PB(); }
#else
            const bool ff_ = false;
#endif
            for (int rep_ = 0; rep_ < (layer == 0 ? REP_OUT : 1); ++rep_) { ProbDense p; p.init(MIX, 1024, lat_only ? 128 : NPAN, (const bf16_t*)(ws + (layer ? WS_WOUT1 : WS_WOUT0)), 1024, 4, 1024, layer);
            EpiRes e{F.in_(I_X), F.in_(I_CTX), XS, MODV + (size_t)layer * 17 * 6144 + 2048, layer}; pg8::gemm_phase(F.lds, F.tid, p, e); }
#if MOE0_IN_P4
            if (layer == 0 && !ff_) { const int c_ = bid_(); if (c_ >= 64) { PB(); moe_weight_items(F, 0, (LAS float*)(F.lds + F.wave * 16384), (c_ - 64) * NWAVES + F.wave, 192 * NWAVES); } }
#endif
        }
        SEAM(tb);
        if (IN(tb + 1)) { PB(); norm2_route_phase(F, layer, lat_only, XS, (bf16_t*)(ws + WS_H)); if (REP_NORM > 1) { __syncthreads(); PB(); norm2_route_phase(F, layer, lat_only, XS, (bf16_t*)(ws + WS_H), true); } }
        SEAM(tb + 1);
        if (IN(tb + 5)) { PB(); for (int rep_ = 0; rep_ < REP_UP; ++rep_) { const LAS int* tab = moe_tile_table(F, layer);
            ProbMoeUp p{1024, H, (const bf16_t*)(ws + WS_WGU), (const int*)(ws + WS_RANKTOK), tab}; EpiGateUp e{(bf16_t*)(ws + WS_HID)}; pg8::gemm_phase(F.lds, F.tid, p, e); } }
        SEAM(tb + 5);
        if (IN(tb + 6)) { PB(); for (int rep_ = 0; rep_ < REP_DOWN; ++rep_) { const LAS int* tab = (const LAS int*)(F.lds + LDS_TAB_OFF);
            { const int ng_ = (bid_() >> 3) & (DESYNC_GROUPS - 1); for (int s_ = 0; s_ < ng_; ++s_) __builtin_amdgcn_s_sleep(DESYNC_DOWN); }
#if DOWN_SKINNY
            moe_down_phase(F, layer, tab);
#elif DOWN_SKINNY_PROBE
            if (rep_ == 0) { ProbMoeDown p{256, (const bf16_t*)(ws + WS_HID), (const bf16_t*)(ws + WS_WDN), tab}; EpiDownSorted e{(bf16_t*)(ws + WS_Y2), (const float*)(ws + WS_RANKW), tab}; pg8::gemm_phase(F.lds, F.tid, p, e); }
            else moe_down_phase<SKPV>(F, layer, tab);
#else
            { ProbMoeDown p{256, (const bf16_t*)(ws + WS_HID), (const bf16_t*)(ws + WS_WDN), tab}; EpiDownSorted e{(bf16_t*)(ws + WS_Y2), (const float*)(ws + WS_RANKW), tab}; pg8::gemm_phase(F.lds, F.tid, p, e); }
#endif
            } }
        SEAM(tb + 6);
        if (IN(tb + 7)) { PB();
            if (layer == 0) { combine_phase<false>(F, 0, XS, F.out, (const bf16_t*)(ws + WS_Y2), H); }
            else combine_phase<true>(F, 1, XS, F.out, (const bf16_t*)(ws + WS_Y2), H);
        }
        if (layer == 0) SEAM(11);
    }
#undef IN
#undef SEAM
#undef PB
#undef H
#undef MIX
#undef XS
#undef MODV
}

#ifndef MK_CUTS
#define MK_CUTS {0, NPH}
#endif
extern "C" void kernel_launch(void* const* d_in, const int* in_sizes, int n_in, void* d_out, int out_size, void* d_ws, size_t ws_size, hipStream_t stream) {
    static int grid = 0;
    if (grid == 0) {
        if (n_in != N_IN || out_size != NB * SEQ * DM || ws_size < WS_END) { fprintf(stderr, "kernel_launch: unexpected shapes (n_in %d, out %d, ws %zu); nothing launched\n", n_in, out_size, ws_size); grid = -1; return; }
        int dev = 0, cus = 0, per_cu = 0;
        if (hipGetDevice(&dev) != hipSuccess || hipDeviceGetAttribute(&cus, hipDeviceAttributeMultiprocessorCount, dev) != hipSuccess) { grid = -1; return; }
        if (hipFuncSetAttribute((const void*)mega_fwd, hipFuncAttributeMaxDynamicSharedMemorySize, LDS_BYTES) != hipSuccess) { fprintf(stderr, "kernel_launch: hipFuncSetAttribute failed\n"); grid = -1; return; }
        if (hipOccupancyMaxActiveBlocksPerMultiprocessor(&per_cu, (const void*)mega_fwd, NTHR, LDS_BYTES) != hipSuccess || per_cu < 1) fprintf(stderr, "kernel_launch: occupancy query says %d\n", per_cu);
        (void)hipGetLastError();
        grid = cus;
    }
    if (grid < 0) return;
    (void)in_sizes;
    if (hipMemsetAsync((char*)d_ws + WS_CTL, 0, CTL_ZERO_BYTES, stream) != hipSuccess) return;
    Args a{};
    for (int i = 0; i < N_IN; ++i) a.in[i] = (const float*)d_in[i];
    a.out = (float*)d_out; a.ws = (unsigned char*)d_ws; a.pad = 0;
    const int cuts[] = MK_CUTS; const int nl = (int)(sizeof(cuts) / sizeof(int)) - 1;
    for (int li = 0; li < nl; ++li) {
        a.ph_lo = cuts[li]; a.ph_hi = cuts[li + 1]; a.li = li;
        hipLaunchKernelGGL(mega_fwd, dim3(grid), dim3(NTHR), LDS_BYTES, stream, a);
        if (hipPeekAtLastError() != hipSuccess) { fprintf(stderr, "kernel_launch: launch %d failed\n", li); break; }
    }
}
```

```cpp
#include <hip/hip_runtime.h>
#include <cstdio>
#include <cstdint>

#ifndef PROBE_HF
#define PROBE_HF 1
#endif
#ifndef PROBE_KT
#define PROBE_KT 1
#endif
#ifndef WT_STORES
#define WT_STORES 0
#endif
#ifndef EARLY_WB
#define EARLY_WB 0
#endif
#ifndef MOE0_IN_P4
#define MOE0_IN_P4 1
#endif
#define LAS __attribute__((address_space(3)))
#define GAS __attribute__((address_space(1)))
#define DI __device__ __forceinline__
typedef unsigned short bf16_t;
typedef short bf16x8 __attribute__((ext_vector_type(8)));
typedef float f32x2 __attribute__((ext_vector_type(2)));
typedef float f32x4 __attribute__((ext_vector_type(4)));
typedef float f32x16 __attribute__((ext_vector_type(16)));
typedef unsigned u32x2 __attribute__((ext_vector_type(2)));
typedef unsigned u32x4 __attribute__((ext_vector_type(4)));
typedef __bf16 bf16x2_t __attribute__((ext_vector_type(2)));

constexpr int NB = 16, SEQ = 2048, CTX = 256, LT = 2304, T = NB * LT, DM = 1024;
constexpr int NPAN = T / 256;
constexpr float EPS = 1e-6f;
constexpr float LOG2E = 1.4426950408889634f;
constexpr int NWAVES = 8, NTHR = 512;
constexpr int MOE_ROWS = 82176;

enum { I_X = 0, I_C, I_CTX, I_CCTX, I_WMOD, I_BMOD, I_NORMG, I_EWIN, I_HCW, I_HCB, I_HW1, I_HB1, I_HW2, I_HB2, I_HW3, I_HFREQ, I_HFB, I_QKG, I_EWOUT,
       I_OWIN, I_QNG, I_WUQ, I_KVNG, I_WUKV, I_SARE, I_SAIM, I_SLDT, I_SBRE, I_SBIM, I_SCRE, I_SCIM, I_SD, I_GLUW, I_GLUB, I_OWOUT,
       I_WRG, I_WRE, I_WGATE, I_WUP, I_WDOWN, I_FINALG, N_IN };

constexpr size_t MiB = 1u << 20;
constexpr size_t WS_CTL = 0, CTL_ZERO_BYTES = 1 * MiB;
constexpr size_t WS_MODV = 1 * MiB;
constexpr size_t WS_ROPE0 = 2 * MiB;
constexpr size_t WS_ROPE1 = 2 * MiB + 512 * 1024;
constexpr size_t WS_NORMF = 2 * MiB + 768 * 1024;
constexpr size_t WS_S5PAR = 2 * MiB + 800 * 1024;
constexpr size_t WS_KTAB = 3 * MiB;
constexpr size_t WS_HYPART = 5 * MiB;
constexpr size_t WS_HYPARTC = 7 * MiB;
constexpr size_t WS_WIN0 = 12 * MiB;
constexpr size_t WS_WOUT0 = WS_WIN0 + 2304 * 1024 * 2;
constexpr size_t WS_WIN1 = WS_WOUT0 + 1024 * 1024 * 2;
constexpr size_t WS_WUQ = WS_WIN1 + 1024 * 1024 * 2;
constexpr size_t WS_WUKV = WS_WUQ + 768 * 256 * 2;
constexpr size_t WS_WGLU = WS_WUKV + 1024 * 128 * 2;
constexpr size_t WS_WOUT1 = WS_WGLU + 512 * 512 * 2;
constexpr size_t WS_WR = WS_WOUT1 + 1024 * 1024 * 2;
constexpr size_t WS_W_END_ = WS_WR + 2 * 256 * 1024 * 2;
static_assert(WS_W_END_ <= 28 * MiB, "weights region");
constexpr size_t WS_WGU = 28 * MiB;
constexpr size_t WS_WDN = 60 * MiB;
constexpr size_t WS_S5A = 76 * MiB;
constexpr size_t WS_S5W = 100 * MiB;
constexpr size_t WS_MOEL = 108 * MiB;
constexpr size_t WS_TOKE = WS_MOEL, WS_TOKW = WS_TOKE + (size_t)T * 8, WS_ROWTOK = WS_TOKW + (size_t)T * 8, WS_ROWDST = WS_ROWTOK + (size_t)MOE_ROWS * 4, WS_ROWW = WS_ROWDST + (size_t)MOE_ROWS * 4;
constexpr size_t WS_TOKPOS = WS_ROWW + (size_t)MOE_ROWS * 4;
static_assert(WS_TOKPOS + (size_t)T * 8 <= 112 * MiB, "moe lists");
constexpr size_t WS_RANKTOK = 112 * MiB;
constexpr size_t WS_RANKW = 117 * MiB;
static_assert(WS_RANKTOK + (size_t)32 * T * 4 <= WS_RANKW && WS_RANKW + (size_t)32 * T * 4 <= 128 * MiB, "rank tables");
constexpr size_t WS_H = 128 * MiB;
constexpr size_t WS_XS = 200 * MiB;
constexpr size_t WS_TMP = 272 * MiB;
constexpr size_t WS_HYT = WS_TMP;
constexpr size_t WS_Q0 = WS_TMP + 108 * MiB;
constexpr size_t WS_K0 = WS_Q0 + 36 * MiB;
constexpr size_t WS_V0 = WS_K0 + 9 * MiB;
constexpr size_t WS_HOT = WS_TMP + 168 * MiB;
constexpr size_t WS_GRAW = 494 * MiB;
constexpr size_t WS_GRAWC = 510 * MiB;
constexpr size_t WS_LOGIT = WS_TMP;
constexpr size_t WS_HID = WS_TMP;
constexpr size_t WS_Y2 = WS_TMP + 41 * MiB;
static_assert(WS_HID + (size_t)MOE_ROWS * 512 <= WS_Y2 && WS_Y2 + (size_t)MOE_ROWS * 2048 <= 494 * MiB, "moe tmp");
constexpr size_t WS_BMAT = WS_TMP;
constexpr size_t WS_S5S = WS_TMP + 60 * MiB;
constexpr size_t WS_Y = WS_S5S;
constexpr size_t WS_KN = WS_TMP + 100 * MiB;
constexpr size_t WS_VM = WS_TMP + 136 * MiB;
constexpr size_t WS_KR = WS_TMP + 172 * MiB;
constexpr size_t WS_CQ = WS_TMP + 175 * MiB;
constexpr size_t WS_CKV = WS_TMP + 193 * MiB;
constexpr size_t WS_QM = WS_H;
constexpr size_t WS_END = 512 * MiB;

constexpr int CW_BAR = 4096;
constexpr int CW_QUEUE = 131072;
constexpr int CW_CNT = 135168;

constexpr int CW_ROWSS = 150000;
static_assert((CW_ROWSS + 2 * T) * 4 <= (int)CTL_ZERO_BYTES, "rowss inside the zeroed region");
constexpr int LDS_BYTES = 147456;
constexpr int MISC_OFF = 146432;
constexpr int PTAB_OFF = MISC_OFF + 128;
constexpr int LDS_TAB_OFF = 131072 + 2048;

DI int bid_() { int b = (int)blockIdx.x; asm volatile("" : "+s"(b)); return b; }
DI int lane_id() { int r; asm volatile("v_mbcnt_lo_u32_b32 %0, -1, 0\n\tv_mbcnt_hi_u32_b32 %0, -1, %0" : "=v"(r)); return r; }
DI int gdim_() { int g = (int)gridDim.x; asm volatile("" : "+s"(g)); return g; }
DI unsigned f2bf(float f) { unsigned u = __builtin_bit_cast(unsigned, f); return (u + 0x7fffu + ((u >> 16) & 1u)) >> 16; }
DI unsigned pk2(float lo, float hi) { f32x2 v = {lo, hi}; bf16x2_t b = __builtin_convertvector(v, bf16x2_t); return __builtin_bit_cast(unsigned, b); }
DI float bf2f(unsigned short h) { return __builtin_bit_cast(float, (unsigned)h << 16); }
DI float bflo(unsigned w) { return __builtin_bit_cast(float, w << 16); }
DI float bfhi(unsigned w) { return __builtin_bit_cast(float, w & 0xffff0000u); }
DI float wave_sum(float v) {
#pragma unroll
    for (int o = 1; o < 64; o <<= 1) v += __shfl_xor(v, o);
    return v;
}
DI float silu_f(float x) { return x / (1.f + __expf(-x)); }
DI float gelu_tanh(float x) { const float u = 0.7978845608028654f * (x + 0.044715f * x * x * x); const float e = __expf(2.f * u); const float th = 1.f - 2.f / (e + 1.f); return 0.5f * x * (1.f + th); }
#define LDS_WAIT() asm volatile("s_waitcnt lgkmcnt(0)" ::: "memory")
#define VM_WAIT() asm volatile("s_waitcnt vmcnt(0)" ::: "memory")

#define XB_TMO      128
#define XB_XCNT(j)  (256  + 64 * (j))
#define XB_XSUB(j)  (1280 + 64 * (j))
#define XB_XGEN(j)  (2304 + 64 * (j))
#define XB_TOP      3328
#define XB_TOPGEN   3392
#define XCD_BAR_WORDS 3456
#define XB_SPIN_CAP (1u << 22)
__device__ __forceinline__ unsigned xb_ld(unsigned* p)              { return __hip_atomic_load(p, __ATOMIC_RELAXED, __HIP_MEMORY_SCOPE_AGENT); }
__device__ __forceinline__ unsigned xb_add(unsigned* p, unsigned v) { return __hip_atomic_fetch_add(p, v, __ATOMIC_RELAXED, __HIP_MEMORY_SCOPE_AGENT); }
__device__ __forceinline__ unsigned xb_xcc_id() { return (unsigned)__builtin_amdgcn_s_getreg((3 << 11) | 20) & 0xFu; }
#define XB_SPIN(cond, bar) do { unsigned _sp = 0; while (cond) { __builtin_amdgcn_s_sleep(1); \
    if ((++_sp & 255u) == 0u) { if (xb_ld(&(bar)[XB_TMO])) break; if (_sp > XB_SPIN_CAP) { atomicAdd(&(bar)[XB_TMO], 1u); break; } } } } while (0)
struct XcdBarrier { unsigned* bar; unsigned x; volatile LAS unsigned* st; };
__device__ __forceinline__ XcdBarrier xcd_barrier_post(unsigned* bar, volatile LAS unsigned* st) {
    XcdBarrier b; b.bar = bar; b.x = xb_xcc_id(); b.st = st;
    if (threadIdx.x == 0) (void)xb_add(&bar[XB_XCNT(b.x)], 1u);
    return b;
}
__device__ __forceinline__ void xcd_barrier_complete(unsigned* bar, unsigned x, unsigned& nloc, unsigned& nx) {
    const unsigned G = gridDim.x * gridDim.y * gridDim.z;
    unsigned sum, cnt, mine, sp = 0u;
    for (;;) {
        sum = 0u; cnt = 0u; mine = 0u;
#pragma unroll
        for (unsigned j = 0; j < 16; ++j) { const unsigned c = xb_ld(&bar[XB_XCNT(j)]); sum += c; cnt += (c > 0u) ? 1u : 0u; mine = (j == x) ? c : mine; }
        if (sum == G) break;
        __builtin_amdgcn_s_sleep(1);
        if ((++sp & 255u) == 0u) { if (xb_ld(&bar[XB_TMO])) break; if (sp > XB_SPIN_CAP) { atomicAdd(&bar[XB_TMO], 1u); break; } }
    }
    nloc = mine > 0u ? mine : 1u; nx = cnt > 0u ? cnt : 1u;
}
__device__ __forceinline__ void xcd_barrier(const XcdBarrier& b, int tid) {
    asm volatile("s_waitcnt vmcnt(0)" ::: "memory");
    __syncthreads();
    if (tid == 0) {
        unsigned* bar = b.bar;
        __builtin_amdgcn_s_waitcnt(0);
        unsigned nloc = b.st[0], nx = b.st[1];
        if (nloc == 0u) { xcd_barrier_complete(bar, b.x, nloc, nx); b.st[0] = nloc; b.st[1] = nx; }
#if EARLY_WB
        __builtin_amdgcn_fence(__ATOMIC_RELEASE, "agent");
        asm volatile("s_waitcnt vmcnt(0)" ::: "memory");
#endif
        const unsigned old = xb_add(&bar[XB_XSUB(b.x)], 1u);
        const unsigned gen = old / nloc;
        if (old + 1u == (gen + 1u) * nloc) {
            __builtin_amdgcn_fence(__ATOMIC_RELEASE, "agent");
            asm volatile("s_waitcnt vmcnt(0)" ::: "memory");
            const unsigned og = xb_add(&bar[XB_TOP], 1u);
            const unsigned tg = og / nx;
            if (og + 1u == (tg + 1u) * nx) xb_add(&bar[XB_TOPGEN], 1u);
            else XB_SPIN(xb_ld(&bar[XB_TOPGEN]) == tg, bar);
            __builtin_amdgcn_fence(__ATOMIC_ACQUIRE, "agent");
            xb_add(&bar[XB_XGEN(b.x)], 1u);
            asm volatile("s_waitcnt vmcnt(0)" ::: "memory");
        } else {
            XB_SPIN(xb_ld(&bar[XB_XGEN(b.x)]) == gen, bar);
            __builtin_amdgcn_fence(__ATOMIC_ACQUIRE, "agent");
            asm volatile("s_waitcnt vmcnt(0)" ::: "memory");
        }
    }
    __syncthreads();
}
namespace pg8 {
constexpr int BM = 256, BK = 64, HALF = 128, HTB = HALF * BK * 2, STAGE_BYTES = 8 * HTB, NXCD = 8, WGM = 8;
__host__ __device__ __forceinline__ int lds_byte(int r, int c) { const int st = (r >> 4) * 2 + (c >> 5), rr = r & 15, cc = c & 31, ob = rr * 64 + cc * 2; return st * 1024 + (ob ^ (((ob >> 9) & 1) << 5)); }
__host__ __device__ __forceinline__ void stage_rc(int b, int& R, int& C) { const int st = b / 1024, sb = b % 1024, swz = sb ^ (((sb >> 9) & 1) << 5); R = (st >> 1) * 16 + swz / 64; C = (st & 1) * 32 + (swz % 64) / 2; }
__host__ __device__ __forceinline__ int perm32(int rho) { const int n = rho >> 4, i = rho & 15; return 8 * (i >> 2) + 4 * n + (i & 3); }
struct Unit { int pm, pn, z; };

struct GridOrder {
    int nM, nN, nwg, G, c, wgm;
    DI void init(int nM_, int nN_, int G_, int c_, int wgm_ = WGM) { nM = nM_; nN = nN_; nwg = nM * nN; G = G_; c = c_; wgm = wgm_; }
    DI bool get(int i, int& pm, int& pn) const {
        const long L = (long)i * G + c; if (L >= nwg) return false;
        int wgid = (int)L; { const int q = nwg / NXCD, r = nwg % NXCD, xcd = wgid % NXCD, off = wgid / NXCD; wgid = (xcd < r ? xcd * (q + 1) : r * (q + 1) + (xcd - r) * q) + off; }
        const int nig = wgm * nN, gid = wgid / nig, fm = gid * wgm, gsz = (nM - fm) < wgm ? (nM - fm) : wgm;
        pm = fm + ((wgid % nig) % gsz); pn = (wgid % nig) / gsz; return true;
    }
};

template <class Prob, class Epi, bool ALIGN_EPI = true>
__device__ __forceinline__ void gemm_phase(LAS unsigned char* lds, int tid_in, const Prob& P, const Epi& E) {
    int tid_ = tid_in; asm volatile("" : "+v"(tid_));
    const int tid = tid_, wid = __builtin_amdgcn_readfirstlane(tid >> 6), lane = tid & 63, wr = wid >> 2, wc = wid & 3, fr = lane & 15, fq = lane >> 4;
    int K_ = P.K; asm volatile("" : "+s"(K_));
    const int K = K_, nt = K / BK;
    int sR[2], sC[2];
#pragma unroll
    for (int i = 0; i < 2; ++i) stage_rc(tid * 16 + i * 8192, sR[i], sC[i]);
    constexpr int NH = Prob::GATHER ? 2 : 1;
    unsigned vB[2], vaC[NH][2], vaN[NH][2];
#pragma unroll
    for (int i = 0; i < 2; ++i) vB[i] = P.b_voff(0, (sR[i] & ~31) + perm32(sR[i] & 31), sC[i]);
    const size_t hstepA = Prob::GATHER ? 0 : (size_t)P.a_voff(pg8::Unit{0, 0, 0}, 1, 0, 0), hstepB = (size_t)P.b_voff(1, 0, 0);
    const size_t kstep = (size_t)(BK * 2);
    const unsigned ldsw = (unsigned)wid * 1024u;
    const int aoff = lds_byte(wr * 64 + fr, fq * 8), boff = lds_byte(wc * 32 + fr, fq * 8);
#define PG8_SA(b, h) (((b) * 2 + (h)) * HTB)
#define PG8_SB(b, h) ((4 + (b) * 2 + (h)) * HTB)
#define PG8_STAGE_A(bufoff, gptr, VO, h) do { const char* gp_ = (gptr) + (h) * hstepA; \
        __builtin_amdgcn_global_load_lds((const unsigned*)(gp_ + VO[Prob::GATHER ? (h) : 0][0]), (LAS unsigned*)(lds + (bufoff) + ldsw), 16, 0, 0); \
        __builtin_amdgcn_global_load_lds((const unsigned*)(gp_ + VO[Prob::GATHER ? (h) : 0][1]), (LAS unsigned*)(lds + (bufoff) + ldsw + 8192), 16, 0, 0); } while (0)
#define PG8_STAGE_B(bufoff, gptr, h) do { const char* gp_ = (gptr) + (h) * hstepB; \
        __builtin_amdgcn_global_load_lds((const unsigned*)(gp_ + vB[0]), (LAS unsigned*)(lds + (bufoff) + ldsw), 16, 0, 0); \
        __builtin_amdgcn_global_load_lds((const unsigned*)(gp_ + vB[1]), (LAS unsigned*)(lds + (bufoff) + ldsw + 8192), 16, 0, 0); } while (0)
#define PG8_LDA(dst, b, h) do { _Pragma("unroll") for (int m = 0; m < 4; ++m) _Pragma("unroll") for (int k = 0; k < 2; ++k) dst[m][k] = *(const LAS bf16x8*)(lds + PG8_SA(b, h) + aoff + m * 2048 + k * 1024); } while (0)
#define PG8_LDB(dst, b, h) do { _Pragma("unroll") for (int n = 0; n < 2; ++n) _Pragma("unroll") for (int k = 0; k < 2; ++k) dst[n][k] = *(const LAS bf16x8*)(lds + PG8_SB(b, h) + boff + n * 2048 + k * 1024); } while (0)
#define PG8_MMA(ai, bj, At, Bt) do { __builtin_amdgcn_s_setprio(1); _Pragma("unroll") for (int m = 0; m < 4; ++m) _Pragma("unroll") for (int n = 0; n < 2; ++n) _Pragma("unroll") for (int k = 0; k < 2; ++k) \
        acc[ai][bj][m][n] = __builtin_amdgcn_mfma_f32_16x16x32_bf16(Bt[n][k], At[m][k], acc[ai][bj][m][n], 0, 0, 0); __builtin_amdgcn_s_setprio(0); } while (0)
#define PG8_WAIT_V(n) asm volatile("s_waitcnt vmcnt(" #n ")" ::: "memory")
#define PG8_WAIT_L(n) asm volatile("s_waitcnt lgkmcnt(" #n ")" ::: "memory")
#define PG8_BAR __builtin_amdgcn_s_barrier()
#define PG8_SCHED __builtin_amdgcn_sched_barrier(0)
    Unit cur, nxt; int ui = 0;
    if (!P.next(0, cur)) return;
    f32x4 acc[2][2][4][2];
#pragma unroll
    for (int a = 0; a < 2; ++a)
#pragma unroll
        for (int b = 0; b < 2; ++b)
#pragma unroll
            for (int m = 0; m < 4; ++m)
#pragma unroll
                for (int n = 0; n < 2; ++n) acc[a][b][m][n] = (f32x4){0.f, 0.f, 0.f, 0.f};
    bf16x8 At[4][2], B0[2][2], B1[2][2];
    const char* cA = P.a_base(cur); const char* cB = P.b_base(cur);
#pragma unroll
    for (int h = 0; h < NH; ++h)
#pragma unroll
        for (int i = 0; i < 2; ++i) { vaC[h][i] = P.a_voff(cur, h, sR[i], sC[i]); vaN[h][i] = vaC[h][i]; }
    PG8_STAGE_B(PG8_SB(0, 0), cB, 0); PG8_STAGE_B(PG8_SB(0, 1), cB, 1); PG8_STAGE_A(PG8_SA(0, 0), cA, vaC, 0); PG8_STAGE_A(PG8_SA(0, 1), cA, vaC, 1);
    if (wr == 1) PG8_BAR;
    PG8_WAIT_V(2); PG8_BAR;
    PG8_STAGE_B(PG8_SB(1, 0), cB + kstep, 0); PG8_STAGE_A(PG8_SA(1, 0), cA + kstep, vaC, 0); PG8_STAGE_B(PG8_SB(1, 1), cB + kstep, 1);
    PG8_WAIT_V(6); PG8_BAR;
    for (;;) {
        const bool has_next = P.next(ui + 1, nxt);
        const char* nA = has_next ? P.a_base(nxt) : cA; const char* nB = has_next ? P.b_base(nxt) : cB;
        if (Prob::GATHER) { if (has_next) {
#pragma unroll
            for (int h = 0; h < NH; ++h)
#pragma unroll
                for (int i = 0; i < 2; ++i) vaN[h][i] = P.a_voff(nxt, h, sR[i], sC[i]); } }
        for (int t = 0; t < nt; t += 2) {
            const bool last = (t == nt - 2);
            const char* a1 = cA + (size_t)(t + 1) * kstep;
            const char* a2 = last ? nA : cA + (size_t)(t + 2) * kstep; const char* b2 = last ? nB : cB + (size_t)(t + 2) * kstep;
            const char* a3 = a2 + kstep; const char* b3 = b2 + kstep;
            unsigned va2[NH][2];
#pragma unroll
            for (int h = 0; h < NH; ++h)
#pragma unroll
                for (int i = 0; i < 2; ++i) va2[h][i] = (Prob::GATHER && last) ? vaN[h][i] : vaC[h][i];
            PG8_LDB(B0, 0, 0); PG8_LDB(B1, 0, 1); PG8_SCHED; PG8_LDA(At, 0, 0); PG8_STAGE_A(PG8_SA(1, 1), a1, vaC, 1);
            PG8_WAIT_V(8); PG8_WAIT_L(0); PG8_BAR; PG8_MMA(0, 0, At, B0); PG8_MMA(0, 1, At, B1); PG8_BAR; PG8_SCHED;
            PG8_LDA(At, 0, 1); PG8_STAGE_B(PG8_SB(0, 0), b2, 0); PG8_STAGE_B(PG8_SB(0, 1), b2, 1); PG8_STAGE_A(PG8_SA(0, 0), a2, va2, 0);
            PG8_WAIT_V(8); PG8_WAIT_L(0); PG8_BAR; PG8_MMA(1, 0, At, B0); PG8_MMA(1, 1, At, B1); PG8_BAR; PG8_SCHED;
            PG8_LDB(B0, 1, 0); PG8_LDB(B1, 1, 1); PG8_SCHED; PG8_LDA(At, 1, 0); PG8_STAGE_A(PG8_SA(0, 1), a2, va2, 1);
            PG8_WAIT_V(8); PG8_WAIT_L(0); PG8_BAR; PG8_MMA(0, 0, At, B0); PG8_MMA(0, 1, At, B1); PG8_BAR; PG8_SCHED;
            PG8_LDA(At, 1, 1); PG8_STAGE_B(PG8_SB(1, 0), b3, 0); PG8_STAGE_B(PG8_SB(1, 1), b3, 1); PG8_STAGE_A(PG8_SA(1, 0), a3, va2, 0);
            PG8_WAIT_V(8); PG8_WAIT_L(0); PG8_BAR; PG8_MMA(1, 0, At, B0); PG8_MMA(1, 1, At, B1); PG8_BAR; PG8_SCHED;
        }
        if constexpr (ALIGN_EPI) { if (wr == 0) PG8_BAR; }
        { const int le_ = lane_id(); E(acc, cur, wr, wc, le_ & 15, le_ >> 4); }
        if (!has_next) break;
#pragma unroll
        for (int a = 0; a < 2; ++a)
#pragma unroll
            for (int b = 0; b < 2; ++b)
#pragma unroll
                for (int m = 0; m < 4; ++m)
#pragma unroll
                    for (int n = 0; n < 2; ++n) acc[a][b][m][n] = (f32x4){0.f, 0.f, 0.f, 0.f};
        cur = nxt; cA = nA; cB = nB; ++ui;
#pragma unroll
        for (int h = 0; h < NH; ++h)
#pragma unroll
            for (int i = 0; i < 2; ++i) vaC[h][i] = vaN[h][i];
        if constexpr (ALIGN_EPI) { if (wr == 1) PG8_BAR; }
    }
    PG8_WAIT_V(0);
    if constexpr (!ALIGN_EPI) { if (wr == 0) PG8_BAR; }
    PG8_BAR;
#undef PG8_SA
#undef PG8_SB
#undef PG8_STAGE_A
#undef PG8_STAGE_B
#undef PG8_LDA
#undef PG8_LDB
#undef PG8_MMA
#undef PG8_WAIT_V
#undef PG8_WAIT_L
#undef PG8_BAR
#undef PG8_SCHED
}
}
typedef pg8::Unit Unit;
typedef f32x4 AccT[2][2][4][2];
struct ProbDense {
    static constexpr bool GATHER = false;
    int K; const bf16_t* A; const bf16_t* B; int lda, ldb; pg8::GridOrder ord; int amap;
    DI void init(const bf16_t* A_, int lda_, int nM, const bf16_t* B_, int ldb_, int nN, int K_, int amap_, int wgm_ = pg8::WGM) { A = A_; B = B_; lda = lda_; ldb = ldb_; K = K_; amap = amap_; ord.init(nM, nN, gdim_(), bid_(), wgm_); }
    DI bool next(int i, Unit& u) const { int pm, pn; if (!ord.get(i, pm, pn)) return false; u.pm = amap ? (pm >> 3) * 9 + 1 + (pm & 7) : pm; u.pn = pn; u.z = 0; return true; }
    DI const char* a_base(const Unit& u) const { return (const char*)(A + (size_t)u.pm * 256 * lda); }
    DI const char* b_base(const Unit& u) const { return (const char*)(B + (size_t)u.pn * 256 * ldb); }
    DI unsigned a_voff(const Unit&, int h, int R, int C) const { return (unsigned)(((h * 128 + R) * lda + C) * 2); }
    DI unsigned b_voff(int h, int Rb, int C) const { return (unsigned)(((h * 128 + Rb) * ldb + C) * 2); }
};
struct ProbS5 {
    static constexpr bool GATHER = false;
    int K; const bf16_t* A; const bf16_t* B; size_t ags, bgs; int lda, ldb, nM, nN, arow0, gd, bi;
    DI bool next(int i, Unit& u) const { const int L = i * gd + bi; if (bi < 0 || L >= 32 * nM * nN) return false; u.z = L / (nM * nN); const int r = L % (nM * nN); u.pm = r / nN; u.pn = r % nN; return true; }
    DI const char* a_base(const Unit& u) const { return (const char*)(A + (size_t)u.z * ags + (size_t)(arow0 + u.pm * 256) * lda); }
    DI const char* b_base(const Unit& u) const { return (const char*)(B + (size_t)u.z * bgs + (size_t)u.pn * 256 * ldb); }
    DI unsigned a_voff(const Unit&, int h, int R, int C) const { return (unsigned)(((h * 128 + R) * lda + C) * 2); }
    DI unsigned b_voff(int h, int Rb, int C) const { return (unsigned)(((h * 128 + Rb) * ldb + C) * 2); }
};
DI int xcd_contig(int L, int n) { const int q = n >> 3, r = n & 7, x = L & 7, off = L >> 3; return (x < r ? x * (q + 1) : r * (q + 1) + (x - r) * q) + off; }
struct ProbMoeUp {
    static constexpr bool GATHER = true;
    int K; const bf16_t* A; const bf16_t* B; const int* rank_tok; const LAS int* tab;
    DI bool next(int i, Unit& u) const { const int L0 = i * gdim_() + bid_(), n = 2 * tab[0]; if (L0 >= n) return false; const int L = xcd_contig(L0, n); u.pm = L >> 1; u.pn = L & 1; u.z = tab[1 + u.pm] & 255; return true; }
    DI const char* a_base(const Unit&) const { return (const char*)A; }
    DI const char* b_base(const Unit& u) const { return (const char*)(B + (size_t)u.z * 512 * 1024 + (size_t)u.pn * 256 * 1024); }
    DI unsigned a_voff(const Unit& u, int h, int R, int C) const { const int rank = (tab[1 + u.pm] >> 8) * 256 + h * 128 + R;
        const int tk = rank < tab[400 + u.z] ? rank_tok[(size_t)u.z * T + rank] >> 1 : 0; return (unsigned)((tk * 1024 + C) * 2); }
    DI unsigned b_voff(int h, int Rb, int C) const { return (unsigned)(((h * 128 + Rb) * 1024 + C) * 2); }
};
struct ProbMoeDown {
    static constexpr bool GATHER = false;
    int K; const bf16_t* A; const bf16_t* B; const LAS int* tab;
    DI bool next(int i, Unit& u) const { const int L0 = i * gdim_() + bid_(), n = 4 * tab[0]; if (L0 >= n) return false; const int L = xcd_contig(L0, n); u.pm = L >> 2; u.pn = L & 3; u.z = tab[1 + u.pm] & 255; return true; }
    DI const char* a_base(const Unit& u) const { return (const char*)(A + (size_t)u.pm * 256 * 256); }
    DI const char* b_base(const Unit& u) const { return (const char*)(B + (size_t)u.z * 1024 * 256 + (size_t)u.pn * 256 * 256); }
    DI unsigned a_voff(const Unit&, int h, int R, int C) const { return (unsigned)(((h * 128 + R) * 256 + C) * 2); }
    DI unsigned b_voff(int h, int Rb, int C) const { return (unsigned)(((h * 128 + Rb) * 256 + C) * 2); }
};

#define EPI_ROW(u, ai, m) ((u).pm * 256 + (ai) * 128 + wr * 64 + (m) * 16 + fr)
#define EPI_COL(u, bj) ((u).pn * 256 + (bj) * 128 + wc * 32 + fq * 8)
#if WT_STORES
DI void st16_wt(void* p, const u32x4& v) { asm volatile("global_store_dwordx4 %0, %1, off sc1\n\ts_nop 1" :: "v"(p), "v"(v) : "memory"); }
#define ST16(addr, val) st16_wt((void*)(addr), (val))
#else
#define ST16(addr, val) (*(u32x4*)(addr) = (val))
#endif
DI u32x4 pack8(const f32x4& a, const f32x4& b) { u32x4 w; w.x = pk2(a[0], a[1]); w.y = pk2(a[2], a[3]); w.z = pk2(b[0], b[1]); w.w = pk2(b[2], b[3]); return w; }

struct EpiNull { float* sink;
    DI void operator()(const AccT& acc, const Unit& u, int wr, int wc, int fr, int fq) const { f32x4 s = {0.f, 0.f, 0.f, 0.f};
#pragma unroll
        for (int ai = 0; ai < 2; ++ai)
#pragma unroll
            for (int bj = 0; bj < 2; ++bj)
#pragma unroll
                for (int m = 0; m < 4; ++m) { s += acc[ai][bj][m][0]; s += acc[ai][bj][m][1]; }
        if (s.x + s.y + s.z + s.w == 12345.678f) sink[u.pm + wr + wc + fr + fq] = s.x; } };
struct EpiStore {
    bf16_t* O; size_t ldc;
    DI void operator()(const AccT& acc, const Unit& u, int wr, int wc, int fr, int fq) const {
#pragma unroll
        for (int ai = 0; ai < 2; ++ai)
#pragma unroll
            for (int m = 0; m < 4; ++m) { bf16_t* rp = O + (size_t)EPI_ROW(u, ai, m) * ldc;
#pragma unroll
                for (int bj = 0; bj < 2; ++bj) ST16(rp + EPI_COL(u, bj), pack8(acc[ai][bj][m][0], acc[ai][bj][m][1])); }
    }
};
struct EpiStoreNT {
    bf16_t* O; size_t ldc;
    DI void operator()(const AccT& acc, const Unit& u, int wr, int wc, int fr, int fq) const {
#pragma unroll
        for (int ai = 0; ai < 2; ++ai)
#pragma unroll
            for (int m = 0; m < 4; ++m) { bf16_t* rp = O + (size_t)EPI_ROW(u, ai, m) * ldc;
#pragma unroll
                for (int bj = 0; bj < 2; ++bj) __builtin_nontemporal_store(pack8(acc[ai][bj][m][0], acc[ai][bj][m][1]), (u32x4*)(rp + EPI_COL(u, bj))); }
    }
};
struct EpiQKV {
    bf16_t *Q, *Kb, *Vb; const float* qkg; const f32x2* rope; float qscale;
    DI void operator()(const AccT& acc, const Unit& u, int wr, int wc, int fr, int fq) const {
        const int kind = (u.pn < 2) ? 0 : (wc < 2 ? 1 : 2);
        const int hs = (u.pn < 2) ? u.pn * 4 + wc : (wc & 1);
        bf16_t* base = kind == 0 ? Q : (kind == 1 ? Kb : Vb); const int ld = kind == 0 ? 512 : 128;
        f32x4 gn[2][2];
        { const float* gp = qkg + (kind & 1) * 64 + 32 * (fq >> 1) + 8 * (fq & 1);
#pragma unroll
          for (int bj = 0; bj < 2; ++bj) { gn[bj][0] = *(const f32x4*)(gp + 16 * bj); gn[bj][1] = *(const f32x4*)(gp + 16 * bj + 4); } }
        const float osc = kind == 0 ? qscale : 1.f;
        const bool roped = kind < 2 && (u.pm % 9) != 0;
#pragma unroll
        for (int ai = 0; ai < 2; ++ai) {
            f32x2 cs[4][8];
            if (roped) {
#pragma unroll
                for (int m = 0; m < 4; ++m) { const int pos = EPI_ROW(u, ai, m) % LT; const f32x2* rp = rope + (size_t)(pos - CTX) * 32 + (fq >> 1) * 16 + (fq & 1) * 8;
#pragma unroll
                    for (int k = 0; k < 8; ++k) cs[m][k] = rp[k]; } }
            asm volatile("" ::: "memory");
#pragma unroll
            for (int m = 0; m < 4; ++m) {
                const int r = EPI_ROW(u, ai, m);
                f32x4 v[2][2];
#pragma unroll
                for (int bj = 0; bj < 2; ++bj) { v[bj][0] = acc[ai][bj][m][0]; v[bj][1] = acc[ai][bj][m][1]; }
                if (kind < 2) {
                    float ss = 0.f;
#pragma unroll
                    for (int bj = 0; bj < 2; ++bj)
#pragma unroll
                        for (int n = 0; n < 2; ++n)
#pragma unroll
                            for (int j = 0; j < 4; ++j) ss += v[bj][n][j] * v[bj][n][j];
                    ss += __shfl_xor(ss, 16); ss += __shfl_xor(ss, 32);
                    const float rstd = __builtin_amdgcn_rsqf(ss * (1.f / 64.f) + EPS);
#pragma unroll
                    for (int bj = 0; bj < 2; ++bj)
#pragma unroll
                        for (int n = 0; n < 2; ++n)
#pragma unroll
                            for (int j = 0; j < 4; ++j) v[bj][n][j] = v[bj][n][j] * rstd * gn[bj][n][j];
                    if (roped) {
#pragma unroll
                        for (int n = 0; n < 2; ++n)
#pragma unroll
                            for (int j = 0; j < 4; ++j) { const f32x2 c2 = cs[m][4 * n + j]; const float t1 = v[0][n][j], t2 = v[1][n][j]; v[0][n][j] = t1 * c2.x - t2 * c2.y; v[1][n][j] = t1 * c2.y + t2 * c2.x; }
                    }
                }
                bf16_t* rowp = base + (size_t)r * ld + hs * 64 + fq * 8;
#pragma unroll
                for (int bj = 0; bj < 2; ++bj) ST16(rowp + 32 * bj, pack8(v[bj][0] * osc, v[bj][1] * osc));
            }
            asm volatile("" ::: "memory");
        }
    }
};
struct EpiRes {
    const float* src_lat; const float* src_ctx; bf16_t* xs; const float* gate; int src_bf16;
    DI void operator()(const AccT& acc, const Unit& u, int wr, int wc, int fr, int fq) const {
        const int b = u.pm / 9; const bool isc = (u.pm % 9) == 0;
        const float* gp = gate + (isc ? 16 : b) * 6144;
        f32x4 gv[2][2];
#pragma unroll
        for (int bj = 0; bj < 2; ++bj) { const int c = EPI_COL(u, bj); gv[bj][0] = *(const f32x4*)(gp + c); gv[bj][1] = *(const f32x4*)(gp + c + 4); }
#pragma unroll
        for (int ai = 0; ai < 2; ++ai) {
            if (src_bf16) { u32x4 sv[4][2];
#pragma unroll
                for (int m = 0; m < 4; ++m)
#pragma unroll
                    for (int bj = 0; bj < 2; ++bj) sv[m][bj] = *(const u32x4*)(xs + (size_t)EPI_ROW(u, ai, m) * DM + EPI_COL(u, bj));
                asm volatile("" ::: "memory");
#pragma unroll
                for (int m = 0; m < 4; ++m) { bf16_t* dp = xs + (size_t)EPI_ROW(u, ai, m) * DM;
#pragma unroll
                    for (int bj = 0; bj < 2; ++bj) { const u32x4 s = sv[m][bj]; const f32x4 s0 = (f32x4){bflo(s.x), bfhi(s.x), bflo(s.y), bfhi(s.y)}, s1 = (f32x4){bflo(s.z), bfhi(s.z), bflo(s.w), bfhi(s.w)};
                        ST16(dp + EPI_COL(u, bj), pack8(s0 + gv[bj][0] * acc[ai][bj][m][0], s1 + gv[bj][1] * acc[ai][bj][m][1])); } }
            } else {
#pragma unroll
              for (int mh = 0; mh < 2; ++mh) { f32x4 sf[2][2][2];
#pragma unroll
                for (int mm = 0; mm < 2; ++mm) { const int r = EPI_ROW(u, ai, 2 * mh + mm); const int pos = r - b * LT;
                    const float* sp = isc ? src_ctx + (size_t)(b * CTX + pos) * DM : src_lat + (size_t)(b * SEQ + pos - CTX) * DM;
#pragma unroll
                    for (int bj = 0; bj < 2; ++bj) { const int c = EPI_COL(u, bj); sf[mm][bj][0] = *(const f32x4*)(sp + c); sf[mm][bj][1] = *(const f32x4*)(sp + c + 4); } }
                asm volatile("" ::: "memory");
#pragma unroll
                for (int mm = 0; mm < 2; ++mm) { const int m = 2 * mh + mm; bf16_t* dp = xs + (size_t)EPI_ROW(u, ai, m) * DM;
#pragma unroll
                    for (int bj = 0; bj < 2; ++bj) ST16(dp + EPI_COL(u, bj), pack8(sf[mm][bj][0] + gv[bj][0] * acc[ai][bj][m][0], sf[mm][bj][1] + gv[bj][1] * acc[ai][bj][m][1])); }
                asm volatile("" ::: "memory"); }
            }
            asm volatile("" ::: "memory");
        }
    }
};
struct EpiRouter {
    float* L;
    DI void operator()(const AccT& acc, const Unit& u, int wr, int wc, int fr, int fq) const {
        if (wc >= 2) return;
#pragma unroll
        for (int ai = 0; ai < 2; ++ai)
#pragma unroll
            for (int m = 0; m < 4; ++m) { float* rp = L + (size_t)EPI_ROW(u, ai, m) * 64 + wc * 32 + fq * 8; *(f32x4*)rp = acc[ai][0][m][0]; *(f32x4*)(rp + 4) = acc[ai][0][m][1]; }
    }
};
struct EpiGateUp {
    bf16_t* H;
    DI void operator()(const AccT& acc, const Unit& u, int wr, int wc, int fr, int fq) const {
#pragma unroll
        for (int ai = 0; ai < 2; ++ai)
#pragma unroll
            for (int m = 0; m < 4; ++m) { f32x4 o[2];
#pragma unroll
                for (int n = 0; n < 2; ++n)
#pragma unroll
                    for (int j = 0; j < 4; ++j) o[n][j] = silu_f(acc[ai][0][m][n][j]) * acc[ai][1][m][n][j];
                ST16(H + (size_t)EPI_ROW(u, ai, m) * 256 + u.pn * 128 + wc * 32 + fq * 8, pack8(o[0], o[1])); asm volatile("" ::: "memory"); }
    }
};
struct EpiDownSorted {
    bf16_t* Y2; const float* rank_w; const LAS int* tab;
    DI void operator()(const AccT& acc, const Unit& u, int wr, int wc, int fr, int fq) const {
        float wv[2][4];
        const int rk0 = (tab[1 + u.pm] >> 8) * 256, cnt = tab[400 + u.z]; const float* rw = rank_w + (size_t)u.z * T;
#pragma unroll
        for (int ai = 0; ai < 2; ++ai)
#pragma unroll
            for (int m = 0; m < 4; ++m) { const int rank = rk0 + ai * 128 + wr * 64 + m * 16 + fr; wv[ai][m] = rank < cnt ? rw[rank] : 0.f; }
        asm volatile("" ::: "memory");
#pragma unroll
        for (int ai = 0; ai < 2; ++ai)
#pragma unroll
            for (int m = 0; m < 4; ++m) { const int r = EPI_ROW(u, ai, m); const float w = wv[ai][m]; bf16_t* rp = Y2 + (size_t)r * 1024;
#pragma unroll
                for (int bj = 0; bj < 2; ++bj) ST16(rp + EPI_COL(u, bj), pack8(acc[ai][bj][m][0] * w, acc[ai][bj][m][1] * w)); asm volatile("" ::: "memory"); }
    }
};
struct EpiDown {
    bf16_t* Y2; const int* row_dst; const float* row_w;
    DI void operator()(const AccT& acc, const Unit& u, int wr, int wc, int fr, int fq) const {
#pragma unroll
        for (int ai = 0; ai < 2; ++ai)
#pragma unroll
            for (int m = 0; m < 4; ++m) { const int r = EPI_ROW(u, ai, m); const int d = row_dst[r]; const float w = row_w[r];
                if (d >= 0) { bf16_t* rp = Y2 + (size_t)d * 1024;
#pragma unroll
                    for (int bj = 0; bj < 2; ++bj) ST16(rp + EPI_COL(u, bj), pack8(acc[ai][bj][m][0] * w, acc[ai][bj][m][1] * w)); } asm volatile("" ::: "memory"); }
    }
};
struct EpiInproj1 {
    bf16_t *CQ, *CKV, *KR, *BM; float* rowss; const f32x2* rope;
    DI void operator()(const AccT& acc, const Unit& u, int wr, int wc, int fr, int fq) const {
#pragma unroll
        for (int ai = 0; ai < 2; ++ai)
#pragma unroll
            for (int m = 0; m < 4; ++m) { const int r = EPI_ROW(u, ai, m);
                if (u.pn == 0) { float ss = 0.f;
#pragma unroll
                    for (int bj = 0; bj < 2; ++bj) { ST16(CQ + (size_t)r * 256 + bj * 128 + wc * 32 + fq * 8, pack8(acc[ai][bj][m][0], acc[ai][bj][m][1]));
#pragma unroll
                        for (int n = 0; n < 2; ++n)
#pragma unroll
                            for (int j = 0; j < 4; ++j) ss += acc[ai][bj][m][n][j] * acc[ai][bj][m][n][j]; }
                    ss += __shfl_xor(ss, 16); ss += __shfl_xor(ss, 32);
                    if (fq == 0) atomicAdd(rowss + r, ss);
                } else if (u.pn < 3) {
                    const int b = r / LT, pos = r % LT, ch = pos >> 5, j = pos & 31;
#pragma unroll
                    for (int bj = 0; bj < 2; ++bj) { const int uc = (u.pn - 1) * 256 + bj * 128 + wc * 32 + fq * 8; const int g = uc >> 4, hi0 = uc & 15;
                        ST16(BM + ((size_t)g * 1280 + ch * 16 + b) * 768 + j * 16 + hi0, pack8(acc[ai][bj][m][0], acc[ai][bj][m][1])); }
                } else {
                    ST16(CKV + (size_t)r * 128 + wc * 32 + fq * 8, pack8(acc[ai][0][m][0], acc[ai][0][m][1]));
                    float ss = 0.f;
#pragma unroll
                    for (int n = 0; n < 2; ++n)
#pragma unroll
                        for (int j = 0; j < 4; ++j) ss += acc[ai][0][m][n][j] * acc[ai][0][m][n][j];
                    ss += __shfl_xor(ss, 16); ss += __shfl_xor(ss, 32);
                    if (fq == 0) atomicAdd(rowss + T + r, ss);
                    if (wc == 0) {
                        const int pos = r % LT; f32x4 v0 = acc[ai][1][m][0], v1 = acc[ai][1][m][1], p0, p1;
#pragma unroll
                        for (int j = 0; j < 4; ++j) { p0[j] = __shfl_xor(v0[j], 16); p1[j] = __shfl_xor(v1[j], 16); }
                        if (pos >= CTX) { const int g = fq >> 1, s = fq & 1; const f32x2* cp = rope + (size_t)(pos - CTX) * 16 + g * 8;
#pragma unroll
                            for (int j = 0; j < 4; ++j) { const f32x2 c0 = cp[j], c1 = cp[4 + j];
                                v0[j] = s ? (p0[j] * c0.y + v0[j] * c0.x) : (v0[j] * c0.x - p0[j] * c0.y);
                                v1[j] = s ? (p1[j] * c1.y + v1[j] * c1.x) : (v1[j] * c1.x - p1[j] * c1.y); } }
                        ST16(KR + (size_t)r * 32 + fq * 8, pack8(v0, v1)); }
                }
                asm volatile("" ::: "memory");
            }
    }
};
struct EpiQup {
    bf16_t* QM; const f32x2* rope; float qscale;
    DI void operator()(const AccT& acc, const Unit& u, int wr, int wc, int fr, int fq) const {
#pragma unroll
        for (int ai = 0; ai < 2; ++ai)
#pragma unroll
            for (int m = 0; m < 4; ++m) { const int r = EPI_ROW(u, ai, m); bf16_t* rp = QM + (size_t)r * 768;
                if (u.pn < 2) {
#pragma unroll
                    for (int bj = 0; bj < 2; ++bj) { const int v = u.pn * 256 + bj * 128 + wc * 32 + fq * 8; ST16(rp + (v >> 6) * 96 + (v & 63), pack8(acc[ai][bj][m][0] * qscale, acc[ai][bj][m][1] * qscale)); }
                } else {
                    const int pos = r % LT; const int head = 2 * wc + (fq >> 1), g = fq & 1;
                    const f32x2* cp = rope + (size_t)(pos - CTX) * 16 + g * 8;
                    f32x4 o[2][2];
#pragma unroll
                    for (int n = 0; n < 2; ++n)
#pragma unroll
                        for (int j = 0; j < 4; ++j) { const f32x2 cs = cp[4 * n + j]; const float t1 = acc[ai][0][m][n][j], t2 = acc[ai][1][m][n][j]; o[0][n][j] = (t1 * cs.x - t2 * cs.y) * qscale; o[1][n][j] = (t1 * cs.y + t2 * cs.x) * qscale; }
#pragma unroll
                    for (int s = 0; s < 2; ++s) ST16(rp + head * 96 + 64 + 16 * g + 8 * s, pack8(o[s][0], o[s][1]));
                }
                asm volatile("" ::: "memory");
            }
    }
};
struct EpiKVup {
    bf16_t *Kn, *Vm;
    DI void operator()(const AccT& acc, const Unit& u, int wr, int wc, int fr, int fq) const {
        bf16_t* base = u.pn < 2 ? Kn : Vm; const int ct = (u.pn & 1) * 256;
#pragma unroll
        for (int ai = 0; ai < 2; ++ai)
#pragma unroll
            for (int m = 0; m < 4; ++m) { bf16_t* rp = base + (size_t)EPI_ROW(u, ai, m) * 512 + ct + wc * 32 + fq * 8;
#pragma unroll
                for (int bj = 0; bj < 2; ++bj) ST16(rp + bj * 128, pack8(acc[ai][bj][m][0], acc[ai][bj][m][1])); }
    }
};
struct EpiS5G1 {
    float* S;
    DI void operator()(const AccT& acc, const Unit& u, int wr, int wc, int fr, int fq) const {
#pragma unroll
        for (int ai = 0; ai < 2; ++ai)
#pragma unroll
            for (int m = 0; m < 4; ++m) { float* rp = S + ((size_t)u.z * 1280 + EPI_ROW(u, ai, m)) * 256 + wc * 32 + fq * 8;
#pragma unroll
                for (int bj = 0; bj < 2; ++bj) { *(f32x4*)(rp + bj * 128) = acc[ai][bj][m][0]; *(f32x4*)(rp + bj * 128 + 4) = acc[ai][bj][m][1]; } }
    }
};
struct EpiS5G2 {
    bf16_t* Y;
    DI void operator()(const AccT& acc, const Unit& u, int wr, int wc, int fr, int fq) const {
#pragma unroll
        for (int ai = 0; ai < 2; ++ai)
#pragma unroll
            for (int m = 0; m < 4; ++m) { const int rl = EPI_ROW(u, ai, m); const int R = rl >> 4, b = rl & 15;
#pragma unroll
                for (int bj = 0; bj < 2; ++bj) { const int c = EPI_COL(u, bj); const int k = c >> 4, ho0 = c & 15; f32x4 o[2];
#pragma unroll
                    for (int n = 0; n < 2; ++n)
#pragma unroll
                        for (int j = 0; j < 4; ++j) o[n][j] = gelu_tanh(acc[ai][bj][m][n][j]);
                    ST16(Y + (size_t)(b * LT + CTX + 32 * R + k) * 512 + u.z * 16 + ho0, pack8(o[0], o[1])); } asm volatile("" ::: "memory"); }
    }
};
struct EpiGLU {
    const bf16_t* Y; const float* bias; bf16_t* MIX;
    DI void operator()(const AccT& acc, const Unit& u, int wr, int wc, int fr, int fq) const {
        f32x4 bv[2][2];
#pragma unroll
        for (int bj = 0; bj < 2; ++bj) { const int c = EPI_COL(u, bj); bv[bj][0] = *(const f32x4*)(bias + c); bv[bj][1] = *(const f32x4*)(bias + c + 4); }
#pragma unroll
        for (int ai = 0; ai < 2; ++ai) { u32x4 gw[4][2];
#pragma unroll
            for (int m = 0; m < 4; ++m)
#pragma unroll
                for (int bj = 0; bj < 2; ++bj) gw[m][bj] = *(const u32x4*)(Y + (size_t)EPI_ROW(u, ai, m) * 512 + EPI_COL(u, bj));
            asm volatile("" ::: "memory");
#pragma unroll
            for (int m = 0; m < 4; ++m) { const int r = EPI_ROW(u, ai, m);
#pragma unroll
                for (int bj = 0; bj < 2; ++bj) { const int c = EPI_COL(u, bj); const u32x4 q = gw[m][bj];
                    const float g[8] = {bflo(q.x), bfhi(q.x), bflo(q.y), bfhi(q.y), bflo(q.z), bfhi(q.z), bflo(q.w), bfhi(q.w)};
                    f32x4 o[2];
#pragma unroll
                    for (int n = 0; n < 2; ++n)
#pragma unroll
                        for (int j = 0; j < 4; ++j) { const float z = acc[ai][bj][m][n][j] + bv[bj][n][j]; o[n][j] = g[4 * n + j] / (1.f + __expf(-z)); }
                    ST16(MIX + (size_t)r * 1024 + 512 + c, pack8(o[0], o[1])); } }
            asm volatile("" ::: "memory"); }
    }
};
struct Frame {
    LAS unsigned char* lds;
    int tid, lane, wave, gw, NGW;
    float* out; unsigned char* ws; unsigned* ctl;
    DI const float* in_(int i) const { const LAS unsigned* p = (const LAS unsigned*)(lds + PTAB_OFF) + 2 * i; const unsigned lo = __builtin_amdgcn_readfirstlane(p[0]), hi = __builtin_amdgcn_readfirstlane(p[1]); return (const float*)(const GAS float*)(((unsigned long long)hi << 32) | lo); }
};

template <class F>
DI void tr_item(const float* W, int K, int N, bf16_t* WT, LAS float* scr, int item, int lane, F rowmap, const float* kscale = nullptr) {
    const int nblk = N / 32, kb = item / nblk, nb = item % nblk, k0 = 64 * kb, n0 = 32 * nb;
    { f32x4 v[8];
#pragma unroll
      for (int i = 0; i < 8; ++i) v[i] = *(const f32x4*)(W + (size_t)(k0 + 8 * i + (lane >> 3)) * N + n0 + 4 * (lane & 7));
#pragma unroll
      for (int i = 0; i < 8; ++i) { LAS float* d = scr + (8 * i + (lane >> 3)) * 33 + 4 * (lane & 7); d[0] = v[i].x; d[1] = v[i].y; d[2] = v[i].z; d[3] = v[i].w; } }
    LDS_WAIT(); asm volatile("" ::: "memory");
    const int c = lane & 7;
    float ks[8];
#pragma unroll
    for (int e = 0; e < 8; ++e) ks[e] = kscale ? kscale[k0 + 8 * c + e] : 1.f;
#pragma unroll
    for (int j = 0; j < 4; ++j) { const int n = (lane >> 3) + 8 * j; const LAS float* s = scr + (8 * c) * 33 + n;
        u32x4 o; o.x = pk2(s[0 * 33] * ks[0], s[1 * 33] * ks[1]); o.y = pk2(s[2 * 33] * ks[2], s[3 * 33] * ks[3]); o.z = pk2(s[4 * 33] * ks[4], s[5 * 33] * ks[5]); o.w = pk2(s[6 * 33] * ks[6], s[7 * 33] * ks[7]);
        const int row = rowmap(n0 + n);
        if (row >= 0) *(u32x4*)(WT + (size_t)row * K + k0 + 8 * c) = o; }
    LDS_WAIT(); asm volatile("" ::: "memory");
}
DI int map_win0(int col) {
    if (col < 1536) return col;
    const int cp = col - 1536, hs = cp >> 6, d = cp & 63, tile = hs >> 2, wc = hs & 3;
    int bj, fq, r;
    if (hs < 10) { const int g = d >> 5, s = (d >> 4) & 1, i = d & 15; fq = 2 * g + (i >> 3); bj = s; r = i & 7; }
    else { bj = d >> 5; fq = (d >> 3) & 3; r = d & 7; }
    return 1536 + 256 * tile + 128 * bj + 32 * wc + 8 * fq + r;
}
DI int map_win1(int col) { return col < 256 ? col : (col < 384 ? 768 + (col - 256) : (col < 416 ? 896 + (col - 384) : 256 + (col - 416))); }
DI int map_wuq(int col) { const int head = col / 96, dd = col % 96; if (dd < 64) return head * 64 + dd; const int e = dd - 64, g = e >> 4, s = (e >> 3) & 1, i = e & 7; return 512 + 64 * (head >> 1) + 32 * s + 8 * (2 * (head & 1) + g) + i; }
DI int map_wukv(int col) { const int head = col >> 7, dd = col & 127; return dd < 64 ? head * 64 + dd : 512 + head * 64 + (dd - 64); }
DI int map_gate(int col) { return 256 * (col >> 7) + (col & 127); }

DI void moe_weight_items(Frame& F, int layer, LAS float* scr, int wrank, int nwrank) {
    const float* wg = F.in_(I_WGATE) + (size_t)layer * 32 * 1024 * 256; const float* wu = F.in_(I_WUP) + (size_t)layer * 32 * 1024 * 256; const float* wd = F.in_(I_WDOWN) + (size_t)layer * 32 * 256 * 1024;
    bf16_t* Wgu = (bf16_t*)(F.ws + WS_WGU); bf16_t* Wdn = (bf16_t*)(F.ws + WS_WDN);
    constexpr int IG = 16 * 8, ID = 4 * 32;
    constexpr int NIT = 32 * (2 * IG + ID);
    for (int it = wrank; it < NIT; it += nwrank) {
        const int e = it / (2 * IG + ID); int r = it % (2 * IG + ID);
        if (r < IG) { tr_item(wg + (size_t)e * 1024 * 256, 1024, 256, Wgu + (size_t)e * 512 * 1024, scr, r, F.lane, [](int c) { return map_gate(c); }); continue; } r -= IG;
        if (r < IG) { tr_item(wu + (size_t)e * 1024 * 256, 1024, 256, Wgu + (size_t)e * 512 * 1024, scr, r, F.lane, [](int c) { return map_gate(c) + 128; }); continue; } r -= IG;
        tr_item(wd + (size_t)e * 256 * 1024, 256, 1024, Wdn + (size_t)e * 1024 * 256, scr, r, F.lane, [](int c) { return c; });
    }
}
DI void router_rg_item(Frame& F, int layer) {
    const float* w = F.in_(I_WRG) + (size_t)layer * 1024 * 4; bf16_t* d = (bf16_t*)(F.ws + WS_WR) + (size_t)layer * 256 * 1024;
    for (int e = F.lane; e < 4096; e += 64) { const int k = e >> 2, n = e & 3; d[n * 1024 + k] = (bf16_t)f2bf(w[e]); }
}
DI void dense_weight_items_l0(Frame& F, LAS float* scr, int wrank, int nwrank) {
    constexpr int N0 = 16 * 72, N1 = 16 * 32, N7 = 16;
    constexpr int NIT = N0 + N1 + N7 + 1;
    for (int it = wrank; it < NIT; it += nwrank) {
        int r = it;
        if (r < N0) { tr_item(F.in_(I_EWIN), 1024, 2304, (bf16_t*)(F.ws + WS_WIN0), scr, r, F.lane, [](int c) { return map_win0(c); }); continue; } r -= N0;
        if (r < N1) { tr_item(F.in_(I_EWOUT), 1024, 1024, (bf16_t*)(F.ws + WS_WOUT0), scr, r, F.lane, [](int c) { return c; }); continue; } r -= N1;
        if (r < N7) { tr_item(F.in_(I_WRE), 1024, 32, (bf16_t*)(F.ws + WS_WR), scr, r, F.lane, [](int c) { return 4 + c; }); continue; }
        router_rg_item(F, 0);
    }
}
DI void dense_weight_items_l1(Frame& F, LAS float* scr, int wrank, int nwrank) {
    constexpr int N2 = 16 * 29, N3 = 4 * 24, N4 = 2 * 32, N5 = 8 * 16, N6 = 16 * 32, N8 = 16;
    constexpr int NIT = N2 + N3 + N4 + N5 + N6 + N8 + 1;
    for (int it = wrank; it < NIT; it += nwrank) {
        int r = it;
        if (r < N2) { tr_item(F.in_(I_OWIN), 1024, 928, (bf16_t*)(F.ws + WS_WIN1), scr, r, F.lane, [](int c) { return map_win1(c); }); continue; } r -= N2;
        if (r < N3) { tr_item(F.in_(I_WUQ), 256, 768, (bf16_t*)(F.ws + WS_WUQ), scr, r, F.lane, [](int c) { return map_wuq(c); }, F.in_(I_QNG)); continue; } r -= N3;
        if (r < N4) { tr_item(F.in_(I_WUKV), 128, 1024, (bf16_t*)(F.ws + WS_WUKV), scr, r, F.lane, [](int c) { return map_wukv(c); }, F.in_(I_KVNG)); continue; } r -= N4;
        if (r < N5) { tr_item(F.in_(I_GLUW), 512, 512, (bf16_t*)(F.ws + WS_WGLU), scr, r, F.lane, [](int c) { return c; }); continue; } r -= N5;
        if (r < N6) { tr_item(F.in_(I_OWOUT), 1024, 1024, (bf16_t*)(F.ws + WS_WOUT1), scr, r, F.lane, [](int c) { return c; }); continue; } r -= N6;
        if (r < N8) { tr_item(F.in_(I_WRE) + 1024 * 32, 1024, 32, (bf16_t*)(F.ws + WS_WR) + 256 * 1024, scr, r, F.lane, [](int c) { return 4 + c; }); continue; }
        router_rg_item(F, 1);
    }
}

DI void mod_block(Frame& F) {
    const int bx = bid_(); if (bx >= 192) return;
    const int layer = bx / 96, cg = bx % 96;
    LAS float* sc = (LAS float*)F.lds;
    LAS float* red = (LAS float*)(F.lds + 17 * 1024 * 4);
    const float* W = F.in_(I_WMOD) + (size_t)layer * 1024 * 6144 + cg * 64 + F.lane;
    const int kb = F.wave * 128;
    float wv[32];
#pragma unroll
    for (int j = 0; j < 32; ++j) wv[j] = W[(size_t)(kb + j) * 6144];
    for (int e = F.tid; e < 17 * 1024; e += NTHR) { const int b = e >> 10, k = e & 1023; const float v = b < 16 ? F.in_(I_C)[b * 1024 + k] : F.in_(I_CCTX)[k]; sc[e] = silu_f(v); }
    __syncthreads();
    float acc[17];
#pragma unroll
    for (int b = 0; b < 17; ++b) acc[b] = 0.f;
#pragma unroll 1
    for (int k0 = 0; k0 < 128; k0 += 32) { float wc[32];
#pragma unroll
        for (int j = 0; j < 32; ++j) wc[j] = wv[j];
        if (k0 + 32 < 128) {
#pragma unroll
            for (int j = 0; j < 32; ++j) wv[j] = W[(size_t)(kb + k0 + 32 + j) * 6144]; }
#pragma unroll
        for (int j = 0; j < 32; ++j)
#pragma unroll
            for (int b = 0; b < 17; ++b) acc[b] += sc[b * 1024 + kb + k0 + j] * wc[j]; }
#pragma unroll
    for (int b = 0; b < 17; ++b) red[(F.wave * 17 + b) * 64 + F.lane] = acc[b];
    __syncthreads();
    for (int e = F.tid; e < 17 * 64; e += NTHR) { const int b = e >> 6, l = e & 63; float s = 0.f;
#pragma unroll
        for (int w = 0; w < 8; ++w) s += red[(w * 17 + b) * 64 + l];
        const int col = cg * 64 + l; ((float*)(F.ws + WS_MODV))[((size_t)layer * 17 + b) * 6144 + col] = s + F.in_(I_BMOD)[layer * 6144 + col]; }
    __syncthreads();
}

DI float red2pi(float x) { const float k = rintf(x * 0.15915494309189535f); float r = fmaf(-k, 6.28318548202514648f, x); r = fmaf(-k, -1.7484556e-7f, r); return r * 0.15915494309189535f; }
DI float sin_hw(float x) { return __builtin_amdgcn_sinf(red2pi(x)); }
DI float cos_hw(float x) { return __builtin_amdgcn_cosf(red2pi(x)); }
DI void lds_addf(LAS float* p, float v) { (void)__hip_atomic_fetch_add(p, v, __ATOMIC_RELAXED, __HIP_MEMORY_SCOPE_WORKGROUP); }
DI void hyena_filter_block72(Frame& F) {
    const int bx = bid_(), tg = bx >> 3, cg = bx & 7, tid = F.tid, r = F.wave, hh = tid & 63;
    LAS float* w3s = (LAS float*)F.lds;
    LAS float* w2s = w3s + 16384;
    LAS float* bfs = w2s + 4096;
    LAS float* h1 = bfs + 192;
    LAS float* w1s = h1 + 4608;
    LAS float* zz = w1s + 2112;
    LAS float* h2t = w1s;
    LAS float* ost = w3s;
    LAS float* sums = h1;
    const float* w1 = F.in_(I_HW1); const float* w2 = F.in_(I_HW2); const float* w3 = F.in_(I_HW3);
    { f32x4 a3[8], a2[2], a1[2]; float ab = 0.f;
#pragma unroll
      for (int k = 0; k < 8; ++k) { const int idx = tid + 512 * k; a3[k] = *(const f32x4*)(w3 + (size_t)(idx >> 6) * 2048 + cg * 256 + (idx & 63) * 4); }
#pragma unroll
      for (int k = 0; k < 2; ++k) a2[k] = *(const f32x4*)(w2 + (tid + 512 * k) * 4);
      a1[0] = *(const f32x4*)(w1 + tid * 4); a1[1] = tid < 16 ? *(const f32x4*)(w1 + (512 + tid) * 4) : (f32x4){0.f, 0.f, 0.f, 0.f};
      if (tid < 192) ab = tid < 64 ? F.in_(I_HB1)[tid] : tid < 128 ? F.in_(I_HB2)[tid - 64] : F.in_(I_HFREQ)[tid - 128];
#pragma unroll 1
      for (int e = tid; e < 72 * 33; e += NTHR) { const int tt = e / 33, f = e % 33; const int n = tt < 64 ? 2048 : 256; const float t = (float)(tt < 64 ? tg * 64 + tt : tg * 8 + tt - 64); float v;
          if (f == 0) v = t / (float)(n - 1); else { const int kk = (f - 1) & 15; const float band = 1e-4f + (float)kk * ((15.f - 1e-4f) / 15.f); const float ang = (6.283185307179586f / (float)n) * t * band; v = (f <= 16) ? cos_hw(ang) : sin_hw(ang); }
          zz[tt * 36 + f] = v; }
#pragma unroll
      for (int k = 0; k < 8; ++k) *(LAS f32x4*)(w3s + (tid + 512 * k) * 4) = a3[k];
#pragma unroll
      for (int k = 0; k < 2; ++k) *(LAS f32x4*)(w2s + (tid + 512 * k) * 4) = a2[k];
      *(LAS f32x4*)(w1s + tid * 4) = a1[0]; if (tid < 16) *(LAS f32x4*)(w1s + (512 + tid) * 4) = a1[1];
      if (tid < 192) bfs[tid] = ab; }
    __syncthreads();
    { float s[9];
#pragma unroll
      for (int k = 0; k < 9; ++k) s[k] = bfs[hh];
#pragma unroll 2
      for (int f = 0; f < 32; f += 4) { const float wa = w1s[f * 64 + hh], wb = w1s[(f + 1) * 64 + hh], wc_ = w1s[(f + 2) * 64 + hh], wd = w1s[(f + 3) * 64 + hh];
#pragma unroll
          for (int k = 0; k < 9; ++k) { const f32x4 z = *(const LAS f32x4*)(zz + (r + 8 * k) * 36 + f); s[k] += z.x * wa + z.y * wb + z.z * wc_ + z.w * wd; } }
      { const float w = w1s[32 * 64 + hh];
#pragma unroll
        for (int k = 0; k < 9; ++k) s[k] += zz[(r + 8 * k) * 36 + 32] * w; }
#pragma unroll
      for (int k = 0; k < 9; ++k) h1[(r + 8 * k) * 64 + hh] = s[k];
      const float fq_ = bfs[128 + hh];
#pragma unroll 1
      for (int k = 0; k < 9; ++k) { LAS float* q = h1 + (r + 8 * k) * 64 + hh; *q = sin_hw(fq_ * *q); } }
    __syncthreads();
    { float s[9];
#pragma unroll
      for (int k = 0; k < 9; ++k) s[k] = bfs[64 + hh];
#pragma unroll 2
      for (int f = 0; f < 64; f += 4) { const float wa = w2s[f * 64 + hh], wb = w2s[(f + 1) * 64 + hh], wc_ = w2s[(f + 2) * 64 + hh], wd = w2s[(f + 3) * 64 + hh];
#pragma unroll
          for (int k = 0; k < 9; ++k) { const f32x4 z = *(const LAS f32x4*)(h1 + (r + 8 * k) * 64 + f); s[k] += z.x * wa + z.y * wb + z.z * wc_ + z.w * wd; } }
      __syncthreads();
      const float fq_ = bfs[128 + hh];
#pragma unroll
      for (int k = 0; k < 9; ++k) { const int tt = r + 8 * k; h2t[hh * 96 + (tt / 9) * 12 + tt % 9] = s[k]; }
#pragma unroll 1
      for (int k = 0; k < 9; ++k) { const int tt = r + 8 * k; LAS float* q = h2t + hh * 96 + (tt / 9) * 12 + tt % 9; *q = sin_hw(fq_ * *q); } }
    sums[tid] = 0.f;
    __syncthreads();
    const int c4 = tid & 63;
    f32x4 acc[9];
#pragma unroll
    for (int i = 0; i < 9; ++i) acc[i] = (f32x4){0.f, 0.f, 0.f, 0.f};
#pragma unroll 2
    for (int h = 0; h < 64; ++h) { const f32x4 wv = *(const LAS f32x4*)(w3s + h * 256 + c4 * 4);
        const f32x4 ha = *(const LAS f32x4*)(h2t + h * 96 + r * 12), hb = *(const LAS f32x4*)(h2t + h * 96 + r * 12 + 4); const float hc = h2t[h * 96 + r * 12 + 8];
        acc[0] += wv * ha.x; acc[1] += wv * ha.y; acc[2] += wv * ha.z; acc[3] += wv * ha.w; acc[4] += wv * hb.x; acc[5] += wv * hb.y; acc[6] += wv * hb.z; acc[7] += wv * hb.w; acc[8] += wv * hc; }
    __syncthreads();
    const int dir = cg >> 2, o = (cg >> 1) & 1, cb = (cg & 1) * 256;
    const float dmin = 3.0701134573253945f, dmax = 15.350567286626973f;
    { f32x4 ssl = (f32x4){0.f, 0.f, 0.f, 0.f}, ssc = (f32x4){0.f, 0.f, 0.f, 0.f};
#pragma unroll
      for (int i = 0; i < 9; ++i) { const int tt = r * 9 + i; const bool lat = tt < 64; const int n = lat ? 2048 : 256; const int t = lat ? tg * 64 + tt : tg * 8 + tt - 64; const float tn = (float)t / (float)(n - 1);
          const bool live = !(dir == 1 && t == 0);
#pragma unroll
          for (int q = 0; q < 4; ++q) { const float delta = dmin + (float)(cb + c4 * 4 + q) * ((dmax - dmin) / 511.f); const float v = live ? acc[i][q] * __expf(-tn * delta) : 0.f;
              ost[(c4 * 4 + q) * 73 + tt] = v; if (lat) ssl[q] += v * v; else ssc[q] += v * v; } }
#pragma unroll
      for (int q = 0; q < 4; ++q) { lds_addf(sums + c4 * 4 + q, ssl[q]); if (r == 7) lds_addf(sums + 256 + c4 * 4 + q, ssc[q]); } }
    __syncthreads();
    { float* graw = (float*)(F.ws + WS_GRAW); float* grawc = (float*)(F.ws + WS_GRAWC); const int lane = tid & 63;
#pragma unroll 4
      for (int jj = 0; jj < 32; ++jj) { const int j = r * 32 + jj; const int t = tg * 64 + lane; float* gp = graw + ((size_t)o * 512 + cb + j) * 4096; const float v = ost[j * 73 + lane];
          if (dir == 0) gp[2048 - t] = v; else if (t > 0) gp[2048 + t] = v; }
#pragma unroll
      for (int k = 0; k < 4; ++k) { const int j = r * 32 + k * 8 + (lane >> 3), i = lane & 7; const int t = tg * 8 + i; float* gp = grawc + ((size_t)o * 512 + cb + j) * 512; const float v = ost[j * 73 + 64 + i];
          if (dir == 0) gp[256 - t] = v; else if (t > 0) gp[256 + t] = v; }
      if (tid < 256) ((float*)(F.ws + WS_HYPART))[(size_t)tg * 2048 + cg * 256 + tid] = sums[tid];
      else ((float*)(F.ws + WS_HYPARTC))[(size_t)tg * 2048 + cg * 256 + tid - 256] = sums[tid];
      if (tg == 0 && dir == 0 && tid < 256) { graw[((size_t)o * 512 + cb + tid) * 4096] = 0.f; grawc[((size_t)o * 512 + cb + tid) * 512] = 0.f; } }
    __syncthreads();
}

DI void s5_ktab_block(Frame& F) {
    const int bx = bid_(), g = bx >> 3, d = bx & 1, m0 = ((bx >> 1) & 3) * 8;
    LAS float* par = (LAS float*)F.lds;
    LAS float* bb = par + 256;
    LAS float* cc = bb + 2048;
    LAS float* lam = cc + 2048;
    const int dg = d * 32 + g;
    if (F.tid < 64) { const int p = F.tid; const float are = F.in_(I_SARE)[dg * 64 + p], aim = F.in_(I_SAIM)[dg * 64 + p]; const float dt = __expf(F.in_(I_SLDT)[dg]);
        const float lr = are * dt, th = aim * dt; float sn, cs; sincosf(th, &sn, &cs); const float em1 = expm1f(lr); const float sh = sinf(0.5f * th);
        const float er = em1 * cs - 2.f * sh * sh, ei = (em1 + 1.f) * sn; const float den = are * are + aim * aim;
        const float cor = (er * are + ei * aim) / den, coi = (ei * are - er * aim) / den;
        par[p * 4 + 0] = lr; par[p * 4 + 1] = th; par[p * 4 + 2] = cor; par[p * 4 + 3] = coi;
        if (m0 == 0) *(f32x4*)((float*)(F.ws + WS_S5PAR) + (size_t)(dg * 64 + p) * 4) = (f32x4){lr, th, cor, coi}; }
    __syncthreads();
    for (int e = F.tid; e < 1024; e += NTHR) { const int p = e >> 4, hi = e & 15; const float br = F.in_(I_SBRE)[(size_t)(dg * 64 + p) * 16 + hi], bi = F.in_(I_SBIM)[(size_t)(dg * 64 + p) * 16 + hi];
        const float cor = par[p * 4 + 2], coi = par[p * 4 + 3]; bb[e * 2] = cor * br - coi * bi; bb[e * 2 + 1] = cor * bi + coi * br; }
    for (int e = F.tid; e < 1024; e += NTHR) { const int ho = e >> 6, p = e & 63; cc[e * 2] = F.in_(I_SCRE)[(size_t)(dg * 16 + ho) * 64 + p]; cc[e * 2 + 1] = F.in_(I_SCIM)[(size_t)(dg * 16 + ho) * 64 + p]; }
    { const int ml = F.tid >> 6, p = F.tid & 63; const float m = (float)(m0 + ml); const float mg = __expf(m * par[p * 4]); float sn, cs; sincosf(m * par[p * 4 + 1], &sn, &cs); lam[F.tid * 2] = mg * cs; lam[F.tid * 2 + 1] = mg * sn; }
    __syncthreads();
    float* kt = (float*)(F.ws + WS_KTAB) + ((size_t)dg * 32 + m0) * 256;
    for (int e = F.tid; e < 2048; e += NTHR) { const int ml = e >> 8, ho = (e >> 4) & 15, hi = e & 15; float s = 0.f;
        for (int p = 0; p < 64; ++p) { const float lr = lam[(ml * 64 + p) * 2], li = lam[(ml * 64 + p) * 2 + 1], br = bb[(p * 16 + hi) * 2], bi = bb[(p * 16 + hi) * 2 + 1];
            const float wr_ = lr * br - li * bi, wi_ = lr * bi + li * br; s += cc[(ho * 64 + p) * 2] * wr_ - cc[(ho * 64 + p) * 2 + 1] * wi_; }
        kt[e] = s; }
    __syncthreads();
}

DI void rope_table1(Frame& F, int gt, int NG) {
    f32x2* r1 = (f32x2*)(F.ws + WS_ROPE1);
    for (int e = gt; e < 2048 * 16; e += NG) { const int p = e >> 4, g = (e >> 3) & 1, i = e & 7; const float pos = (float)(g ? (p & 63) : (p >> 6)); const float fr = exp2f(-(float)i * (13.287712379549449f / 8.f)); float sn, cs; sincosf(pos * fr, &sn, &cs); r1[e] = (f32x2){cs, sn}; }
}
DI void rope_tables(Frame& F) {
    const int gt = bid_() * NTHR + F.tid, NG = gdim_() * NTHR;
    f32x2* r0 = (f32x2*)(F.ws + WS_ROPE0);
    for (int e = gt; e < 2048 * 32; e += NG) { const int p = e >> 5, g = (e >> 4) & 1, i = e & 15; const float pos = (float)(g ? (p & 63) : (p >> 6)); const float fr = exp2f(-(float)i * (13.287712379549449f / 16.f)); float sn, cs; sincosf(pos * fr, &sn, &cs); r0[e] = (f32x2){cs, sn}; }
}

DI void p0_compute_part(Frame& F) {
    hyena_filter_block72(F);
#if PROBE_HF > 1
    hyena_filter_block72(F);
#endif
    s5_ktab_block(F);
#if PROBE_KT > 1
    s5_ktab_block(F);
#endif
    rope_tables(F);
}
DI void p0_weight_part(Frame& F) {
    __syncthreads();
    LAS float* scr = (LAS float*)(F.lds + F.wave * 16384);
    dense_weight_items_l0(F, scr, F.gw, F.NGW);
#if !MOE0_IN_P4
    moe_weight_items(F, 0, scr, F.gw, F.NGW);
#endif
    __syncthreads();
}

DI void normf_items(Frame& F, int gt) {
    if (gt < 2048) { const int seg = gt >> 10, oc = gt & 1023; const float* part = (const float*)(F.ws + (seg ? WS_HYPARTC : WS_HYPART)); float s = 0.f;
        for (int b = 0; b < 256; ++b) s += part[(size_t)b * 2048 + oc] + part[(size_t)b * 2048 + 1024 + oc];
        ((float*)(F.ws + WS_NORMF))[gt] = 1.f / sqrtf(s + EPS); }
}
DI void s5_expand(Frame& F, int gt, int NG) {
    const float* ktab = (const float*)(F.ws + WS_KTAB); const f32x4* par = (const f32x4*)(F.ws + WS_S5PAR);
    bf16_t* SA = (bf16_t*)(F.ws + WS_S5A); bf16_t* SW = (bf16_t*)(F.ws + WS_S5W);
    for (int it = gt; it < 32 * 512 * 96; it += NG) {
        const int g = it / (512 * 96), rem = it % (512 * 96), row = rem / 96, c8 = (rem % 96) * 8; const int k = row >> 4, ho = row & 15;
        float v[8];
        if (c8 < 512) { const int j = c8 >> 4, hi0 = c8 & 15;
            if (k > j) { const float* kp = ktab + (((size_t)(0 * 32 + g) * 32 + (k - j)) * 16 + ho) * 16 + hi0;
#pragma unroll
                for (int e = 0; e < 8; ++e) v[e] = kp[e]; }
            else if (k < j) { const float* kp = ktab + (((size_t)(1 * 32 + g) * 32 + (j - k)) * 16 + ho) * 16 + hi0;
#pragma unroll
                for (int e = 0; e < 8; ++e) v[e] = kp[e]; }
            else { const float* k0 = ktab + (((size_t)(0 * 32 + g) * 32) * 16 + ho) * 16 + hi0; const float* k1 = ktab + (((size_t)(1 * 32 + g) * 32) * 16 + ho) * 16 + hi0; const float dsk = F.in_(I_SD)[g * 16 + ho];
#pragma unroll
                for (int e = 0; e < 8; ++e) v[e] = k0[e] + k1[e] + ((hi0 + e) == ho ? dsk : 0.f); }
        } else { const int cc = c8 - 512, d = cc >> 7, im = (cc >> 6) & 1, p0 = cc & 63; const int dg = d * 32 + g; const float pw = d == 0 ? (float)(k + 1) : (float)(32 - k);
#pragma unroll
            for (int e = 0; e < 8; ++e) { const int p = p0 + e; const f32x4 pr = par[dg * 64 + p]; const float mg = __expf(pw * pr.x); float sn, cs; sincosf(pw * pr.y, &sn, &cs); const float lr = mg * cs, li = mg * sn;
                const float cr = F.in_(I_SCRE)[(size_t)(dg * 16 + ho) * 64 + p], ci = F.in_(I_SCIM)[(size_t)(dg * 16 + ho) * 64 + p];
                v[e] = im ? -(cr * li + ci * lr) : (cr * lr - ci * li); }
        }
        u32x4 o; o.x = pk2(v[0], v[1]); o.y = pk2(v[2], v[3]); o.z = pk2(v[4], v[5]); o.w = pk2(v[6], v[7]);
        *(u32x4*)(SA + ((size_t)g * 512 + row) * 768 + c8) = o;
    }
    for (int it = gt; it < 32 * 256 * 64; it += NG) {
        const int g = it / (256 * 64), rem = it % (256 * 64), n = rem >> 6, c8 = (rem & 63) * 8; const int d = n >> 7, im = (n >> 6) & 1, p = n & 63, j = c8 >> 4, hi0 = c8 & 15; const int dg = d * 32 + g;
        const f32x4 pr = par[dg * 64 + p]; const float pw = d == 0 ? (float)(31 - j) : (float)j; const float mg = __expf(pw * pr.x); float sn, cs; sincosf(pw * pr.y, &sn, &cs); const float lr = mg * cs, li = mg * sn;
        float v[8];
#pragma unroll
        for (int e = 0; e < 8; ++e) { const float br = F.in_(I_SBRE)[(size_t)(dg * 64 + p) * 16 + hi0 + e], bi = F.in_(I_SBIM)[(size_t)(dg * 64 + p) * 16 + hi0 + e];
            const float Br = pr.z * br - pr.w * bi, Bi = pr.z * bi + pr.w * br; v[e] = im ? (lr * Bi + li * Br) : (lr * Br - li * Bi); }
        u32x4 o; o.x = pk2(v[0], v[1]); o.y = pk2(v[2], v[3]); o.z = pk2(v[4], v[5]); o.w = pk2(v[6], v[7]);
        *(u32x4*)(SW + ((size_t)g * 256 + n) * 512 + c8) = o;
    }
}
#define MFMA16(a, b, c) __builtin_amdgcn_mfma_f32_16x16x32_bf16((a), (b), (c), 0, 0, 0)
#define MFMA32(a, b, c) __builtin_amdgcn_mfma_f32_32x32x16_bf16((a), (b), (c), 0, 0, 0)
DI int lds_add(LAS int* p, int v) { return __hip_atomic_fetch_add(p, v, __ATOMIC_RELAXED, __HIP_MEMORY_SCOPE_WORKGROUP); }
DI int lat_row(int tl) { return (tl >> 11) * LT + CTX + (tl & 2047); }

template <int RPW = 3>
DI void modnorm_phase(Frame& F, int layer, int which, bool lat_only, const float* lat, const float* ctx, bf16_t* H) {
    const float* ng = F.in_(I_NORMG) + (layer * 2 + which) * 1024; const float* mv = (const float*)(F.ws + WS_MODV) + (size_t)layer * 17 * 6144 + (which ? 3072 : 0);
    const int nrows = lat_only ? NB * SEQ : T;
    f32x4 g4[4];
#pragma unroll
    for (int j = 0; j < 4; ++j) g4[j] = *(const f32x4*)(ng + 4 * F.lane + 256 * j);
    for (int i0 = F.gw; i0 < nrows; i0 += RPW * F.NGW) {
        f32x4 v[RPW][4]; const float* mrow[RPW]; int rr[RPW];
#pragma unroll
        for (int u = 0; u < RPW; ++u) { const int i = i0 + u * F.NGW; const int ic = i < nrows ? i : i0;
            const int r = lat_only ? lat_row(ic) : ic; const int b = r / LT, pos = r % LT; const bool isc = pos < CTX; rr[u] = i < nrows ? r : -1;
            const float* src = isc ? ctx + (size_t)(b * CTX + pos) * DM : lat + (size_t)(b * SEQ + pos - CTX) * DM; mrow[u] = mv + (isc ? 16 : b) * 6144;
#pragma unroll
            for (int j = 0; j < 4; ++j) v[u][j] = *(const f32x4*)(src + 4 * F.lane + 256 * j); }
#pragma unroll
        for (int u = 0; u < RPW; ++u) { float ss = 0.f;
#pragma unroll
            for (int j = 0; j < 4; ++j) ss += (v[u][j].x * v[u][j].x + v[u][j].y * v[u][j].y) + (v[u][j].z * v[u][j].z + v[u][j].w * v[u][j].w);
            const float rstd = 1.f / sqrtf(wave_sum(ss) * (1.f / DM) + EPS);
            if (rr[u] >= 0) {
#pragma unroll
                for (int j = 0; j < 4; ++j) { const f32x4 sh = *(const f32x4*)(mrow[u] + 4 * F.lane + 256 * j), sc = *(const f32x4*)(mrow[u] + 1024 + 4 * F.lane + 256 * j);
                    const f32x4 y = v[u][j] * rstd * g4[j] * (sc + 1.f) + sh;
                    *(u32x2*)(H + (size_t)rr[u] * DM + 4 * F.lane + 256 * j) = (u32x2){pk2(y.x, y.y), pk2(y.z, y.w)}; } } }
    }
}

template <bool FINAL>
DI void combine_phase(Frame& F, int layer, bf16_t* XS, float* out, const bf16_t* Y2, bf16_t* H) {
    const float* mvg = (const float*)(F.ws + WS_MODV) + (size_t)layer * 17 * 6144 + 5120;
    const float* mvn = (const float*)(F.ws + WS_MODV) + (size_t)(layer + 1) * 17 * 6144;
    const float* ng = FINAL ? F.in_(I_FINALG) : F.in_(I_NORMG) + ((layer + 1) * 2) * 1024;
    const int nrows = FINAL ? NB * SEQ : T;
    const LAS int* ttab = (const LAS int*)(F.lds + LDS_TAB_OFF);
    f32x4 g4[4];
#pragma unroll
    for (int j = 0; j < 4; ++j) g4[j] = *(const f32x4*)(ng + 4 * F.lane + 256 * j);
    for (int i0 = F.gw; i0 < nrows; i0 += 2 * F.NGW) {
        u32x2 xv[2][4], ya[2][4], yb[2][4]; int rr[2], mb[2], rc[2];
#pragma unroll
        for (int u = 0; u < 2; ++u) { const int i = i0 + u * F.NGW; const int ic = i < nrows ? i : i0;
            const int r = FINAL ? lat_row(ic) : ic; const int b = r / LT, pos = r % LT; rr[u] = i < nrows ? r : -1; rc[u] = r; mb[u] = pos < CTX ? 16 : b;
            const int* tp = (const int*)(F.ws + WS_TOKPOS) + (size_t)r * 2; const int t0 = tp[0], t1 = tp[1];
            const bf16_t* px = XS + (size_t)r * DM; const bf16_t* pa = Y2 + (size_t)(256 * ttab[432 + (t0 >> 16)] + (t0 & 0xffff)) * DM; const bf16_t* pb = Y2 + (size_t)(256 * ttab[432 + (t1 >> 16)] + (t1 & 0xffff)) * DM;
#pragma unroll
            for (int j = 0; j < 4; ++j) { const int c = 4 * F.lane + 256 * j; xv[u][j] = *(const u32x2*)(px + c); ya[u][j] = *(const u32x2*)(pa + c); yb[u][j] = *(const u32x2*)(pb + c); } }
#pragma unroll
        for (int u = 0; u < 2; ++u) { const float* grow = mvg + mb[u] * 6144; f32x4 v[4]; float ss = 0.f;
#pragma unroll
            for (int j = 0; j < 4; ++j) { const int c = 4 * F.lane + 256 * j; const f32x4 g = *(const f32x4*)(grow + c); const u32x2 a = ya[u][j], bb = yb[u][j], xx = xv[u][j];
                f32x4 m; m.x = bflo(a.x) + bflo(bb.x); m.y = bfhi(a.x) + bfhi(bb.x); m.z = bflo(a.y) + bflo(bb.y); m.w = bfhi(a.y) + bfhi(bb.y);
                const f32x4 x = {bflo(xx.x), bfhi(xx.x), bflo(xx.y), bfhi(xx.y)};
                v[j] = x + g * m; ss += (v[j].x * v[j].x + v[j].y * v[j].y) + (v[j].z * v[j].z + v[j].w * v[j].w); }
            const float rstd = 1.f / sqrtf(wave_sum(ss) * (1.f / DM) + EPS);
            if (rr[u] >= 0) {
                if (FINAL) { const int r = rc[u]; float* orow = out + (size_t)((r / LT) * SEQ + (r % LT) - CTX) * DM;
#pragma unroll
                    for (int j = 0; j < 4; ++j) *(f32x4*)(orow + 4 * F.lane + 256 * j) = v[j] * rstd * g4[j];
                } else {
                    const float* mrow = mvn + mb[u] * 6144; bf16_t* px = XS + (size_t)rc[u] * DM;
#pragma unroll
                    for (int j = 0; j < 4; ++j) { const int c = 4 * F.lane + 256 * j; *(u32x2*)(px + c) = (u32x2){pk2(v[j].x, v[j].y), pk2(v[j].z, v[j].w)};
                        const f32x4 sh = *(const f32x4*)(mrow + c), sc = *(const f32x4*)(mrow + 1024 + c); const f32x4 y = v[j] * rstd * g4[j] * (sc + 1.f) + sh;
                        *(u32x2*)(H + (size_t)rc[u] * DM + c) = (u32x2){pk2(y.x, y.y), pk2(y.z, y.w)}; }
                } } }
    }
}

#ifndef PROBE_NOROUTE
#define PROBE_NOROUTE 0
#endif
DI void norm2_route_phase(Frame& F, int layer, bool lat_only, const bf16_t* XS, bf16_t* H, bool dry = false) {
    int tid_ = F.tid; asm volatile("" : "+v"(tid_));
    const int tid = tid_, w = __builtin_amdgcn_readfirstlane(tid_ >> 6), l = tid_ & 63, r16 = l & 15, kq = l >> 4;
    LAS float* ssp = (LAS float*)F.lds;
    LAS float* lgp = ssp + 128;
    LAS float* lgs = lgp + 8 * 16 * 48;
    LAS int* hist = (LAS int*)(lgs + 16 * 49);
    LAS int* rbase = hist + 32;
    LAS int* lk = hist + 64;
    LAS float* lw = (LAS float*)(lk + 320);
    if (tid < 32) hist[tid] = 0;
    const int kb = 128 * w + 4 * kq;
    bf16x8 wf[3][4];
    { const bf16_t* WR = (const bf16_t*)(F.ws + WS_WR) + (size_t)layer * 256 * 1024 + kb;
#pragma unroll
      for (int cb = 0; cb < 3; ++cb)
#pragma unroll
          for (int s2 = 0; s2 < 4; ++s2) { const bf16_t* p = WR + (size_t)(16 * cb + r16) * 1024 + 32 * s2; const u32x2 b0 = *(const u32x2*)p, b1 = *(const u32x2*)(p + 16);
              wf[cb][s2] = __builtin_bit_cast(bf16x8, (u32x4){b0.x, b0.y, b1.x, b1.y}); } }
    f32x4 gq[4][2];
    { const float* ng = F.in_(I_NORMG) + (layer * 2 + 1) * 1024 + kb;
#pragma unroll
      for (int s2 = 0; s2 < 4; ++s2) { gq[s2][0] = *(const f32x4*)(ng + 32 * s2); gq[s2][1] = *(const f32x4*)(ng + 32 * s2 + 16); } }
    const float* mv = (const float*)(F.ws + WS_MODV) + (size_t)layer * 17 * 6144 + 3072 + kb;
    const int ngroups = (lat_only ? NB * SEQ : T) / 16, G = gdim_(), per = (ngroups + G - 1) / G;
    const int g_lo = bid_() * per, g_hi = (g_lo + per < ngroups) ? g_lo + per : ngroups;
    u32x2 xn[4][2];
    int gi = g_lo;
    if (gi < g_hi) { const int r0 = lat_only ? lat_row(gi * 16) : gi * 16; const bf16_t* xr = XS + (size_t)(r0 + r16) * DM + kb;
#pragma unroll
        for (int s2 = 0; s2 < 4; ++s2) { xn[s2][0] = *(const u32x2*)(xr + 32 * s2); xn[s2][1] = *(const u32x2*)(xr + 32 * s2 + 16); } }
    f32x4 gsv[4][2], shv[4][2]; int cur_m = -1;
    __syncthreads();
#pragma unroll 1
    for (; gi < g_hi; ++gi) {
        const int r0 = lat_only ? lat_row(gi * 16) : gi * 16; const int b = r0 / LT; const bool isc = (r0 % LT) < CTX; const int mi = isc ? 16 : b;
        u32x2 xc[4][2];
#pragma unroll
        for (int s2 = 0; s2 < 4; ++s2) { xc[s2][0] = xn[s2][0]; xc[s2][1] = xn[s2][1]; }
        if (gi + 1 < g_hi) { const int r1 = lat_only ? lat_row((gi + 1) * 16) : (gi + 1) * 16; const bf16_t* xr = XS + (size_t)(r1 + r16) * DM + kb;
#pragma unroll
            for (int s2 = 0; s2 < 4; ++s2) { xn[s2][0] = *(const u32x2*)(xr + 32 * s2); xn[s2][1] = *(const u32x2*)(xr + 32 * s2 + 16); } }
        if (mi != cur_m) { cur_m = mi; const float* mrow = mv + mi * 6144;
#pragma unroll
            for (int s2 = 0; s2 < 4; ++s2)
#pragma unroll
                for (int q = 0; q < 2; ++q) { const f32x4 sc = *(const f32x4*)(mrow + 1024 + 32 * s2 + 16 * q); shv[s2][q] = *(const f32x4*)(mrow + 32 * s2 + 16 * q); gsv[s2][q] = gq[s2][q] * (sc + 1.f); } }
        f32x4 xv[4][2]; float ss = 0.f;
#pragma unroll
        for (int s2 = 0; s2 < 4; ++s2)
#pragma unroll
            for (int q = 0; q < 2; ++q) { const u32x2 v = xc[s2][q]; xv[s2][q] = (f32x4){bflo(v.x), bfhi(v.x), bflo(v.y), bfhi(v.y)};
                ss += (xv[s2][q].x * xv[s2][q].x + xv[s2][q].y * xv[s2][q].y) + (xv[s2][q].z * xv[s2][q].z + xv[s2][q].w * xv[s2][q].w); }
        ss += __shfl_xor(ss, 16); ss += __shfl_xor(ss, 32);
        if (kq == 0) ssp[w * 16 + r16] = ss;
        __syncthreads();
        float tot = 0.f;
#pragma unroll
        for (int q = 0; q < 8; ++q) tot += ssp[q * 16 + r16];
        const float rstd = 1.f / sqrtf(tot * (1.f / DM) + EPS);
        f32x4 acc[3];
#pragma unroll
        for (int cb = 0; cb < 3; ++cb) acc[cb] = (f32x4){0.f, 0.f, 0.f, 0.f};
        bf16_t* hrow = H + (size_t)(r0 + r16) * DM + kb;
#pragma unroll
        for (int s2 = 0; s2 < 4; ++s2) { const int c0 = 32 * s2;
            const f32x4 y0 = xv[s2][0] * rstd * gsv[s2][0] + shv[s2][0], y1 = xv[s2][1] * rstd * gsv[s2][1] + shv[s2][1];
            const u32x4 hv = pack8(y0, y1);
            *(u32x2*)(hrow + c0) = (u32x2){hv.x, hv.y}; *(u32x2*)(hrow + c0 + 16) = (u32x2){hv.z, hv.w};
            const bf16x8 af = __builtin_bit_cast(bf16x8, hv);
#pragma unroll
            for (int cb = 0; cb < 3; ++cb) acc[cb] = MFMA16(af, wf[cb][s2], acc[cb]); }
#pragma unroll
        for (int cb = 0; cb < 3; ++cb)
#pragma unroll
            for (int i = 0; i < 4; ++i) lgp[(w * 16 + 4 * kq + i) * 48 + 16 * cb + r16] = acc[cb][i];
        __syncthreads();
        { const int row = tid >> 5, col = tid & 31; float a0 = 0.f, a1 = 0.f;
#pragma unroll
          for (int q = 0; q < 8; ++q) { a0 += lgp[(q * 16 + row) * 48 + col]; if (col < 4) a1 += lgp[(q * 16 + row) * 48 + 32 + col]; }
          lgs[row * 49 + col] = a0; if (col < 4) lgs[row * 49 + 32 + col] = a1; }
        __syncthreads();
        if (tid < 16 && !(dry && PROBE_NOROUTE)) {
            const int r = r0 + tid; const LAS float* lg = lgs + tid * 49;
            int gidx = 0; float gm = lg[0];
#pragma unroll
            for (int q = 1; q < 4; ++q) if (lg[q] > gm) { gm = lg[q]; gidx = q; }
            const float gp = 1.f / (__expf(lg[0] - gm) + __expf(lg[1] - gm) + __expf(lg[2] - gm) + __expf(lg[3] - gm));
            const LAS float* ev = lg + 4 + 8 * gidx;
            int i1 = 0; float l1 = ev[0];
#pragma unroll
            for (int q = 1; q < 8; ++q) if (ev[q] > l1) { l1 = ev[q]; i1 = q; }
            int i2 = -1; float l2 = -3.0e38f;
#pragma unroll
            for (int q = 0; q < 8; ++q) if (q != i1 && ev[q] > l2) { l2 = ev[q]; i2 = q; }
            const float w1 = 1.f / (1.f + __expf(l2 - l1)), w2 = 1.f - w1;
            int* te = (int*)(F.ws + WS_TOKE) + (size_t)r * 2; float* tw = (float*)(F.ws + WS_TOKW) + (size_t)r * 2;
            if (!dry) { te[0] = 8 * gidx + i1; te[1] = 8 * gidx + i2; tw[0] = gp * w1; tw[1] = gp * w2;
                const int ka = lds_add(&hist[8 * gidx + i1], 1), kb_ = lds_add(&hist[8 * gidx + i2], 1); const int tl = (gi - g_lo) * 16 + tid;
                lk[2 * tl] = (8 * gidx + i1) | (ka << 8); lk[2 * tl + 1] = (8 * gidx + i2) | (kb_ << 8); lw[2 * tl] = gp * w1; lw[2 * tl + 1] = gp * w2; }
        }
    }
    __syncthreads();
    if (!dry && tid < 32) rbase[tid] = hist[tid] ? (int)atomicAdd(F.ctl + CW_CNT + layer * 256 + tid, (unsigned)hist[tid]) : 0;
    __syncthreads();
    if (!dry && g_lo < g_hi) { const int ntl = (g_hi - g_lo) * 16;
        if (tid < 2 * ntl) { const int tl = tid >> 1, k = tid & 1; const int gi_ = g_lo + (tl >> 4); const int r = (lat_only ? lat_row(gi_ * 16) : gi_ * 16) + (tl & 15);
            const int v = lk[tid]; const int e = v & 255, rank = rbase[e] + (v >> 8);
            ((int*)(F.ws + WS_RANKTOK))[(size_t)e * T + rank] = 2 * r + k; ((float*)(F.ws + WS_RANKW))[(size_t)e * T + rank] = lw[tid];
            ((int*)(F.ws + WS_TOKPOS))[(size_t)r * 2 + k] = (e << 16) | rank; } }
    __syncthreads();
}

DI void route_phase(Frame& F, int layer, bool lat_only) {
    LAS int* hist = (LAS int*)F.lds;
    if (F.tid < 32) hist[F.tid] = 0;
    __syncthreads();
    const int gt = bid_() * NTHR + F.tid; const int ntok = lat_only ? NB * SEQ : T;
    if (gt < ntok) {
        const int r = lat_only ? lat_row(gt) : gt; const float* lg = (const float*)(F.ws + WS_LOGIT) + (size_t)r * 64;
        const f32x4 gl = *(const f32x4*)lg; int gi = 0; float gm = gl.x;
        if (gl.y > gm) { gm = gl.y; gi = 1; } if (gl.z > gm) { gm = gl.z; gi = 2; } if (gl.w > gm) { gm = gl.w; gi = 3; }
        const float gp = 1.f / (__expf(gl.x - gm) + __expf(gl.y - gm) + __expf(gl.z - gm) + __expf(gl.w - gm));
        const f32x4 e0 = *(const f32x4*)(lg + 4 + 8 * gi), e1 = *(const f32x4*)(lg + 8 + 8 * gi);
        const float ev[8] = {e0.x, e0.y, e0.z, e0.w, e1.x, e1.y, e1.z, e1.w};
        int i1 = 0; float l1 = ev[0];
#pragma unroll
        for (int i = 1; i < 8; ++i) if (ev[i] > l1) { l1 = ev[i]; i1 = i; }
        int i2 = -1; float l2 = -3.0e38f;
#pragma unroll
        for (int i = 0; i < 8; ++i) if (i != i1 && ev[i] > l2) { l2 = ev[i]; i2 = i; }
        const float w1 = 1.f / (1.f + __expf(l2 - l1)), w2 = 1.f - w1;
        int* te = (int*)(F.ws + WS_TOKE) + (size_t)r * 2; float* tw = (float*)(F.ws + WS_TOKW) + (size_t)r * 2;
        te[0] = 8 * gi + i1; te[1] = 8 * gi + i2; tw[0] = gp * w1; tw[1] = gp * w2;
        lds_add(&hist[8 * gi + i1], 1); lds_add(&hist[8 * gi + i2], 1);
    }
    __syncthreads();
    if (F.tid < 32 && hist[F.tid]) atomicAdd(F.ctl + CW_CNT + layer * 256 + F.tid, (unsigned)hist[F.tid]);
    __syncthreads();
}
DI void assign_phase(Frame& F, int layer, bool lat_only) {
    LAS int* hist = (LAS int*)F.lds; LAS int* offs = hist + 32; LAS int* base = hist + 64; LAS int* cnts = hist + 96;
    unsigned* cnt = F.ctl + CW_CNT + layer * 256; unsigned* cur = cnt + 128;
    if (F.tid < 32) { hist[F.tid] = 0; cnts[F.tid] = (int)__hip_atomic_load(cnt + F.tid, __ATOMIC_RELAXED, __HIP_MEMORY_SCOPE_AGENT); }
    __syncthreads();
    if (F.tid == 0) { int o = 0; for (int e = 0; e < 32; ++e) { offs[e] = o; o += (cnts[e] + 255) & ~255; } }
    const int gt = bid_() * NTHR + F.tid; const int ntok = lat_only ? NB * SEQ : T;
    int r = -1, e0 = 0, e1 = 0, k0 = 0, k1 = 0; float w0 = 0.f, w1 = 0.f;
    if (gt < ntok) { r = lat_only ? lat_row(gt) : gt; const int* te = (const int*)(F.ws + WS_TOKE) + (size_t)r * 2; const float* tw = (const float*)(F.ws + WS_TOKW) + (size_t)r * 2;
        e0 = te[0]; e1 = te[1]; w0 = tw[0]; w1 = tw[1]; k0 = lds_add(&hist[e0], 1); k1 = lds_add(&hist[e1], 1); }
    __syncthreads();
    if (F.tid < 32) base[F.tid] = hist[F.tid] ? (int)atomicAdd(cur + F.tid, (unsigned)hist[F.tid]) : 0;
    __syncthreads();
    int* rt = (int*)(F.ws + WS_ROWTOK); int* rd = (int*)(F.ws + WS_ROWDST); float* rw = (float*)(F.ws + WS_ROWW);
    if (r >= 0) { const int p0 = offs[e0] + base[e0] + k0, p1 = offs[e1] + base[e1] + k1;
        rt[p0] = r; rd[p0] = 2 * r; rw[p0] = w0; rt[p1] = r; rd[p1] = 2 * r + 1; rw[p1] = w1;
        int* tp = (int*)(F.ws + WS_TOKPOS) + (size_t)r * 2; tp[0] = p0; tp[1] = p1; }
    if (bid_() >= 128 && bid_() < 160) { const int e = bid_() - 128; const int lo = offs[e] + cnts[e], hi = offs[e] + ((cnts[e] + 255) & ~255);
        for (int p = lo + F.tid; p < hi; p += NTHR) { rt[p] = 0; rd[p] = -1; rw[p] = 0.f; } }
    __syncthreads();
}
DI const LAS int* moe_tile_table(Frame& F, int layer) {
    LAS int* tab = (LAS int*)(F.lds + LDS_TAB_OFF);
    __syncthreads();
    if (F.tid < 64) {
        const unsigned* cnt = F.ctl + CW_CNT + layer * 256; const int e = F.tid & 31;
        const int c = (int)__hip_atomic_load(cnt + e, __ATOMIC_RELAXED, __HIP_MEMORY_SCOPE_AGENT); const int nt = (c + 255) >> 8;
        int inc = nt;
#pragma unroll
        for (int o = 1; o < 32; o <<= 1) { const int v = __shfl_up(inc, o, 64); if ((F.tid & 31) >= o) inc += v; }
        if (F.tid < 32) { const int start = inc - nt; for (int i = 0; i < nt; ++i) tab[1 + start + i] = e | (i << 8); if (e == 31) tab[0] = inc; tab[400 + e] = c; tab[432 + e] = start; }
    }
    __syncthreads();
    return tab;
}

DI void l1_norm_phase(Frame& F) {
    bf16_t* CQ = (bf16_t*)(F.ws + WS_CQ); bf16_t* CKV = (bf16_t*)(F.ws + WS_CKV); bf16_t* KR = (bf16_t*)(F.ws + WS_KR);
    const f32x4 gq = *(const f32x4*)(F.in_(I_QNG) + 4 * F.lane); const f32x2 gk = *(const f32x2*)(F.in_(I_KVNG) + 2 * F.lane);
    const f32x2* rope = (const f32x2*)(F.ws + WS_ROPE1);
    const int g = (F.lane >> 3) & 1, i = F.lane & 7;
    for (int r0 = F.gw * 4; r0 < T; r0 += F.NGW * 4) {
        u32x2 a[4]; unsigned c[4]; unsigned short k0[4], k1[4];
#pragma unroll
        for (int u = 0; u < 4; ++u) { const int r = r0 + u; a[u] = *((const u32x2*)(CQ + (size_t)r * 256) + F.lane); c[u] = *((const unsigned*)(CKV + (size_t)r * 128) + F.lane);
            const bf16_t* kp = KR + (size_t)r * 32 + 16 * g + i; k0[u] = kp[0]; k1[u] = kp[8]; }
#pragma unroll
        for (int u = 0; u < 4; ++u) { const int r = r0 + u; const int pos = r % LT;
            { const float x0 = bflo(a[u].x), x1 = bfhi(a[u].x), x2 = bflo(a[u].y), x3 = bfhi(a[u].y);
              const float rstd = 1.f / sqrtf(wave_sum(x0 * x0 + x1 * x1 + x2 * x2 + x3 * x3) * (1.f / 256.f) + EPS);
              *((u32x2*)(CQ + (size_t)r * 256) + F.lane) = (u32x2){pk2(x0 * rstd * gq.x, x1 * rstd * gq.y), pk2(x2 * rstd * gq.z, x3 * rstd * gq.w)}; }
            { const float x0 = bflo(c[u]), x1 = bfhi(c[u]);
              const float rstd = 1.f / sqrtf(wave_sum(x0 * x0 + x1 * x1) * (1.f / 128.f) + EPS);
              *((unsigned*)(CKV + (size_t)r * 128) + F.lane) = pk2(x0 * rstd * gk.x, x1 * rstd * gk.y); }
            if (pos >= CTX && F.lane < 16) { bf16_t* kp = KR + (size_t)r * 32 + 16 * g + i;
                const float t1 = bf2f(k0[u]), t2 = bf2f(k1[u]); const f32x2 cs = rope[(size_t)(pos - CTX) * 16 + g * 8 + i];
                kp[0] = (bf16_t)f2bf(t1 * cs.x - t2 * cs.y); kp[8] = (bf16_t)f2bf(t1 * cs.y + t2 * cs.x); } }
    }
}

DI void s5_scan_phase(Frame& F) {
    const int gt = bid_() * NTHR + F.tid; if (gt >= 65536) return;
    const int p = gt & 63, d = (gt >> 6) & 1, b = (gt >> 7) & 15, g = gt >> 11;
    const f32x4 pr = ((const f32x4*)(F.ws + WS_S5PAR))[(d * 32 + g) * 64 + p];
    const float mg = __expf(32.f * pr.x); float sn, cs; sincosf(32.f * pr.y, &sn, &cs); const float lr = mg * cs, li = mg * sn;
    const float* S = (const float*)(F.ws + WS_S5S) + (size_t)g * 1280 * 256 + d * 128 + p; bf16_t* BM = (bf16_t*)(F.ws + WS_BMAT) + (size_t)g * 1280 * 768 + 512 + d * 128 + p;
    float xr = 0.f, xi = 0.f;
#pragma unroll 1
    for (int s0 = 0; s0 < 72; s0 += 24) {
        float sr[24], si[24];
#pragma unroll
        for (int q = 0; q < 24; ++q) { const int s = s0 + q; const int c = d == 0 ? s : (s < 8 ? 7 - s : 79 - s); const float* sp = S + (size_t)(c * 16 + b) * 256; sr[q] = sp[0]; si[q] = sp[64]; }
#pragma unroll
        for (int q = 0; q < 24; ++q) { const int s = s0 + q; const int c = d == 0 ? s : (s < 8 ? 7 - s : 79 - s); bf16_t* bp = BM + (size_t)(c * 16 + b) * 768;
            bp[0] = (bf16_t)f2bf(xr); bp[64] = (bf16_t)f2bf(xi);
            const float nr = lr * xr - li * xi + sr[q], ni = lr * xi + li * xr + si[q]; xr = nr; xi = ni; }
    }
}

template <bool CM, int PM = 0>
DI void hyena_unit(Frame& F, int c0) {
    constexpr int n = CM ? 256 : 2048, UP = n + 8, NCH = n / 8, GC = 2 * n + 8;
    int tid_ = F.tid; asm volatile("" : "+v"(tid_));
    const int w = __builtin_amdgcn_readfirstlane(tid_ >> 6), l = tid_ & 63, c = CM ? c0 + w : c0, seg0 = CM ? 0 : CTX, tw = CM ? 0 : 256 * w;
    LAS bf16_t* U = (LAS bf16_t*)F.lds + (CM ? w * (16 * UP) : 0);
    LAS bf16_t* G = (LAS bf16_t*)(F.lds + (CM ? 8 * 16 * UP * 2 : 16 * UP * 2)) + (CM ? w * (8 * GC) : 0);
    const bf16_t* HyT = (const bf16_t*)(F.ws + WS_HYT); bf16_t* HoT = (bf16_t*)(F.ws + WS_HOT);
    const float* cw = F.in_(I_HCW); const float* cb = F.in_(I_HCB);
    const float* grbase = (const float*)(F.ws + (CM ? WS_GRAWC : WS_GRAW)) + (size_t)c * (2 * n);
    const int j0 = (CM ? l : tid_) * 8;
    f32x4 gq[4];
#define HY_LOAD_FILTER(o_) do { const float* gr_ = grbase + (size_t)(o_) * 512 * (2 * n); \
        _Pragma("unroll") for (int q = 0; q < 4; ++q) { const int jj = (j0 + 4 * q) < 2 * n ? j0 + 4 * q : 0; gq[q] = *(const f32x4*)(gr_ + jj); } } while (0)
    HY_LOAD_FILTER(0);
    { const int ch = 1024 + c; const float w0 = cw[ch], w1 = cw[1536 + ch], w2 = cw[3072 + ch], bs = cb[ch];
      u32x4 raw[8]; unsigned short pvr[8], nvr[8];
#pragma unroll
      for (int i = 0; i < 8; ++i) { const int q = CM ? l + 64 * i : tid_ + 512 * i; const int b = q / NCH, s0 = (q % NCH) * 8;
          const bf16_t* src = HyT + (size_t)ch * T + b * LT + seg0;
          raw[i] = *(const u32x4*)(src + s0); pvr[i] = src[s0 > 0 ? s0 - 1 : 0]; nvr[i] = src[s0 + 8 < n ? s0 + 8 : n - 1]; }
#pragma unroll
      for (int i = 0; i < 8; ++i) { const int q = CM ? l + 64 * i : tid_ + 512 * i; const int b = q / NCH, s0 = (q % NCH) * 8;
          const float pv = s0 > 0 ? bf2f(pvr[i]) : 0.f, nv = s0 + 8 < n ? bf2f(nvr[i]) : 0.f;
          const float v[10] = {pv, bflo(raw[i].x), bfhi(raw[i].x), bflo(raw[i].y), bfhi(raw[i].y), bflo(raw[i].z), bfhi(raw[i].z), bflo(raw[i].w), bfhi(raw[i].w), nv};
          float o[8];
#pragma unroll
          for (int e = 0; e < 8; ++e) o[e] = w0 * v[e] + w1 * v[e + 1] + w2 * v[e + 2] + bs;
          *(LAS u32x4*)(U + b * UP + s0) = (u32x4){pk2(o[0], o[1]), pk2(o[2], o[3]), pk2(o[4], o[5]), pk2(o[6], o[7])}; } }
#pragma unroll 1
    for (int o = 0; o < 2; ++o) {
        int ll = l; asm volatile("" : "+v"(ll));
        const int lb = n + 8 * (ll >> 4) - (ll & 15);
        const int rr = lb & 7, gl = rr * GC + lb - rr;
        const int j0l = CM ? ll * 8 : (w * 64 + ll) * 8;
        if (o == 1) { const float* gr_ = grbase + (size_t)512 * (2 * n);
#pragma unroll
            for (int q = 0; q < 4; ++q) { const int jj = (j0l + 4 * q) < 2 * n ? j0l + 4 * q : 0; gq[q] = *(const f32x4*)(gr_ + jj); } }
        { float nfs = 0.f;
          { const float* part = (const float*)(F.ws + (CM ? WS_HYPARTC : WS_HYPART)) + o * 512 + c;
            nfs = part[(size_t)(ll >> 1) * 2048 + (ll & 1) * 1024]; }
          const float nf = 1.f / sqrtf(wave_sum(nfs) + EPS); float gv[16];
#pragma unroll
          for (int q = 0; q < 4; ++q) { const bool ok = (j0l + 4 * q) < 2 * n; const f32x4 a = ok ? gq[q] : (f32x4){0.f, 0.f, 0.f, 0.f};
              gv[4 * q] = a.x * nf; gv[4 * q + 1] = a.y * nf; gv[4 * q + 2] = a.z * nf; gv[4 * q + 3] = a.w * nf; }
          unsigned pe[8], po[7];
#pragma unroll
          for (int i = 0; i < 8; ++i) pe[i] = pk2(gv[2 * i], gv[2 * i + 1]);
#pragma unroll
          for (int i = 0; i < 7; ++i) po[i] = pk2(gv[2 * i + 1], gv[2 * i + 2]);
#pragma unroll
          for (int r = 0; r < 8; ++r) { const int h2 = r >> 1; const u32x4 val = (r & 1) ? (u32x4){po[h2], po[h2 + 1], po[h2 + 2], po[h2 + 3]} : (u32x4){pe[h2], pe[h2 + 1], pe[h2 + 2], pe[h2 + 3]};
              *(LAS u32x4*)(G + r * GC + j0l) = val; } }
        const int xch = o == 0 ? c : 512 + c;
        const int lq = ll >> 4;
        const int b = ll & 15;
        const bf16_t* xs = HyT + (size_t)xch * T + b * LT + seg0;
        u32x2 xraw[16];
#pragma unroll
        for (int I = 0; I < 16; ++I) xraw[I] = *(const u32x2*)(xs + tw + 16 * I + 4 * lq);
        const unsigned short xe_prev = xs[tw > 0 ? tw - 1 : 0], xe_next = xs[tw + 256 < n ? tw + 256 : n - 1];
        __syncthreads();
        f32x4 acc[16];
#pragma unroll
        for (int I = 0; I < 16; ++I) acc[I] = (f32x4){0.f, 0.f, 0.f, 0.f};
        bf16x8 Fw[16];
        const LAS bf16_t* gb = G + gl - tw;
#pragma unroll
        for (int I = 0; I < 16; ++I) Fw[I] = *(const LAS bf16x8*)(gb - 16 * I);
        const LAS bf16_t* ub = U + (ll & 15) * UP + 8 * (ll >> 4);
        bf16x8 bfr = *(const LAS bf16x8*)ub;
#pragma unroll 1
        for (int K0 = 0; K0 < (PM == 2 ? 256 : n); K0 += 256) {
#pragma unroll
            for (int s = 0; s < 8; ++s) {
                const int k0 = K0 + 32 * s;
                const int kk = (k0 + 32 < n) ? k0 + 32 : k0;
                const bf16x8 bnx = *(const LAS bf16x8*)(ub + kk);
                const bf16x8 n0 = *(const LAS bf16x8*)(gb + kk), n1 = *(const LAS bf16x8*)(gb + kk - 16);
#pragma unroll
                for (int I = 0; I < 16; ++I) acc[I] = MFMA16(Fw[(I - 2 * s) & 15], bfr, acc[I]);
                Fw[(14 - 2 * s) & 15] = n0; Fw[(15 - 2 * s) & 15] = n1; bfr = bnx;
                __builtin_amdgcn_sched_barrier(0);
            }
        }
        __syncthreads();
        const float fb = F.in_(I_HFB)[o * 512 + c];
        const float w0 = cw[xch], w1 = cw[1536 + xch], w2 = cw[3072 + xch], bs = cb[xch];
        unsigned spm1 = (unsigned)xe_prev, sn_cur = (unsigned)__shfl((int)(xraw[0].x & 0xffffu), (ll + 16) & 63);
#pragma unroll
        for (int I = 0; I < 16; ++I) { const int t = tw + 16 * I + 4 * lq;
            const u32x2 raw = xraw[I];
            const unsigned sp_cur = (unsigned)__shfl((int)(raw.y >> 16), (ll - 16) & 63);
            const unsigned sn_next = I < 15 ? (unsigned)__shfl((int)(xraw[I < 15 ? I + 1 : 15].x & 0xffffu), (ll + 16) & 63) : (unsigned)xe_next;
            const unsigned pvb = lq > 0 ? sp_cur : spm1, nvb = lq < 3 ? sn_cur : sn_next;
            spm1 = sp_cur; sn_cur = sn_next;
            const float pv = t > 0 ? bf2f((unsigned short)pvb) : 0.f, nv = t + 4 < n ? bf2f((unsigned short)nvb) : 0.f;
            const float v[6] = {pv, bflo(raw.x), bfhi(raw.x), bflo(raw.y), bfhi(raw.y), nv};
            const u32x2 uu = *(const LAS u32x2*)(U + b * UP + t); const float uf[4] = {bflo(uu.x), bfhi(uu.x), bflo(uu.y), bfhi(uu.y)};
            float r[4];
#pragma unroll
            for (int e = 0; e < 4; ++e) { const float xc = w0 * v[e] + w1 * v[e + 1] + w2 * v[e + 2] + bs; r[e] = xc * (acc[I][e] + uf[e] * fb); }
            if (o == 0) *(LAS u32x2*)(U + b * UP + t) = (u32x2){pk2(r[0], r[1]), pk2(r[2], r[3])};
            else if (PM != 1) *(u32x2*)(HoT + (size_t)c * T + b * LT + seg0 + t) = (u32x2){pk2(r[0], r[1]), pk2(r[2], r[3])};
            if ((I & 3) == 3) __builtin_amdgcn_sched_barrier(0); }
        __syncthreads();
    }
#undef HY_LOAD_FILTER
}

DI void hot_transpose_phase(Frame& F) {
    const bf16_t* HoT = (const bf16_t*)(F.ws + WS_HOT); bf16_t* MIX = (bf16_t*)F.out;
    LAS unsigned* scr = (LAS unsigned*)(F.lds + F.wave * 16384);
    const int l = F.lane, lr = l >> 3, lc = l & 7;
    constexpr int NIT = 8 * (T / 64);
    u32x4 vn[8];
    if (F.gw < NIT) { const int c0 = (F.gw & 7) * 64, t0 = (F.gw >> 3) * 64;
#pragma unroll
        for (int i = 0; i < 8; ++i) vn[i] = *(const u32x4*)(HoT + (size_t)(c0 + 8 * i + lr) * T + t0 + 8 * lc); }
    for (int it = F.gw; it < NIT; it += F.NGW) {
        const int c0 = (it & 7) * 64, t0 = (it >> 3) * 64;
        u32x4 v[8];
#pragma unroll
        for (int i = 0; i < 8; ++i) v[i] = vn[i];
        if (it + F.NGW < NIT) { const int itn = it + F.NGW; const int c1 = (itn & 7) * 64, t1 = (itn >> 3) * 64;
#pragma unroll
            for (int i = 0; i < 8; ++i) vn[i] = *(const u32x4*)(HoT + (size_t)(c1 + 8 * i + lr) * T + t1 + 8 * lc); }
#pragma unroll
        for (int i = 0; i < 8; ++i) { LAS unsigned* p = scr + (8 * i + lr) * 33 + 4 * lc; p[0] = v[i].x; p[1] = v[i].y; p[2] = v[i].z; p[3] = v[i].w; }
        LDS_WAIT(); asm volatile("" ::: "memory");
#pragma unroll
        for (int i = 0; i < 8; ++i) { const int tt = 8 * i + lr; const LAS unsigned short* q = (const LAS unsigned short*)scr + tt + (8 * lc) * 66;
            unsigned e[8];
#pragma unroll
            for (int k = 0; k < 8; ++k) e[k] = q[k * 66];
            *(u32x4*)(MIX + (size_t)(t0 + tt) * DM + c0 + 8 * lc) = (u32x4){e[0] | (e[1] << 16), e[2] | (e[3] << 16), e[4] | (e[5] << 16), e[6] | (e[7] << 16)}; }
        LDS_WAIT(); asm volatile("" ::: "memory");
    }
}

DI float max3f(float a, float b, float c) { float r; asm("v_max3_f32 %0, %1, %2, %3" : "=v"(r) : "v"(a), "v"(b), "v"(c)); return r; }
typedef short s16x4 __attribute__((ext_vector_type(4)));
DI bf16x8 vtr8(const LAS bf16_t* p0, const LAS bf16_t* p1) {
    const s16x4 a = __builtin_bit_cast(s16x4, __builtin_amdgcn_ds_read_tr16_b64_v4i16((LAS s16x4*)p0)), b = __builtin_bit_cast(s16x4, __builtin_amdgcn_ds_read_tr16_b64_v4i16((LAS s16x4*)p1));
    return (bf16x8){a[0], a[1], a[2], a[3], b[0], b[1], b[2], b[3]};
}
template <int DK, bool MLA, int APM = 0>
DI void attn_unit(Frame& F, const bf16_t* Q, int ldq, int qcol, const bf16_t* Kp, int ldk, int kcol, const bf16_t* KRp, const bf16_t* Vp, int ldv, int vcol,
                  bf16_t* O, int ocol, int qrow0, int krow0, int nkeys) {
    constexpr int KP = DK + 8, VP = 96, KS = DK / 16;
    int tid_ = F.tid; asm volatile("" : "+v"(tid_));
    const int tid = tid_, w = __builtin_amdgcn_readfirstlane(tid_ >> 6), l = tid_ & 63, n = l & 31, h = l >> 5;
    LAS bf16_t* Kb = (LAS bf16_t*)F.lds;
    LAS bf16_t* Vt = Kb + 2 * 64 * KP;
    bf16x8 qf[KS];
    { const bf16_t* qp = Q + (size_t)(qrow0 + 32 * w + n) * ldq + qcol + 8 * h;
#pragma unroll
      for (int ks = 0; ks < KS; ++ks) qf[ks] = *(const bf16x8*)(qp + 16 * ks); }
    const int kkey = tid >> 3, kch = tid & 7, rkey = tid >> 2, rch = tid & 3;
    const bf16_t* kg = Kp + (size_t)(krow0 + kkey) * ldk + kcol + 8 * kch;
    const bf16_t* rg = MLA ? KRp + (size_t)(krow0 + (rkey & 63)) * 32 + 8 * rch : nullptr;
    const bf16_t* vg = Vp + (size_t)(krow0 + kkey) * ldv + vcol + 8 * kch;
    const int pim = 16 * (n >> 4) + 8 * ((n >> 2) & 1) + 4 * ((n >> 3) & 1) + (n & 3);
    const int nt = nkeys >> 6;
    const int vtr_off = (8 * h + ((l >> 2) & 3)) * VP + 16 * ((l >> 4) & 1) + 4 * (l & 3);
    u32x4 kA, rA = (u32x4){0, 0, 0, 0}, vA, kB, rB = (u32x4){0, 0, 0, 0}, vB;
#define ATT_LOAD(KR_, RR_, VR_, tile) do { const size_t ko_ = (size_t)(tile) * 64; KR_ = *(const u32x4*)(kg + ko_ * ldk); if (MLA && tid < 256) RR_ = *(const u32x4*)(rg + ko_ * 32); VR_ = *(const u32x4*)(vg + ko_ * ldv); } while (0)
#define ATT_STAGE(buf, KR_, RR_, VR_) do { \
        *(LAS u32x4*)(Kb + (buf) * 64 * KP + kkey * KP + 8 * kch) = KR_; \
        if (MLA && tid < 256) *(LAS u32x4*)(Kb + (buf) * 64 * KP + rkey * KP + 64 + 8 * rch) = RR_; \
        *(LAS u32x4*)(Vt + (buf) * 64 * VP + kkey * VP + 8 * kch) = VR_; } while (0)
    ATT_LOAD(kA, rA, vA, 0);
    if (nt > 1) ATT_LOAD(kB, rB, vB, 1);
    __syncthreads();
    ATT_STAGE(0, kA, rA, vA);
    __syncthreads();
    f32x16 O0, O1, negm;
#pragma unroll
    for (int i = 0; i < 16; ++i) { O0[i] = 0.f; O1[i] = 0.f; negm[i] = 0.f; }
    float lrun = 0.f;
#define ATT_TILE(buf) do { \
        f32x16 S0, S1; \
        const LAS bf16_t* kb0 = Kb + (buf) * 64 * KP + pim * KP + 8 * h; \
        bf16x8 ka[KS], kc[KS];                   \
        _Pragma("unroll") for (int ks = 0; ks < KS; ++ks) { ka[ks] = *(const LAS bf16x8*)(kb0 + 16 * ks); kc[ks] = *(const LAS bf16x8*)(kb0 + 32 * KP + 16 * ks); } \
        const LAS bf16_t* vb = Vt + (buf) * 64 * VP + vtr_off; \
        bf16x8 va[2][2], vc[2][2];               \
        _Pragma("unroll") for (int kb = 0; kb < 2; ++kb) \
            _Pragma("unroll") for (int s = 0; s < 2; ++s) { const LAS bf16_t* vq = vb + (32 * kb + 16 * s) * VP; va[kb][s] = vtr8(vq, vq + 4 * VP); vc[kb][s] = vtr8(vq + 32, vq + 4 * VP + 32); } \
        __builtin_amdgcn_sched_barrier(0); \
        if (APM != 2) { S0 = MFMA32(ka[0], qf[0], negm); S1 = MFMA32(kc[0], qf[0], negm); \
        _Pragma("unroll") for (int ks = 1; ks < KS; ++ks) { S0 = MFMA32(ka[ks], qf[ks], S0); S1 = MFMA32(kc[ks], qf[ks], S1); } } \
        else { _Pragma("unroll") for (int i = 0; i < 16; ++i) { S0[i] = __builtin_bit_cast(float, (unsigned)ka[i % KS][0] & 0x3f800000u); S1[i] = __builtin_bit_cast(float, (unsigned)kc[i % KS][1] & 0x3f800000u); } } \
        asm volatile("s_nop 15\n\ts_nop 15" : "+v"(S0), "+v"(S1));       \
        if (APM != 1) { \
        float mx = max3f(S0[0], S1[0], S0[1]), mx2 = max3f(S1[1], S0[2], S1[2]); \
        _Pragma("unroll") for (int i = 3; i < 15; i += 2) { mx = max3f(mx, S0[i], S1[i]); mx2 = max3f(mx2, S0[i + 1], S1[i + 1]); } \
        mx = max3f(mx, S0[15], S1[15]); mx = max3f(mx, mx2, __shfl_xor(max3f(mx, mx2, mx2), 32)); \
        if (__any(mx > 8.f || mx < -24.f)) { \
            const float sc = __builtin_amdgcn_exp2f(-mx); \
            _Pragma("unroll") for (int i = 0; i < 16; ++i) { S0[i] -= mx; S1[i] -= mx; O0[i] *= sc; O1[i] *= sc; negm[i] -= mx; } \
            lrun *= sc; \
        } \
        float rs = 0.f; \
        _Pragma("unroll") for (int i = 0; i < 16; ++i) { S0[i] = __builtin_amdgcn_exp2f(S0[i]); S1[i] = __builtin_amdgcn_exp2f(S1[i]); rs += S0[i] + S1[i]; } \
        lrun += rs; } \
        bf16x8 pf[2][2]; \
        _Pragma("unroll") for (int s = 0; s < 2; ++s) { \
            pf[0][s] = __builtin_bit_cast(bf16x8, (u32x4){pk2(S0[8 * s], S0[8 * s + 1]), pk2(S0[8 * s + 2], S0[8 * s + 3]), pk2(S0[8 * s + 4], S0[8 * s + 5]), pk2(S0[8 * s + 6], S0[8 * s + 7])}); \
            pf[1][s] = __builtin_bit_cast(bf16x8, (u32x4){pk2(S1[8 * s], S1[8 * s + 1]), pk2(S1[8 * s + 2], S1[8 * s + 3]), pk2(S1[8 * s + 4], S1[8 * s + 5]), pk2(S1[8 * s + 6], S1[8 * s + 7])}); } \
        _Pragma("unroll") for (int kb = 0; kb < 2; ++kb) \
            _Pragma("unroll") for (int s = 0; s < 2; ++s) { if (APM != 2) { O0 = MFMA32(va[kb][s], pf[kb][s], O0); O1 = MFMA32(vc[kb][s], pf[kb][s], O1); } else { O0[kb * 2 + s] += __builtin_bit_cast(float, (unsigned)(va[kb][s][0] ^ pf[kb][s][1]) & 0x3f800000u); O1[kb * 2 + s] += __builtin_bit_cast(float, (unsigned)(vc[kb][s][0] ^ pf[kb][s][2]) & 0x3f800000u); } } \
    } while (0)
#pragma unroll 1
    for (int t = 0; t < nt; t += 2) {
        if (t + 2 < nt) ATT_LOAD(kA, rA, vA, t + 2);
        ATT_TILE(0);
        ATT_STAGE(1, kB, rB, vB);
        __syncthreads();
        if (t + 3 < nt) ATT_LOAD(kB, rB, vB, t + 3);
        ATT_TILE(1);
        if (t + 2 < nt) ATT_STAGE(0, kA, rA, vA);
        __syncthreads();
    }
#undef ATT_LOAD
#undef ATT_STAGE
#undef ATT_TILE
    const float inv = 1.f / (lrun + __shfl_xor(lrun, 32));
    if (APM != 0 && inv != 12345.678f) return;
    bf16_t* op = O + (size_t)(qrow0 + 32 * w + n) * DM + ocol + 4 * h;
#pragma unroll
    for (int jj = 0; jj < 4; ++jj) {
        *(u32x2*)(op + 8 * jj) = (u32x2){pk2(O0[4 * jj] * inv, O0[4 * jj + 1] * inv), pk2(O0[4 * jj + 2] * inv, O0[4 * jj + 3] * inv)};
        *(u32x2*)(op + 32 + 8 * jj) = (u32x2){pk2(O1[4 * jj] * inv, O1[4 * jj + 1] * inv), pk2(O1[4 * jj + 2] * inv, O1[4 * jj + 3] * inv)}; }
}

template <int K, int NCH, int SKP = 0, class Epi>
DI void skinny_unit(Frame& F, int tid_in, const bf16_t* Arow0, int lda, const bf16_t* Bg, const Epi& epi) {
    int tid = tid_in; asm volatile("" : "+v"(tid));
    constexpr int KPD = K + 8, CH = 64, BSZ = CH * KPD, NS = K / 32, NPC = (CH * K / 8) / NTHR;
    const int w = __builtin_amdgcn_readfirstlane(tid >> 6), l = tid & 63, r16 = l & 15, fq = l >> 4;
    LAS bf16_t* Bs = (LAS bf16_t*)F.lds;
    int s_goff[NPC], s_loff[NPC];
#pragma unroll
    for (int j = 0; j < NPC; ++j) { const int e = tid + NTHR * j, cc = e / (K / 8), kc = e % (K / 8); const int rho = 16 * (2 * (cc >> 5) + ((cc >> 2) & 1)) + 4 * ((cc >> 3) & 3) + (cc & 3);
        s_goff[j] = cc * K + 8 * kc; s_loff[j] = rho * KPD + 8 * kc; }
    bf16x8 af[2][NS];
#pragma unroll
    for (int rb = 0; rb < 2; ++rb) { const bf16_t* ap = Arow0 + (size_t)(32 * w + 16 * rb + r16) * lda + 8 * fq;
#pragma unroll
        for (int s2 = 0; s2 < NS; ++s2) af[rb][s2] = *(const bf16x8*)(ap + 32 * s2); }
    u32x4 st[2][NPC];
#define SK_LOAD(set, chunk) do { _Pragma("unroll") for (int j = 0; j < NPC; ++j) st[set][j] = *(const u32x4*)(Bg + (size_t)(chunk) * CH * K + s_goff[j]); } while (0)
#define SK_STAGE(set, buf_) do { _Pragma("unroll") for (int j = 0; j < NPC; ++j) *(LAS u32x4*)(Bs + (buf_) * BSZ + s_loff[j]) = st[set][j]; } while (0)
    SK_LOAD(0, 0); SK_LOAD(1, 1);
    __syncthreads();
    SK_STAGE(0, 0); if (2 < NCH) SK_LOAD(0, 2);
    __syncthreads();
#define SK_STEP(ch, nset) do { \
        const int buf = (ch) & 1; \
        f32x4 acc[2][4]; \
        _Pragma("unroll") for (int rb = 0; rb < 2; ++rb) _Pragma("unroll") for (int cg = 0; cg < 4; ++cg) acc[rb][cg] = (f32x4){0.f, 0.f, 0.f, 0.f}; \
        const LAS bf16_t* bb = Bs + buf * BSZ + r16 * KPD + 8 * fq; \
        if (SKP != 1 && SKP != 3) { constexpr int NG = 4 * (NS / 4); bf16x8 bfr[2][4];            \
          _Pragma("unroll") for (int s2 = 0; s2 < 4; ++s2) bfr[0][s2] = *(const LAS bf16x8*)(bb + 32 * s2); \
          _Pragma("unroll") for (int g = 0; g < NG; ++g) { const int cg = g / (NS / 4), sh = 4 * (g % (NS / 4)); \
            if (g + 1 < NG) { const int cg1 = (g + 1) / (NS / 4), sh1 = 4 * ((g + 1) % (NS / 4)); \
                _Pragma("unroll") for (int s2 = 0; s2 < 4; ++s2) bfr[(g + 1) & 1][s2] = *(const LAS bf16x8*)(bb + (16 * cg1) * KPD + 32 * (sh1 + s2)); } \
            __builtin_amdgcn_sched_barrier(0); \
            _Pragma("unroll") for (int s2 = 0; s2 < 4; ++s2) { acc[0][cg] = MFMA16(bfr[g & 1][s2], af[0][sh + s2], acc[0][cg]); acc[1][cg] = MFMA16(bfr[g & 1][s2], af[1][sh + s2], acc[1][cg]); } \
            __builtin_amdgcn_sched_barrier(0); } } \
        if (SKP != 2 && SKP != 3) { _Pragma("unroll") for (int rb = 0; rb < 2; ++rb) _Pragma("unroll") for (int cp = 0; cp < 2; ++cp) epi(rb, (ch), cp, acc[rb][2 * cp], acc[rb][2 * cp + 1]); } \
        else { float sx_ = 0.f; _Pragma("unroll") for (int rb = 0; rb < 2; ++rb) _Pragma("unroll") for (int cg = 0; cg < 4; ++cg) sx_ += acc[rb][cg][0] + acc[rb][cg][1] + acc[rb][cg][2] + acc[rb][cg][3]; if (sx_ == 12345.678f) epi(0, (ch), 0, acc[0][0], acc[0][1]); } \
        if ((ch) + 1 < NCH) { SK_STAGE(nset, buf ^ 1); if ((ch) + 3 < NCH) SK_LOAD(nset, (ch) + 3); } \
        __syncthreads(); \
    } while (0)
#pragma unroll 1
    for (int c2 = 0; c2 < NCH; c2 += 2) { SK_STEP(c2, 1); SK_STEP(c2 + 1, 0); }
#undef SK_LOAD
#undef SK_STAGE
#undef SK_STEP
}
template <int SKP = 0>
DI void moe_down_phase(Frame& F, int layer, const LAS int* tab) {
    int tid_ = F.tid; asm volatile("" : "+v"(tid_));
    const int tid = tid_, w = __builtin_amdgcn_readfirstlane(tid_ >> 6), r16 = tid_ & 15, fq = (tid_ & 63) >> 4;
    const bf16_t* HID = (const bf16_t*)(F.ws + WS_HID); const bf16_t* WDN = (const bf16_t*)(F.ws + WS_WDN); bf16_t* Y2 = (bf16_t*)(F.ws + WS_Y2);
    const float* row_w = (const float*)(F.ws + WS_ROWW);
    const int nunits = 2 * tab[0]; (void)layer;
#pragma unroll 1
    for (int u = bid_(); u < nunits; u += gdim_()) {
        const int tile = u >> 1, nh = u & 1, e = tab[1 + tile];
        float wg[2];
#pragma unroll
        for (int rb = 0; rb < 2; ++rb) { const int r = tile * 256 + 32 * w + 16 * rb + r16; wg[rb] = row_w[r]; }
        auto epi = [&](int rb, int ch, int cp, const f32x4& v0, const f32x4& v1) {
            *(u32x4*)(Y2 + (size_t)(tile * 256 + 32 * w + 16 * rb + r16) * 1024 + 512 * nh + 64 * ch + 32 * cp + 8 * fq) = pack8(v0 * wg[rb], v1 * wg[rb]); };
        skinny_unit<256, 8, SKP>(F, tid, HID + (size_t)tile * 256 * 256, 256, WDN + (size_t)e * 1024 * 256 + (size_t)(512 * nh) * 256, epi);
    }
}
DI int queue_next(Frame& F, unsigned* qw) {
    LAS int* slot = (LAS int*)(F.lds + MISC_OFF + 64);
    __syncthreads();
    if (F.tid == 0) *slot = (int)atomicAdd(qw, 1u);
    __syncthreads();
    return *slot;
}
DI void l1_upproj_phase(Frame& F) {
    int tid_ = F.tid; asm volatile("" : "+v"(tid_));
    const int tid = tid_, w = __builtin_amdgcn_readfirstlane(tid_ >> 6), r16 = tid_ & 15, fq = (tid_ & 63) >> 4;
    const bf16_t* CQ = (const bf16_t*)(F.ws + WS_CQ); const bf16_t* CKV = (const bf16_t*)(F.ws + WS_CKV);
    bf16_t* QM = (bf16_t*)(F.ws + WS_QM); bf16_t* KN = (bf16_t*)(F.ws + WS_KN); bf16_t* VM = (bf16_t*)(F.ws + WS_VM);
    const f32x2* rope = (const f32x2*)(F.ws + WS_ROPE1); const float qs = 0.10206207261596575f * LOG2E;
    const float* rowss = (const float*)(F.ctl + CW_ROWSS);
    constexpr int NQ = 128 * 3, NKV = NPAN * 2;
#pragma unroll 1
    for (int u = bid_(); u < NQ + NKV; u += gdim_()) {
        if (u < NQ) {
            const int pl = u / 3, nt3 = u % 3, panel = (pl >> 3) * 9 + 1 + (pl & 7), row0 = panel * 256;
            float rq[2];
#pragma unroll
            for (int rb = 0; rb < 2; ++rb) rq[rb] = qs / sqrtf(rowss[row0 + 32 * w + 16 * rb + r16] * (1.f / 256.f) + EPS);
            auto epi = [&](int rb, int ch, int cp, const f32x4& v0, const f32x4& v1) {
                const int r = row0 + 32 * w + 16 * rb + r16; bf16_t* rp = QM + (size_t)r * 768;
                if (nt3 < 2) { const int v = nt3 * 256 + 64 * ch + 32 * cp + 8 * fq; *(u32x4*)(rp + (v >> 6) * 96 + (v & 63)) = pack8(v0 * rq[rb], v1 * rq[rb]); }
                else { (void)v0; (void)v1; } };
            if (nt3 < 2) skinny_unit<256, 4>(F, tid, CQ + (size_t)row0 * 256, 256, (const bf16_t*)(F.ws + WS_WUQ) + (size_t)(nt3 * 256) * 256, epi);
            else {
                f32x4 keep[2][2];
                auto epr = [&](int rb, int ch, int cp, const f32x4& v0, const f32x4& v1) {
                    if (cp == 0) { keep[rb][0] = v0; keep[rb][1] = v1; return; }
                    const int r = row0 + 32 * w + 16 * rb + r16, pos = r % LT; const int head = 2 * ch + (fq >> 1), g = fq & 1;
                    const f32x2* cpn = rope + (size_t)(pos - CTX) * 16 + g * 8; f32x4 o[2][2];
#pragma unroll
                    for (int j = 0; j < 8; ++j) { const f32x2 cs = cpn[j]; const float t1 = keep[rb][j >> 2][j & 3], t2 = (j < 4 ? v0 : v1)[j & 3];
                        o[0][j >> 2][j & 3] = (t1 * cs.x - t2 * cs.y) * rq[rb]; o[1][j >> 2][j & 3] = (t1 * cs.y + t2 * cs.x) * rq[rb]; }
                    bf16_t* rp = QM + (size_t)r * 768 + head * 96 + 64 + 16 * g;
                    *(u32x4*)rp = pack8(o[0][0], o[0][1]); *(u32x4*)(rp + 8) = pack8(o[1][0], o[1][1]); };
                skinny_unit<256, 4>(F, tid, CQ + (size_t)row0 * 256, 256, (const bf16_t*)(F.ws + WS_WUQ) + (size_t)512 * 256, epr);
            }
        } else {
            const int uu = u - NQ, panel = uu >> 1, nh = uu & 1, row0 = panel * 256; bf16_t* base = nh ? VM : KN;
            float rk[2];
#pragma unroll
            for (int rb = 0; rb < 2; ++rb) rk[rb] = 1.f / sqrtf(rowss[T + row0 + 32 * w + 16 * rb + r16] * (1.f / 128.f) + EPS);
            auto epi = [&](int rb, int ch, int cp, const f32x4& v0, const f32x4& v1) {
                *(u32x4*)(base + (size_t)(row0 + 32 * w + 16 * rb + r16) * 512 + 64 * ch + 32 * cp + 8 * fq) = pack8(v0 * rk[rb], v1 * rk[rb]); };
            skinny_unit<128, 8>(F, tid, CKV + (size_t)row0 * 128, 128, (const bf16_t*)(F.ws + WS_WUKV) + (size_t)(512 * nh) * 128, epi);
        }
    }
}

struct Args { const float* in[N_IN]; float* out; unsigned char* ws; int ph_lo, ph_hi, li, pad; };
static_assert(sizeof(Args) == N_IN * 8 + 16 + 16, "Args has no padding holes");
constexpr int NPH = 26;
#ifndef REP_P0
#define REP_P0 1
#endif
#ifndef REP_P1
#define REP_P1 1
#endif
#ifndef REP_P2
#define REP_P2 1
#endif
#ifndef REP_P12
#define REP_P12 1
#endif
#ifndef REP_P14
#define REP_P14 1
#endif
#ifndef REP_P17
#define REP_P17 1
#endif
#ifndef REP_OUT
#define REP_OUT 1
#endif
#ifndef REP_NORM
#define REP_NORM 1
#endif
#ifndef REP_ROUTER
#define REP_ROUTER 1
#endif
#ifndef REP_UP
#define REP_UP 1
#endif
#ifndef REP_DOWN
#define REP_DOWN 1
#endif
#ifndef PROBE_HY_MODE
#define PROBE_HY_MODE 0
#endif
#ifndef PROBE_EXTRA_HY
#define PROBE_EXTRA_HY 0
#endif
#ifndef PROBE_APM
#define PROBE_APM 3
#endif
#ifndef PROBE_NK
#define PROBE_NK LT
#endif
#ifndef PROBE_GEMM
#define PROBE_GEMM 0
#endif
#ifndef SKPV
#define SKPV 0
#endif
#ifndef DOWN_SKINNY_PROBE
#define DOWN_SKINNY_PROBE 0
#endif
#ifndef DOWN_SKINNY
#define DOWN_SKINNY 0
#endif
#ifndef PROBE_P1C
#define PROBE_P1C 1
#endif
#ifndef PROBE_P1W
#define PROBE_P1W 1
#endif
#ifndef QKV_WGM
#define QKV_WGM 8
#endif
#ifndef FILLER_FIRST
#define FILLER_FIRST 1
#endif
#ifndef DESYNC_OUT
#define DESYNC_OUT 0
#endif
#ifndef DESYNC_DOWN
#define DESYNC_DOWN 127
#endif
#ifndef DESYNC_GROUPS
#define DESYNC_GROUPS 2
#endif
#ifndef PROBE_XBAR
#define PROBE_XBAR 0
#endif
#ifndef REP_P3
#define REP_P3 1
#endif
#ifndef REP_P16
#define REP_P16 1
#endif

DI bool ph_in(int k, int lo, int hi) { asm volatile("" : "+s"(lo), "+s"(hi)); return lo <= k && k < hi; }
__global__ void __launch_bounds__(NTHR, 2) mega_fwd(Args args) {
    extern __shared__ __attribute__((aligned(16))) unsigned char lds_raw[];
    Frame F;
    F.lds = (LAS unsigned char*)lds_raw;
    F.tid = threadIdx.x; F.lane = F.tid & 63; F.wave = __builtin_amdgcn_readfirstlane(F.tid >> 6); const int wave0 = F.wave;
    F.gw = bid_() * NWAVES + F.wave; F.NGW = gdim_() * NWAVES;
    F.out = args.out; F.ws = args.ws; F.ctl = (unsigned*)(args.ws + WS_CTL);
    volatile LAS unsigned* MISC = (volatile LAS unsigned*)(F.lds + MISC_OFF);
    if (F.tid < 32) MISC[F.tid] = 0u;
    if (F.tid == 64) { LAS unsigned long long* pt = (LAS unsigned long long*)(F.lds + PTAB_OFF);
#pragma unroll
        for (int i = 0; i < N_IN; ++i) pt[i] = (unsigned long long)args.in[i]; }
    __syncthreads();
    XcdBarrier bar = xcd_barrier_post(F.ctl + CW_BAR + args.li * XCD_BAR_WORDS, MISC + 8);
    const int lo = args.ph_lo, hi = args.ph_hi;
    const unsigned ws_lo0 = __builtin_amdgcn_readfirstlane((unsigned)(unsigned long long)args.ws), ws_hi0 = __builtin_amdgcn_readfirstlane((unsigned)((unsigned long long)args.ws >> 32));
    const unsigned out_lo0 = __builtin_amdgcn_readfirstlane((unsigned)(unsigned long long)args.out), out_hi0 = __builtin_amdgcn_readfirstlane((unsigned)((unsigned long long)args.out >> 32));
#ifndef PHMASK
#define PHMASK 0xFFFFFFFFu
#endif
#define IN(k) (((PHMASK >> (k)) & 1u) && ph_in((k), lo, hi))
#define PB() do { F.lane = lane_id(); asm volatile("" : "+v"(F.lane)); { int w_ = wave0; asm volatile("" : "+s"(w_)); F.wave = w_; } F.tid = F.wave * 64 + F.lane; F.gw = bid_() * NWAVES + F.wave; { unsigned lo_ = ws_lo0, hi_ = ws_hi0, ol_ = out_lo0, oh_ = out_hi0; asm volatile("" : "+s"(lo_), "+s"(hi_), "+s"(ol_), "+s"(oh_)); F.ws = (unsigned char*)(GAS unsigned char*)(((unsigned long long)hi_ << 32) | lo_); F.out = (float*)(GAS float*)(((unsigned long long)oh_ << 32) | ol_); } F.ctl = (unsigned*)F.ws; ws = F.ws; } while (0)
#define SEAM(k) do { if (IN(k) && IN((k) + 1)) { XcdBarrier bb_ = bar; asm volatile("" : "+s"(bb_.x)); asm volatile("" : "+s"(bb_.bar)); xcd_barrier(bb_, wave0 * 64 + lane_id()); } } while (0)
    unsigned char* ws = F.ws;
#define H ((bf16_t*)(ws + WS_H))
#define MIX ((bf16_t*)F.out)
#define XS ((bf16_t*)(ws + WS_XS))
#define MODV ((const float*)(ws + WS_MODV))

    if (IN(0)) { PB(); mod_block(F); }
    SEAM(0);
    if (IN(1)) { PB();
        if (bid_() & 1) { for (int r_ = 0; r_ < PROBE_P1C; ++r_) { p0_compute_part(F); PB(); __syncthreads(); } for (int r_ = 0; r_ < PROBE_P1W; ++r_) { p0_weight_part(F); PB(); } modnorm_phase(F, 0, 0, false, F.in_(I_X), F.in_(I_CTX), H); }
        else { modnorm_phase(F, 0, 0, false, F.in_(I_X), F.in_(I_CTX), H); PB(); for (int r_ = 0; r_ < PROBE_P1W; ++r_) { p0_weight_part(F); PB(); } for (int r_ = 0; r_ < PROBE_P1C; ++r_) { __syncthreads(); p0_compute_part(F); PB(); } }
#if PROBE_P1ALL > 1
        __syncthreads(); PB();
        if (bid_() & 1) { p0_compute_part(F); PB(); __syncthreads(); p0_weight_part(F); PB(); modnorm_phase(F, 0, 0, false, F.in_(I_X), F.in_(I_CTX), H); }
        else { modnorm_phase(F, 0, 0, false, F.in_(I_X), F.in_(I_CTX), H); PB(); p0_weight_part(F); PB(); __syncthreads(); p0_compute_part(F); PB(); }
#endif
    }
    SEAM(1);
    for (int xb_ = 0; xb_ < PROBE_XBAR; ++xb_) { XcdBarrier bb_ = bar; asm volatile("" : "+s"(bb_.x)); asm volatile("" : "+s"(bb_.bar)); xcd_barrier(bb_, wave0 * 64 + lane_id()); }
#pragma unroll 1
    for (int layer = 0; layer < 2; ++layer) {
        if (layer == 0) {
            if (IN(2)) { PB(); for (int rep_ = 0; rep_ < REP_P2; ++rep_) {
                { ProbDense p; p.init((const bf16_t*)(ws + WS_WIN0), 1024, 6, H, 1024, NPAN, 1024, 0); EpiStore e{(bf16_t*)(ws + WS_HYT), (size_t)T}; pg8::gemm_phase(F.lds, F.tid, p, e); }
#if PROBE_GEMM == 1
                { ProbDense p; p.init((const bf16_t*)(ws + WS_WIN0), 1024, 6, H, 1024, NPAN, 1024, 0); EpiStore e{(bf16_t*)(ws + WS_HYT), (size_t)T}; pg8::gemm_phase(F.lds, F.tid, p, e); }
#elif PROBE_GEMM == 3
                { ProbDense p; p.init((const bf16_t*)(ws + WS_WIN0), 1024, 6, H, 1024, NPAN, 1024, 0); EpiStoreNT e{(bf16_t*)(ws + WS_HYT), (size_t)T}; pg8::gemm_phase(F.lds, F.tid, p, e); }
#elif PROBE_GEMM == 2
                { ProbDense p; p.init((const bf16_t*)(ws + WS_WIN0), 1024, 6, H, 1024, NPAN, 1024, 0); EpiNull e{(float*)(ws + WS_HYT)}; pg8::gemm_phase(F.lds, F.tid, p, e); }
#endif
#if PROBE_GEMM == 5
                if (rep_ > 0) { ProbDense p; p.init(H, 1024, NPAN, (const bf16_t*)(ws + WS_WIN0) + 1536 * 1024, 1024, 3, 1024, 0); EpiNull e{(float*)(ws + WS_HYT)}; pg8::gemm_phase(F.lds, F.tid, p, e); } else
#endif
                { ProbDense p; p.init(H, 1024, NPAN, (const bf16_t*)(ws + WS_WIN0) + 1536 * 1024, 1024, 3, 1024, 0, QKV_WGM);
                  EpiQKV e{(bf16_t*)(ws + WS_Q0), (bf16_t*)(ws + WS_K0), (bf16_t*)(ws + WS_V0), F.in_(I_QKG), (const f32x2*)(ws + WS_ROPE0), 0.125f * LOG2E}; pg8::gemm_phase(F.lds, F.tid, p, e); }
#if PROBE_GEMM == 4
                { ProbDense p; p.init(H, 1024, NPAN, (const bf16_t*)(ws + WS_WIN0) + 1536 * 1024, 1024, 3, 1024, 0);
                  EpiQKV e{(bf16_t*)(ws + WS_Q0), (bf16_t*)(ws + WS_K0), (bf16_t*)(ws + WS_V0), F.in_(I_QKG), (const f32x2*)(ws + WS_ROPE0), 0.125f * LOG2E}; pg8::gemm_phase(F.lds, F.tid, p, e); }
#endif
            }
                { const int c_ = bid_(); if (c_ >= 96) { PB(); const int rk = c_ - 96; dense_weight_items_l1(F, (LAS float*)(F.lds + F.wave * 16384), rk * NWAVES + F.wave, 160 * NWAVES); rope_table1(F, rk * NTHR + F.tid, 160 * NTHR); s5_expand(F, rk * NTHR + F.tid, 160 * NTHR); } }
            }
            SEAM(2);
            if (IN(3)) { PB();
                const bf16_t* Q0 = (const bf16_t*)(ws + WS_Q0); const bf16_t* K0 = (const bf16_t*)(ws + WS_K0); const bf16_t* V0 = (const bf16_t*)(ws + WS_V0);
                for (int rep_ = 0; rep_ < REP_P3; ++rep_)
                for (;;) { int item = queue_next(F, F.ctl + CW_QUEUE + 128 * rep_); if (item >= 1728 + PROBE_EXTRA_HY) break; if (item >= 1728) { hyena_unit<false, PROBE_HY_MODE>(F, item - 1728); continue; }
                    if (item >= 1024 && item < 1536) hyena_unit<false>(F, item - 1024);
                    else if (item < 1664) { int b, head, qrow0, nk;
                        if (item < 1024) { const int idx = item; b = idx >> 6; head = (idx >> 3) & 7; qrow0 = b * LT + CTX + 256 * (idx & 7); nk = LT; }
                        else { const int idx = item - 1536; b = idx >> 3; head = idx & 7; qrow0 = b * LT; nk = CTX; }
                        attn_unit<64, false>(F, Q0, 512, head * 64, K0, 128, (head >> 2) * 64, nullptr, V0, 128, (head >> 2) * 64, MIX, 512 + head * 64, qrow0, b * LT, nk); }
                    else hyena_unit<true>(F, (item - 1664) * 8); }
            }
            SEAM(3);
        } else {
            if (IN(12)) { PB();
#if FILLER_FIRST
                const bool ff_ = bid_() >= 64 && ((bid_() >> 3) & 1);
                if (ff_) { moe_weight_items(F, 1, (LAS float*)(F.lds + F.wave * 16384), (bid_() - 64) * NWAVES + F.wave, 192 * NWAVES); __syncthreads(); PB(); }
#else
                const bool ff_ = false;
#endif
                for (int rep_ = 0; rep_ < REP_P12; ++rep_) { ProbDense p; p.init(H, 1024, NPAN, (const bf16_t*)(ws + WS_WIN1), 1024, 4, 1024, 0);
                EpiInproj1 e{(bf16_t*)(ws + WS_CQ), (bf16_t*)(ws + WS_CKV), (bf16_t*)(ws + WS_KR), (bf16_t*)(ws + WS_BMAT), (float*)(F.ctl + CW_ROWSS), (const f32x2*)(ws + WS_ROPE1)}; pg8::gemm_phase(F.lds, F.tid, p, e); }
                { const int c_ = bid_(); if (c_ >= 64 && !ff_) { PB(); moe_weight_items(F, 1, (LAS float*)(F.lds + F.wave * 16384), (c_ - 64) * NWAVES + F.wave, 192 * NWAVES); } } }
            SEAM(12);
            if (IN(14)) { PB(); for (int rep_ = 0; rep_ < REP_P14; ++rep_) {
                l1_upproj_phase(F); PB();
                { ProbS5 p{512, (const bf16_t*)(ws + WS_BMAT), (const bf16_t*)(ws + WS_S5W), (size_t)1280 * 768, (size_t)256 * 512, 768, 512, 5, 1, 0, gdim_(), bid_()};
                  EpiS5G1 e{(float*)(ws + WS_S5S)}; pg8::gemm_phase(F.lds, F.tid, p, e); }
            } }
            SEAM(14);
            if (IN(15)) { PB(); s5_scan_phase(F); }
            SEAM(15);
            if (IN(16)) { PB();
                { ProbS5 p{768, (const bf16_t*)(ws + WS_BMAT), (const bf16_t*)(ws + WS_S5A), (size_t)1280 * 768, (size_t)512 * 768, 768, 768, 4, 2, 128, gdim_(), bid_()};
                  EpiS5G2 e{(bf16_t*)(ws + WS_Y)}; pg8::gemm_phase(F.lds, F.tid, p, e); }
                const bf16_t* QM = (const bf16_t*)(ws + WS_QM); const bf16_t* KN = (const bf16_t*)(ws + WS_KN); const bf16_t* KR = (const bf16_t*)(ws + WS_KR); const bf16_t* VM = (const bf16_t*)(ws + WS_VM);
                for (int rep_ = 0; rep_ < REP_P16; ++rep_)
                for (int ri_ = 0; ri_ < 4; ++ri_) { const int c_ = bid_(), grp_ = (c_ & 7) * 16 + ri_ * 4 + (c_ >> 6); const int b = grp_ >> 3, head = grp_ & 7, qb = (c_ >> 3) & 7;
                    if (rep_ == 0) attn_unit<96, true>(F, QM, 768, head * 96, KN, 512, head * 64, KR, VM, 512, head * 64, MIX, head * 64, b * LT + CTX + 256 * qb, b * LT, LT);
                    else attn_unit<96, true, PROBE_APM>(F, QM, 768, head * 96, KN, 512, head * 64, KR, VM, 512, head * 64, MIX, head * 64, b * LT + CTX + 256 * qb, b * LT, PROBE_NK); }
            }
            SEAM(16);
            if (IN(17)) { PB(); for (int rep_ = 0; rep_ < REP_P17; ++rep_) { ProbDense p; p.init((const bf16_t*)(ws + WS_Y), 512, 128, (const bf16_t*)(ws + WS_WGLU), 512, 2, 512, 1);
                EpiGLU e{(const bf16_t*)(ws + WS_Y), F.in_(I_GLUB), MIX}; pg8::gemm_phase(F.lds, F.tid, p, e); } }
            SEAM(17);
        }
        const int tb = layer == 0 ? 4 : 18;
        const bool lat_only = layer == 1;
        if (IN(tb)) { PB();
            if (layer == 0) { hot_transpose_phase(F); XcdBarrier bb_ = bar; asm volatile("" : "+s"(bb_.x)); asm volatile("" : "+s"(bb_.bar)); xcd_barrier(bb_, wave0 * 64 + lane_id()); PB(); }
            if ((bid_() >> 3) & 1) { for (int s_ = 0; s_ < DESYNC_OUT; ++s_) __builtin_amdgcn_s_sleep(127); }
#if MOE0_IN_P4 && FILLER_FIRST
            const bool ff_ = layer == 0 && bid_() >= 64 && ((bid_() >> 3) & 1);
            if (ff_) { PB(); moe_weight_items(F, 0, (LAS float*)(F.lds + F.wave * 16384), (bid_() - 64) * NWAVES + F.wave, 192 * NWAVES); __syncthreads(); PB(); }
#else
            const bool ff_ = false;
#endif
            for (int rep_ = 0; rep_ < (layer == 0 ? REP_OUT : 1); ++rep_) { ProbDense p; p.init(MIX, 1024, lat_only ? 128 : NPAN, (const bf16_t*)(ws + (layer ? WS_WOUT1 : WS_WOUT0)), 1024, 4, 1024, layer);
            EpiRes e{F.in_(I_X), F.in_(I_CTX), XS, MODV + (size_t)layer * 17 * 6144 + 2048, layer}; pg8::gemm_phase(F.lds, F.tid, p, e); }
#if MOE0_IN_P4
            if (layer == 0 && !ff_) { const int c_ = bid_(); if (c_ >= 64) { PB(); moe_weight_items(F, 0, (LAS float*)(F.lds + F.wave * 16384), (c_ - 64) * NWAVES + F.wave, 192 * NWAVES); } }
#endif
        }
        SEAM(tb);
        if (IN(tb + 1)) { PB(); norm2_route_phase(F, layer, lat_only, XS, (bf16_t*)(ws + WS_H)); if (REP_NORM > 1) { __syncthreads(); PB(); norm2_route_phase(F, layer, lat_only, XS, (bf16_t*)(ws + WS_H), true); } }
        SEAM(tb + 1);
        if (IN(tb + 5)) { PB(); for (int rep_ = 0; rep_ < REP_UP; ++rep_) { const LAS int* tab = moe_tile_table(F, layer);
            ProbMoeUp p{1024, H, (const bf16_t*)(ws + WS_WGU), (const int*)(ws + WS_RANKTOK), tab}; EpiGateUp e{(bf16_t*)(ws + WS_HID)}; pg8::gemm_phase(F.lds, F.tid, p, e); } }
        SEAM(tb + 5);
        if (IN(tb + 6)) { PB(); for (int rep_ = 0; rep_ < REP_DOWN; ++rep_) { const LAS int* tab = (const LAS int*)(F.lds + LDS_TAB_OFF);
            { const int ng_ = (bid_() >> 3) & (DESYNC_GROUPS - 1); for (int s_ = 0; s_ < ng_; ++s_) __builtin_amdgcn_s_sleep(DESYNC_DOWN); }
#if DOWN_SKINNY
            moe_down_phase(F, layer, tab);
#elif DOWN_SKINNY_PROBE
            if (rep_ == 0) { ProbMoeDown p{256, (const bf16_t*)(ws + WS_HID), (const bf16_t*)(ws + WS_WDN), tab}; EpiDownSorted e{(bf16_t*)(ws + WS_Y2), (const float*)(ws + WS_RANKW), tab}; pg8::gemm_phase(F.lds, F.tid, p, e); }
            else moe_down_phase<SKPV>(F, layer, tab);
#else
            { ProbMoeDown p{256, (const bf16_t*)(ws + WS_HID), (const bf16_t*)(ws + WS_WDN), tab}; EpiDownSorted e{(bf16_t*)(ws + WS_Y2), (const float*)(ws + WS_RANKW), tab}; pg8::gemm_phase(F.lds, F.tid, p, e); }
#endif
            } }
        SEAM(tb + 6);
        if (IN(tb + 7)) { PB();
            if (layer == 0) { combine_phase<false>(F, 0, XS, F.out, (const bf16_t*)(ws + WS_Y2), H); }
            else combine_phase<true>(F, 1, XS, F.out, (const bf16_t*)(ws + WS_Y2), H);
        }
        if (layer == 0) SEAM(11);
    }
#undef IN
#undef SEAM
#undef PB
#undef H
#undef MIX
#undef XS
#undef MODV
}

#ifndef MK_CUTS
#define MK_CUTS {0, NPH}
#endif
extern "C" void kernel_launch(void* const* d_in, const int* in_sizes, int n_in, void* d_out, int out_size, void* d_ws, size_t ws_size, hipStream_t stream) {
    static int grid = 0;
    if (grid == 0) {
        if (n_in != N_IN || out_size != NB * SEQ * DM || ws_size < WS_END) { fprintf(stderr, "kernel_launch: unexpected shapes (n_in %d, out %d, ws %zu); nothing launched\n", n_in, out_size, ws_size); grid = -1; return; }
        int dev = 0, cus = 0, per_cu = 0;
        if (hipGetDevice(&dev) != hipSuccess || hipDeviceGetAttribute(&cus, hipDeviceAttributeMultiprocessorCount, dev) != hipSuccess) { grid = -1; return; }
        if (hipFuncSetAttribute((const void*)mega_fwd, hipFuncAttributeMaxDynamicSharedMemorySize, LDS_BYTES) != hipSuccess) { fprintf(stderr, "kernel_launch: hipFuncSetAttribute failed\n"); grid = -1; return; }
        if (hipOccupancyMaxActiveBlocksPerMultiprocessor(&per_cu, (const void*)mega_fwd, NTHR, LDS_BYTES) != hipSuccess || per_cu < 1) fprintf(stderr, "kernel_launch: occupancy query says %d\n", per_cu);
        (void)hipGetLastError();
        grid = cus;
    }
    if (grid < 0) return;
    (void)in_sizes;
    if (hipMemsetAsync((char*)d_ws + WS_CTL, 0, CTL_ZERO_BYTES, stream) != hipSuccess) return;
    Args a{};
    for (int i = 0; i < N_IN; ++i) a.in[i] = (const float*)d_in[i];
    a.out = (float*)d_out; a.ws = (unsigned char*)d_ws; a.pad = 0;
    const int cuts[] = MK_CUTS; const int nl = (int)(sizeof(cuts) / sizeof(int)) - 1;
    for (int li = 0; li < nl; ++li) {
        a.ph_lo = cuts[li]; a.ph_hi = cuts[li + 1]; a.li = li;
        hipLaunchKernelGGL(mega_fwd, dim3(grid), dim3(NTHR), LDS_BYTES, stream, a);
        if (hipPeekAtLastError() != hipSuccess) { fprintf(stderr, "kernel_launch: launch %d failed\n", li); break; }
    }
}
```

```cpp
#include <hip/hip_runtime.h>
#include <cstdio>
#include <cstdint>

#ifndef PROBE_HF
#define PROBE_HF 1
#endif
#ifndef PROBE_KT
#define PROBE_KT 1
#endif
#ifndef WT_STORES
#define WT_STORES 0
#endif
#ifndef EARLY_WB
#define EARLY_WB 0
#endif
#ifndef MOE0_IN_P4
#define MOE0_IN_P4 1
#endif
#define LAS __attribute__((address_space(3)))
#define GAS __attribute__((address_space(1)))
#define DI __device__ __forceinline__
typedef unsigned short bf16_t;
typedef short bf16x8 __attribute__((ext_vector_type(8)));
typedef float f32x2 __attribute__((ext_vector_type(2)));
typedef float f32x4 __attribute__((ext_vector_type(4)));
typedef float f32x16 __attribute__((ext_vector_type(16)));
typedef unsigned u32x2 __attribute__((ext_vector_type(2)));
typedef unsigned u32x4 __attribute__((ext_vector_type(4)));
typedef __bf16 bf16x2_t __attribute__((ext_vector_type(2)));

constexpr int NB = 16, SEQ = 2048, CTX = 256, LT = 2304, T = NB * LT, DM = 1024;
constexpr int NPAN = T / 256;
constexpr float EPS = 1e-6f;
constexpr float LOG2E = 1.4426950408889634f;
constexpr int NWAVES = 8, NTHR = 512;
constexpr int MOE_ROWS = 82176;

enum { I_X = 0, I_C, I_CTX, I_CCTX, I_WMOD, I_BMOD, I_NORMG, I_EWIN, I_HCW, I_HCB, I_HW1, I_HB1, I_HW2, I_HB2, I_HW3, I_HFREQ, I_HFB, I_QKG, I_EWOUT,
       I_OWIN, I_QNG, I_WUQ, I_KVNG, I_WUKV, I_SARE, I_SAIM, I_SLDT, I_SBRE, I_SBIM, I_SCRE, I_SCIM, I_SD, I_GLUW, I_GLUB, I_OWOUT,
       I_WRG, I_WRE, I_WGATE, I_WUP, I_WDOWN, I_FINALG, N_IN };

constexpr size_t MiB = 1u << 20;
constexpr size_t WS_CTL = 0, CTL_ZERO_BYTES = 1 * MiB;
constexpr size_t WS_MODV = 1 * MiB;
constexpr size_t WS_ROPE0 = 2 * MiB;
constexpr size_t WS_ROPE1 = 2 * MiB + 512 * 1024;
constexpr size_t WS_NORMF = 2 * MiB + 768 * 1024;
constexpr size_t WS_S5PAR = 2 * MiB + 800 * 1024;
constexpr size_t WS_KTAB = 3 * MiB;
constexpr size_t WS_HYPART = 5 * MiB;
constexpr size_t WS_HYPARTC = 7 * MiB;
constexpr size_t WS_WIN0 = 12 * MiB;
constexpr size_t WS_WOUT0 = WS_WIN0 + 2304 * 1024 * 2;
constexpr size_t WS_WIN1 = WS_WOUT0 + 1024 * 1024 * 2;
constexpr size_t WS_WUQ = WS_WIN1 + 1024 * 1024 * 2;
constexpr size_t WS_WUKV = WS_WUQ + 768 * 256 * 2;
constexpr size_t WS_WGLU = WS_WUKV + 1024 * 128 * 2;
constexpr size_t WS_WOUT1 = WS_WGLU + 512 * 512 * 2;
constexpr size_t WS_WR = WS_WOUT1 + 1024 * 1024 * 2;
constexpr size_t WS_W_END_ = WS_WR + 2 * 256 * 1024 * 2;
static_assert(WS_W_END_ <= 28 * MiB, "weights region");
constexpr size_t WS_WGU = 28 * MiB;
constexpr size_t WS_WDN = 60 * MiB;
constexpr size_t WS_S5A = 76 * MiB;
constexpr size_t WS_S5W = 100 * MiB;
constexpr size_t WS_MOEL = 108 * MiB;
constexpr size_t WS_TOKE = WS_MOEL, WS_TOKW = WS_TOKE + (size_t)T * 8, WS_ROWTOK = WS_TOKW + (size_t)T * 8, WS_ROWDST = WS_ROWTOK + (size_t)MOE_ROWS * 4, WS_ROWW = WS_ROWDST + (size_t)MOE_ROWS * 4;
constexpr size_t WS_TOKPOS = WS_ROWW + (size_t)MOE_ROWS * 4;
static_assert(WS_TOKPOS + (size_t)T * 8 <= 112 * MiB, "moe lists");
constexpr size_t WS_RANKTOK = 112 * MiB;
constexpr size_t WS_RANKW = 117 * MiB;
static_assert(WS_RANKTOK + (size_t)32 * T * 4 <= WS_RANKW && WS_RANKW + (size_t)32 * T * 4 <= 128 * MiB, "rank tables");
constexpr size_t WS_H = 128 * MiB;
constexpr size_t WS_XS = 200 * MiB;
constexpr size_t WS_TMP = 272 * MiB;
constexpr size_t WS_HYT = WS_TMP;
constexpr size_t WS_Q0 = WS_TMP + 108 * MiB;
constexpr size_t WS_K0 = WS_Q0 + 36 * MiB;
constexpr size_t WS_V0 = WS_K0 + 9 * MiB;
constexpr size_t WS_HOT = WS_TMP + 168 * MiB;
constexpr size_t WS_GRAW = 494 * MiB;
constexpr size_t WS_GRAWC = 510 * MiB;
constexpr size_t WS_LOGIT = WS_TMP;
constexpr size_t WS_HID = WS_TMP;
constexpr size_t WS_Y2 = WS_TMP + 41 * MiB;
static_assert(WS_HID + (size_t)MOE_ROWS * 512 <= WS_Y2 && WS_Y2 + (size_t)MOE_ROWS * 2048 <= 494 * MiB, "moe tmp");
constexpr size_t WS_BMAT = WS_TMP;
constexpr size_t WS_S5S = WS_TMP + 60 * MiB;
constexpr size_t WS_Y = WS_S5S;
constexpr size_t WS_KN = WS_TMP + 100 * MiB;
constexpr size_t WS_VM = WS_TMP + 136 * MiB;
constexpr size_t WS_KR = WS_TMP + 172 * MiB;
constexpr size_t WS_CQ = WS_TMP + 175 * MiB;
constexpr size_t WS_CKV = WS_TMP + 193 * MiB;
constexpr size_t WS_QM = WS_H;
constexpr size_t WS_END = 512 * MiB;

constexpr int CW_BAR = 4096;
constexpr int CW_QUEUE = 131072;
constexpr int CW_CNT = 135168;

constexpr int CW_TFLAG = 140000;
constexpr int CW_ROWSS = 150000;
static_assert((CW_ROWSS + 2 * T) * 4 <= (int)CTL_ZERO_BYTES, "rowss inside the zeroed region");
constexpr int LDS_BYTES = 147456;
constexpr int MISC_OFF = 146432;
constexpr int PTAB_OFF = MISC_OFF + 128;
constexpr int LDS_TAB_OFF = 131072 + 2048;

DI int bid_() { int b = (int)blockIdx.x; asm volatile("" : "+s"(b)); return b; }
DI int lane_id() { int r; asm volatile("v_mbcnt_lo_u32_b32 %0, -1, 0\n\tv_mbcnt_hi_u32_b32 %0, -1, %0" : "=v"(r)); return r; }
DI int gdim_() { int g = (int)gridDim.x; asm volatile("" : "+s"(g)); return g; }
DI unsigned f2bf(float f) { unsigned u = __builtin_bit_cast(unsigned, f); return (u + 0x7fffu + ((u >> 16) & 1u)) >> 16; }
DI unsigned pk2(float lo, float hi) { f32x2 v = {lo, hi}; bf16x2_t b = __builtin_convertvector(v, bf16x2_t); return __builtin_bit_cast(unsigned, b); }
DI float bf2f(unsigned short h) { return __builtin_bit_cast(float, (unsigned)h << 16); }
DI float bflo(unsigned w) { return __builtin_bit_cast(float, w << 16); }
DI float bfhi(unsigned w) { return __builtin_bit_cast(float, w & 0xffff0000u); }
DI float wave_sum(float v) {
#pragma unroll
    for (int o = 1; o < 64; o <<= 1) v += __shfl_xor(v, o);
    return v;
}
DI float silu_f(float x) { return x / (1.f + __expf(-x)); }
DI float gelu_tanh(float x) { const float u = 0.7978845608028654f * (x + 0.044715f * x * x * x); const float e = __expf(2.f * u); const float th = 1.f - 2.f / (e + 1.f); return 0.5f * x * (1.f + th); }
#define LDS_WAIT() asm volatile("s_waitcnt lgkmcnt(0)" ::: "memory")
#define VM_WAIT() asm volatile("s_waitcnt vmcnt(0)" ::: "memory")

#define XB_TMO      128
#define XB_XCNT(j)  (256  + 64 * (j))
#define XB_XSUB(j)  (1280 + 64 * (j))
#define XB_XGEN(j)  (2304 + 64 * (j))
#define XB_TOP      3328
#define XB_TOPGEN   3392
#define XCD_BAR_WORDS 3456
#define XB_SPIN_CAP (1u << 22)
__device__ __forceinline__ unsigned xb_ld(unsigned* p)              { return __hip_atomic_load(p, __ATOMIC_RELAXED, __HIP_MEMORY_SCOPE_AGENT); }
__device__ __forceinline__ unsigned xb_add(unsigned* p, unsigned v) { return __hip_atomic_fetch_add(p, v, __ATOMIC_RELAXED, __HIP_MEMORY_SCOPE_AGENT); }
__device__ __forceinline__ unsigned xb_xcc_id() { return (unsigned)__builtin_amdgcn_s_getreg((3 << 11) | 20) & 0xFu; }
#define XB_SPIN(cond, bar) do { unsigned _sp = 0; while (cond) { __builtin_amdgcn_s_sleep(1); \
    if ((++_sp & 255u) == 0u) { if (xb_ld(&(bar)[XB_TMO])) break; if (_sp > XB_SPIN_CAP) { atomicAdd(&(bar)[XB_TMO], 1u); break; } } } } while (0)
struct XcdBarrier { unsigned* bar; unsigned x; volatile LAS unsigned* st; };
__device__ __forceinline__ XcdBarrier xcd_barrier_post(unsigned* bar, volatile LAS unsigned* st) {
    XcdBarrier b; b.bar = bar; b.x = xb_xcc_id(); b.st = st;
    if (threadIdx.x == 0) (void)xb_add(&bar[XB_XCNT(b.x)], 1u);
    return b;
}
__device__ __forceinline__ void xcd_barrier_complete(unsigned* bar, unsigned x, unsigned& nloc, unsigned& nx) {
    const unsigned G = gridDim.x * gridDim.y * gridDim.z;
    unsigned sum, cnt, mine, sp = 0u;
    for (;;) {
        sum = 0u; cnt = 0u; mine = 0u;
#pragma unroll
        for (unsigned j = 0; j < 16; ++j) { const unsigned c = xb_ld(&bar[XB_XCNT(j)]); sum += c; cnt += (c > 0u) ? 1u : 0u; mine = (j == x) ? c : mine; }
        if (sum == G) break;
        __builtin_amdgcn_s_sleep(1);
        if ((++sp & 255u) == 0u) { if (xb_ld(&bar[XB_TMO])) break; if (sp > XB_SPIN_CAP) { atomicAdd(&bar[XB_TMO], 1u); break; } }
    }
    nloc = mine > 0u ? mine : 1u; nx = cnt > 0u ? cnt : 1u;
}
__device__ __forceinline__ void xcd_barrier(const XcdBarrier& b, int tid) {
    asm volatile("s_waitcnt vmcnt(0)" ::: "memory");
    __syncthreads();
    if (tid == 0) {
        unsigned* bar = b.bar;
        __builtin_amdgcn_s_waitcnt(0);
        unsigned nloc = b.st[0], nx = b.st[1];
        if (nloc == 0u) { xcd_barrier_complete(bar, b.x, nloc, nx); b.st[0] = nloc; b.st[1] = nx; }
#if EARLY_WB
        __builtin_amdgcn_fence(__ATOMIC_RELEASE, "agent");
        asm volatile("s_waitcnt vmcnt(0)" ::: "memory");
#endif
        const unsigned old = xb_add(&bar[XB_XSUB(b.x)], 1u);
        const unsigned gen = old / nloc;
        if (old + 1u == (gen + 1u) * nloc) {
            __builtin_amdgcn_fence(__ATOMIC_RELEASE, "agent");
            asm volatile("s_waitcnt vmcnt(0)" ::: "memory");
            const unsigned og = xb_add(&bar[XB_TOP], 1u);
            const unsigned tg = og / nx;
            if (og + 1u == (tg + 1u) * nx) xb_add(&bar[XB_TOPGEN], 1u);
            else XB_SPIN(xb_ld(&bar[XB_TOPGEN]) == tg, bar);
            __builtin_amdgcn_fence(__ATOMIC_ACQUIRE, "agent");
            xb_add(&bar[XB_XGEN(b.x)], 1u);
            asm volatile("s_waitcnt vmcnt(0)" ::: "memory");
        } else {
            XB_SPIN(xb_ld(&bar[XB_XGEN(b.x)]) == gen, bar);
            asm volatile("buffer_inv sc0" ::: "memory");
            asm volatile("s_waitcnt vmcnt(0)" ::: "memory");
        }
    }
    __syncthreads();
}
namespace pg8 {
constexpr int BM = 256, BK = 64, HALF = 128, HTB = HALF * BK * 2, STAGE_BYTES = 8 * HTB, NXCD = 8, WGM = 8;
__host__ __device__ __forceinline__ int lds_byte(int r, int c) { const int st = (r >> 4) * 2 + (c >> 5), rr = r & 15, cc = c & 31, ob = rr * 64 + cc * 2; return st * 1024 + (ob ^ (((ob >> 9) & 1) << 5)); }
__host__ __device__ __forceinline__ void stage_rc(int b, int& R, int& C) { const int st = b / 1024, sb = b % 1024, swz = sb ^ (((sb >> 9) & 1) << 5); R = (st >> 1) * 16 + swz / 64; C = (st & 1) * 32 + (swz % 64) / 2; }
__host__ __device__ __forceinline__ int perm32(int rho) { const int n = rho >> 4, i = rho & 15; return 8 * (i >> 2) + 4 * n + (i & 3); }
struct Unit { int pm, pn, z; };

struct GridOrder {
    int nM, nN, nwg, G, c, wgm;
    DI void init(int nM_, int nN_, int G_, int c_, int wgm_ = WGM) { nM = nM_; nN = nN_; nwg = nM * nN; G = G_; c = c_; wgm = wgm_; }
    DI bool get(int i, int& pm, int& pn) const {
        const long L = (long)i * G + c; if (L >= nwg) return false;
        int wgid = (int)L; { const int q = nwg / NXCD, r = nwg % NXCD, xcd = wgid % NXCD, off = wgid / NXCD; wgid = (xcd < r ? xcd * (q + 1) : r * (q + 1) + (xcd - r) * q) + off; }
        const int nig = wgm * nN, gid = wgid / nig, fm = gid * wgm, gsz = (nM - fm) < wgm ? (nM - fm) : wgm;
        pm = fm + ((wgid % nig) % gsz); pn = (wgid % nig) / gsz; return true;
    }
};

template <class Prob, class Epi, bool ALIGN_EPI = true>
__device__ __forceinline__ void gemm_phase(LAS unsigned char* lds, int tid_in, const Prob& P, const Epi& E) {
    int tid_ = tid_in; asm volatile("" : "+v"(tid_));
    const int tid = tid_, wid = __builtin_amdgcn_readfirstlane(tid >> 6), lane = tid & 63, wr = wid >> 2, wc = wid & 3, fr = lane & 15, fq = lane >> 4;
    int K_ = P.K; asm volatile("" : "+s"(K_));
    const int K = K_, nt = K / BK;
    int sR[2], sC[2];
#pragma unroll
    for (int i = 0; i < 2; ++i) stage_rc(tid * 16 + i * 8192, sR[i], sC[i]);
    constexpr int NH = Prob::GATHER ? 2 : 1;
    unsigned vB[2], vaC[NH][2], vaN[NH][2];
#pragma unroll
    for (int i = 0; i < 2; ++i) vB[i] = P.b_voff(0, (sR[i] & ~31) + perm32(sR[i] & 31), sC[i]);
    const size_t hstepA = Prob::GATHER ? 0 : (size_t)P.a_voff(pg8::Unit{0, 0, 0}, 1, 0, 0), hstepB = (size_t)P.b_voff(1, 0, 0);
    const size_t kstep = (size_t)(BK * 2);
    const unsigned ldsw = (unsigned)wid * 1024u;
    const int aoff = lds_byte(wr * 64 + fr, fq * 8), boff = lds_byte(wc * 32 + fr, fq * 8);
#define PG8_SA(b, h) (((b) * 2 + (h)) * HTB)
#define PG8_SB(b, h) ((4 + (b) * 2 + (h)) * HTB)
#define PG8_STAGE_A(bufoff, gptr, VO, h) do { const char* gp_ = (gptr) + (h) * hstepA; \
        __builtin_amdgcn_global_load_lds((const unsigned*)(gp_ + VO[Prob::GATHER ? (h) : 0][0]), (LAS unsigned*)(lds + (bufoff) + ldsw), 16, 0, 0); \
        __builtin_amdgcn_global_load_lds((const unsigned*)(gp_ + VO[Prob::GATHER ? (h) : 0][1]), (LAS unsigned*)(lds + (bufoff) + ldsw + 8192), 16, 0, 0); } while (0)
#define PG8_STAGE_B(bufoff, gptr, h) do { const char* gp_ = (gptr) + (h) * hstepB; \
        __builtin_amdgcn_global_load_lds((const unsigned*)(gp_ + vB[0]), (LAS unsigned*)(lds + (bufoff) + ldsw), 16, 0, 0); \
        __builtin_amdgcn_global_load_lds((const unsigned*)(gp_ + vB[1]), (LAS unsigned*)(lds + (bufoff) + ldsw + 8192), 16, 0, 0); } while (0)
#define PG8_LDA(dst, b, h) do { _Pragma("unroll") for (int m = 0; m < 4; ++m) _Pragma("unroll") for (int k = 0; k < 2; ++k) dst[m][k] = *(const LAS bf16x8*)(lds + PG8_SA(b, h) + aoff + m * 2048 + k * 1024); } while (0)
#define PG8_LDB(dst, b, h) do { _Pragma("unroll") for (int n = 0; n < 2; ++n) _Pragma("unroll") for (int k = 0; k < 2; ++k) dst[n][k] = *(const LAS bf16x8*)(lds + PG8_SB(b, h) + boff + n * 2048 + k * 1024); } while (0)
#define PG8_MMA(ai, bj, At, Bt) do { __builtin_amdgcn_s_setprio(1); _Pragma("unroll") for (int m = 0; m < 4; ++m) _Pragma("unroll") for (int n = 0; n < 2; ++n) _Pragma("unroll") for (int k = 0; k < 2; ++k) \
        acc[ai][bj][m][n] = __builtin_amdgcn_mfma_f32_16x16x32_bf16(Bt[n][k], At[m][k], acc[ai][bj][m][n], 0, 0, 0); __builtin_amdgcn_s_setprio(0); } while (0)
#define PG8_WAIT_V(n) asm volatile("s_waitcnt vmcnt(" #n ")" ::: "memory")
#define PG8_WAIT_L(n) asm volatile("s_waitcnt lgkmcnt(" #n ")" ::: "memory")
#define PG8_BAR __builtin_amdgcn_s_barrier()
#define PG8_SCHED __builtin_amdgcn_sched_barrier(0)
    Unit cur, nxt; int ui = 0;
    if (!P.next(0, cur)) return;
    f32x4 acc[2][2][4][2];
#pragma unroll
    for (int a = 0; a < 2; ++a)
#pragma unroll
        for (int b = 0; b < 2; ++b)
#pragma unroll
            for (int m = 0; m < 4; ++m)
#pragma unroll
                for (int n = 0; n < 2; ++n) acc[a][b][m][n] = (f32x4){0.f, 0.f, 0.f, 0.f};
    bf16x8 At[4][2], B0[2][2], B1[2][2];
    const char* cA = P.a_base(cur); const char* cB = P.b_base(cur);
#pragma unroll
    for (int h = 0; h < NH; ++h)
#pragma unroll
        for (int i = 0; i < 2; ++i) { vaC[h][i] = P.a_voff(cur, h, sR[i], sC[i]); vaN[h][i] = vaC[h][i]; }
    PG8_STAGE_B(PG8_SB(0, 0), cB, 0); PG8_STAGE_B(PG8_SB(0, 1), cB, 1); PG8_STAGE_A(PG8_SA(0, 0), cA, vaC, 0); PG8_STAGE_A(PG8_SA(0, 1), cA, vaC, 1);
    if (wr == 1) PG8_BAR;
    PG8_WAIT_V(2); PG8_BAR;
    PG8_STAGE_B(PG8_SB(1, 0), cB + kstep, 0); PG8_STAGE_A(PG8_SA(1, 0), cA + kstep, vaC, 0); PG8_STAGE_B(PG8_SB(1, 1), cB + kstep, 1);
    PG8_WAIT_V(6); PG8_BAR;
    for (;;) {
        const bool has_next = P.next(ui + 1, nxt);
        const char* nA = has_next ? P.a_base(nxt) : cA; const char* nB = has_next ? P.b_base(nxt) : cB;
        if (Prob::GATHER) { if (has_next) {
#pragma unroll
            for (int h = 0; h < NH; ++h)
#pragma unroll
                for (int i = 0; i < 2; ++i) vaN[h][i] = P.a_voff(nxt, h, sR[i], sC[i]); } }
        for (int t = 0; t < nt; t += 2) {
            const bool last = (t == nt - 2);
            const char* a1 = cA + (size_t)(t + 1) * kstep;
            const char* a2 = last ? nA : cA + (size_t)(t + 2) * kstep; const char* b2 = last ? nB : cB + (size_t)(t + 2) * kstep;
            const char* a3 = a2 + kstep; const char* b3 = b2 + kstep;
            unsigned va2[NH][2];
#pragma unroll
            for (int h = 0; h < NH; ++h)
#pragma unroll
                for (int i = 0; i < 2; ++i) va2[h][i] = (Prob::GATHER && last) ? vaN[h][i] : vaC[h][i];
            PG8_LDB(B0, 0, 0); PG8_LDB(B1, 0, 1); PG8_SCHED; PG8_LDA(At, 0, 0); PG8_STAGE_A(PG8_SA(1, 1), a1, vaC, 1);
            PG8_WAIT_V(8); PG8_WAIT_L(0); PG8_BAR; PG8_MMA(0, 0, At, B0); PG8_MMA(0, 1, At, B1); PG8_BAR; PG8_SCHED;
            PG8_LDA(At, 0, 1); PG8_STAGE_B(PG8_SB(0, 0), b2, 0); PG8_STAGE_B(PG8_SB(0, 1), b2, 1); PG8_STAGE_A(PG8_SA(0, 0), a2, va2, 0);
            PG8_WAIT_V(8); PG8_WAIT_L(0); PG8_BAR; PG8_MMA(1, 0, At, B0); PG8_MMA(1, 1, At, B1); PG8_BAR; PG8_SCHED;
            PG8_LDB(B0, 1, 0); PG8_LDB(B1, 1, 1); PG8_SCHED; PG8_LDA(At, 1, 0); PG8_STAGE_A(PG8_SA(0, 1), a2, va2, 1);
            PG8_WAIT_V(8); PG8_WAIT_L(0); PG8_BAR; PG8_MMA(0, 0, At, B0); PG8_MMA(0, 1, At, B1); PG8_BAR; PG8_SCHED;
            PG8_LDA(At, 1, 1); PG8_STAGE_B(PG8_SB(1, 0), b3, 0); PG8_STAGE_B(PG8_SB(1, 1), b3, 1); PG8_STAGE_A(PG8_SA(1, 0), a3, va2, 0);
            PG8_WAIT_V(8); PG8_WAIT_L(0); PG8_BAR; PG8_MMA(1, 0, At, B0); PG8_MMA(1, 1, At, B1); PG8_BAR; PG8_SCHED;
        }
        if constexpr (ALIGN_EPI) { if (wr == 0) PG8_BAR; }
        { const int le_ = lane_id(); E(acc, cur, wr, wc, le_ & 15, le_ >> 4); }
        if (!has_next) break;
#pragma unroll
        for (int a = 0; a < 2; ++a)
#pragma unroll
            for (int b = 0; b < 2; ++b)
#pragma unroll
                for (int m = 0; m < 4; ++m)
#pragma unroll
                    for (int n = 0; n < 2; ++n) acc[a][b][m][n] = (f32x4){0.f, 0.f, 0.f, 0.f};
        cur = nxt; cA = nA; cB = nB; ++ui;
#pragma unroll
        for (int h = 0; h < NH; ++h)
#pragma unroll
            for (int i = 0; i < 2; ++i) vaC[h][i] = vaN[h][i];
        if constexpr (ALIGN_EPI) { if (wr == 1) PG8_BAR; }
    }
    PG8_WAIT_V(0);
    if constexpr (!ALIGN_EPI) { if (wr == 0) PG8_BAR; }
    PG8_BAR;
#undef PG8_SA
#undef PG8_SB
#undef PG8_STAGE_A
#undef PG8_STAGE_B
#undef PG8_LDA
#undef PG8_LDB
#undef PG8_MMA
#undef PG8_WAIT_V
#undef PG8_WAIT_L
#undef PG8_BAR
#undef PG8_SCHED
}
}
typedef pg8::Unit Unit;
typedef f32x4 AccT[2][2][4][2];
DI int xcd_contig(int L, int n) { const int q = n >> 3, r = n & 7, x = L & 7, off = L >> 3; return (x < r ? x * (q + 1) : r * (q + 1) + (x - r) * q) + off; }
struct ProbDense {
    static constexpr bool GATHER = false;
    int K; const bf16_t* A; const bf16_t* B; int lda, ldb; pg8::GridOrder ord; int amap;
    unsigned* wflag; unsigned wneed;
    DI void init(const bf16_t* A_, int lda_, int nM, const bf16_t* B_, int ldb_, int nN, int K_, int amap_, int wgm_ = pg8::WGM) { A = A_; B = B_; lda = lda_; ldb = ldb_; K = K_; amap = amap_; wflag = nullptr; wneed = 0u; ord.init(nM, nN, gdim_(), bid_(), wgm_); }
    DI bool next(int i, Unit& u) const { int pm, pn; if (!ord.get(i, pm, pn)) return false; u.pm = amap ? (pm >> 3) * 9 + 1 + (pm & 7) : pm; u.pn = pn; u.z = 0;
        if (wneed) { unsigned* fl = wflag + u.pm; unsigned sp = 0; while (xb_ld(fl) < wneed) { __builtin_amdgcn_s_sleep(1); if (++sp > (1u << 14)) break; } asm volatile("" ::: "memory"); }
        return true; }
    DI const char* a_base(const Unit& u) const { return (const char*)(A + (size_t)u.pm * 256 * lda); }
    DI const char* b_base(const Unit& u) const { return (const char*)(B + (size_t)u.pn * 256 * ldb); }
    DI unsigned a_voff(const Unit&, int h, int R, int C) const { return (unsigned)(((h * 128 + R) * lda + C) * 2); }
    DI unsigned b_voff(int h, int Rb, int C) const { return (unsigned)(((h * 128 + Rb) * ldb + C) * 2); }
};
struct ProbS5 {
    static constexpr bool GATHER = false;
    int K; const bf16_t* A; const bf16_t* B; size_t ags, bgs; int lda, ldb, nM, nN, arow0, gd, bi;
    DI bool next(int i, Unit& u) const { const int L0 = i * gd + bi, n = 32 * nM * nN; if (bi < 0 || L0 >= n) return false; const int L = xcd_contig(L0, n);        u.z = L / (nM * nN); const int r = L % (nM * nN); u.pm = r / nN; u.pn = r % nN; return true; }
    DI const char* a_base(const Unit& u) const { return (const char*)(A + (size_t)u.z * ags + (size_t)(arow0 + u.pm * 256) * lda); }
    DI const char* b_base(const Unit& u) const { return (const char*)(B + (size_t)u.z * bgs + (size_t)u.pn * 256 * ldb); }
    DI unsigned a_voff(const Unit&, int h, int R, int C) const { return (unsigned)(((h * 128 + R) * lda + C) * 2); }
    DI unsigned b_voff(int h, int Rb, int C) const { return (unsigned)(((h * 128 + Rb) * ldb + C) * 2); }
};
struct ProbMoeUp {
    static constexpr bool GATHER = true;
    int K; const bf16_t* A; const bf16_t* B; const int* rank_tok; const LAS int* tab;
    DI bool next(int i, Unit& u) const { const int L0 = i * gdim_() + bid_(), n = 2 * tab[0]; if (L0 >= n) return false; const int L = xcd_contig(L0, n); u.pm = L >> 1; u.pn = L & 1; u.z = tab[1 + u.pm] & 255; return true; }
    DI const char* a_base(const Unit&) const { return (const char*)A; }
    DI const char* b_base(const Unit& u) const { return (const char*)(B + (size_t)u.z * 512 * 1024 + (size_t)u.pn * 256 * 1024); }
    DI unsigned a_voff(const Unit& u, int h, int R, int C) const { const int rank = (tab[1 + u.pm] >> 8) * 256 + h * 128 + R;
        const int tk = rank < tab[400 + u.z] ? rank_tok[(size_t)u.z * T + rank] >> 1 : 0; return (unsigned)((tk * 1024 + C) * 2); }
    DI unsigned b_voff(int h, int Rb, int C) const { return (unsigned)(((h * 128 + Rb) * 1024 + C) * 2); }
};
struct ProbMoeDown {
    static constexpr bool GATHER = false;
    int K; const bf16_t* A; const bf16_t* B; const LAS int* tab; unsigned* flag;
    int st, qd, na, nb, off, nw;
    DI void init() { const int nt = tab[0], c = bid_(), x = c & 7; nw = gdim_() >> 3; off = c >> 3;
        const int nu = 2 * nt, nd = 4 * nt, qu = (nu >> 3) + (x < (nu & 7) ? 1 : 0), q = nd >> 3, r = nd & 7;
        qd = q + (x < r ? 1 : 0); st = x < r ? x * (q + 1) : r * (q + 1) + (x - r) * q;
        const int rem = qu % nw; na = rem == 0 ? nw : rem; nb = nw - na;
        { const int ln = lane_id(); Unit uu; const bool v = ln < 32 && unit_at(ln, uu); const bool rdy = v && xb_ld(flag + uu.pm) >= 2u; ready = (unsigned)__ballot(rdy); asm volatile("" ::: "memory"); } }
    unsigned ready;
    DI bool unit_at(int i, Unit& u) const { const int head = 3 * nb; int loc;
        if (off >= na) loc = i < 3 ? i * nb + (off - na) : head + (i - 3) * nw + off; else loc = head + i * nw + off;
        if (loc >= qd) return false;
        const int L = st + loc; u.pm = L >> 2; u.pn = L & 3; u.z = tab[1 + u.pm] & 255; return true; }
    DI bool next(int i, Unit& u) const {
        if (!unit_at(i, u)) return false;
        if (i >= 32 || !((ready >> i) & 1u)) { unsigned* fl = flag + u.pm; unsigned sp = 0;
        while (xb_ld(fl) < 2u) { __builtin_amdgcn_s_sleep(1); if (++sp > (1u << 14)) break; } }
        asm volatile("" ::: "memory");
        return true; }
    DI const char* a_base(const Unit& u) const { return (const char*)(A + (size_t)u.pm * 256 * 256); }
    DI const char* b_base(const Unit& u) const { return (const char*)(B + (size_t)u.z * 1024 * 256 + (size_t)u.pn * 256 * 256); }
    DI unsigned a_voff(const Unit&, int h, int R, int C) const { return (unsigned)(((h * 128 + R) * 256 + C) * 2); }
    DI unsigned b_voff(int h, int Rb, int C) const { return (unsigned)(((h * 128 + Rb) * 256 + C) * 2); }
};

#define EPI_ROW(u, ai, m) ((u).pm * 256 + (ai) * 128 + wr * 64 + (m) * 16 + fr)
#define EPI_COL(u, bj) ((u).pn * 256 + (bj) * 128 + wc * 32 + fq * 8)
#if WT_STORES
DI void st16_wt(void* p, const u32x4& v) { asm volatile("global_store_dwordx4 %0, %1, off sc1\n\ts_nop 1" :: "v"(p), "v"(v) : "memory"); }
#define ST16(addr, val) st16_wt((void*)(addr), (val))
#else
#define ST16(addr, val) (*(u32x4*)(addr) = (val))
#endif
DI u32x4 pack8(const f32x4& a, const f32x4& b) { u32x4 w; w.x = pk2(a[0], a[1]); w.y = pk2(a[2], a[3]); w.z = pk2(b[0], b[1]); w.w = pk2(b[2], b[3]); return w; }

struct EpiNull { float* sink;
    DI void operator()(const AccT& acc, const Unit& u, int wr, int wc, int fr, int fq) const { f32x4 s = {0.f, 0.f, 0.f, 0.f};
#pragma unroll
        for (int ai = 0; ai < 2; ++ai)
#pragma unroll
            for (int bj = 0; bj < 2; ++bj)
#pragma unroll
                for (int m = 0; m < 4; ++m) { s += acc[ai][bj][m][0]; s += acc[ai][bj][m][1]; }
        if (s.x + s.y + s.z + s.w == 12345.678f) sink[u.pm + wr + wc + fr + fq] = s.x; } };
struct EpiStore {
    bf16_t* O; size_t ldc;
    DI void operator()(const AccT& acc, const Unit& u, int wr, int wc, int fr, int fq) const {
#pragma unroll
        for (int ai = 0; ai < 2; ++ai)
#pragma unroll
            for (int m = 0; m < 4; ++m) { bf16_t* rp = O + (size_t)EPI_ROW(u, ai, m) * ldc;
#pragma unroll
                for (int bj = 0; bj < 2; ++bj) ST16(rp + EPI_COL(u, bj), pack8(acc[ai][bj][m][0], acc[ai][bj][m][1])); }
    }
};
struct EpiStoreNT {
    bf16_t* O; size_t ldc;
    DI void operator()(const AccT& acc, const Unit& u, int wr, int wc, int fr, int fq) const {
#pragma unroll
        for (int ai = 0; ai < 2; ++ai)
#pragma unroll
            for (int m = 0; m < 4; ++m) { bf16_t* rp = O + (size_t)EPI_ROW(u, ai, m) * ldc;
#pragma unroll
                for (int bj = 0; bj < 2; ++bj) __builtin_nontemporal_store(pack8(acc[ai][bj][m][0], acc[ai][bj][m][1]), (u32x4*)(rp + EPI_COL(u, bj))); }
    }
};
struct EpiQKV {
    bf16_t *Q, *Kb, *Vb; const float* qkg; const f32x2* rope; float qscale;
    DI void operator()(const AccT& acc, const Unit& u, int wr, int wc, int fr, int fq) const {
        const int kind = (u.pn < 2) ? 0 : (wc < 2 ? 1 : 2);
        const int hs = (u.pn < 2) ? u.pn * 4 + wc : (wc & 1);
        bf16_t* base = kind == 0 ? Q : (kind == 1 ? Kb : Vb); const int ld = kind == 0 ? 512 : 128;
        f32x4 gn[2][2];
        { const float* gp = qkg + (kind & 1) * 64 + 32 * (fq >> 1) + 8 * (fq & 1);
#pragma unroll
          for (int bj = 0; bj < 2; ++bj) { gn[bj][0] = *(const f32x4*)(gp + 16 * bj); gn[bj][1] = *(const f32x4*)(gp + 16 * bj + 4); } }
        const float osc = kind == 0 ? qscale : 1.f;
        const bool roped = kind < 2 && (u.pm % 9) != 0;
#pragma unroll
        for (int ai = 0; ai < 2; ++ai) {
            f32x2 cs[4][8];
            if (roped) {
#pragma unroll
                for (int m = 0; m < 4; ++m) { const int pos = EPI_ROW(u, ai, m) % LT; const f32x2* rp = rope + (size_t)(pos - CTX) * 32 + (fq >> 1) * 16 + (fq & 1) * 8;
#pragma unroll
                    for (int k = 0; k < 8; ++k) cs[m][k] = rp[k]; } }
            asm volatile("" ::: "memory");
#pragma unroll
            for (int m = 0; m < 4; ++m) {
                const int r = EPI_ROW(u, ai, m);
                f32x4 v[2][2];
#pragma unroll
                for (int bj = 0; bj < 2; ++bj) { v[bj][0] = acc[ai][bj][m][0]; v[bj][1] = acc[ai][bj][m][1]; }
                if (kind < 2) {
                    float ss = 0.f;
#pragma unroll
                    for (int bj = 0; bj < 2; ++bj)
#pragma unroll
                        for (int n = 0; n < 2; ++n)
#pragma unroll
                            for (int j = 0; j < 4; ++j) ss += v[bj][n][j] * v[bj][n][j];
                    ss += __shfl_xor(ss, 16); ss += __shfl_xor(ss, 32);
                    const float rstd = __builtin_amdgcn_rsqf(ss * (1.f / 64.f) + EPS);
#pragma unroll
                    for (int bj = 0; bj < 2; ++bj)
#pragma unroll
                        for (int n = 0; n < 2; ++n)
#pragma unroll
                            for (int j = 0; j < 4; ++j) v[bj][n][j] = v[bj][n][j] * rstd * gn[bj][n][j];
                    if (roped) {
#pragma unroll
                        for (int n = 0; n < 2; ++n)
#pragma unroll
                            for (int j = 0; j < 4; ++j) { const f32x2 c2 = cs[m][4 * n + j]; const float t1 = v[0][n][j], t2 = v[1][n][j]; v[0][n][j] = t1 * c2.x - t2 * c2.y; v[1][n][j] = t1 * c2.y + t2 * c2.x; }
                    }
                }
                bf16_t* rowp = base + (size_t)r * ld + hs * 64 + fq * 8;
#pragma unroll
                for (int bj = 0; bj < 2; ++bj) ST16(rowp + 32 * bj, pack8(v[bj][0] * osc, v[bj][1] * osc));
            }
            asm volatile("" ::: "memory");
        }
    }
};
struct EpiRes {
    const float* src_lat; const float* src_ctx; bf16_t* xs; const float* gate; int src_bf16;
    DI void operator()(const AccT& acc, const Unit& u, int wr, int wc, int fr, int fq) const {
        const int b = u.pm / 9; const bool isc = (u.pm % 9) == 0;
        const float* gp = gate + (isc ? 16 : b) * 6144;
        f32x4 gv[2][2];
#pragma unroll
        for (int bj = 0; bj < 2; ++bj) { const int c = EPI_COL(u, bj); gv[bj][0] = *(const f32x4*)(gp + c); gv[bj][1] = *(const f32x4*)(gp + c + 4); }
#pragma unroll
        for (int ai = 0; ai < 2; ++ai) {
            if (src_bf16) { u32x4 sv[4][2];
#pragma unroll
                for (int m = 0; m < 4; ++m)
#pragma unroll
                    for (int bj = 0; bj < 2; ++bj) sv[m][bj] = *(const u32x4*)(xs + (size_t)EPI_ROW(u, ai, m) * DM + EPI_COL(u, bj));
                asm volatile("" ::: "memory");
#pragma unroll
                for (int m = 0; m < 4; ++m) { bf16_t* dp = xs + (size_t)EPI_ROW(u, ai, m) * DM;
#pragma unroll
                    for (int bj = 0; bj < 2; ++bj) { const u32x4 s = sv[m][bj]; const f32x4 s0 = (f32x4){bflo(s.x), bfhi(s.x), bflo(s.y), bfhi(s.y)}, s1 = (f32x4){bflo(s.z), bfhi(s.z), bflo(s.w), bfhi(s.w)};
                        ST16(dp + EPI_COL(u, bj), pack8(s0 + gv[bj][0] * acc[ai][bj][m][0], s1 + gv[bj][1] * acc[ai][bj][m][1])); } }
            } else {
#pragma unroll
              for (int mh = 0; mh < 2; ++mh) { f32x4 sf[2][2][2];
#pragma unroll
                for (int mm = 0; mm < 2; ++mm) { const int r = EPI_ROW(u, ai, 2 * mh + mm); const int pos = r - b * LT;
                    const float* sp = isc ? src_ctx + (size_t)(b * CTX + pos) * DM : src_lat + (size_t)(b * SEQ + pos - CTX) * DM;
#pragma unroll
                    for (int bj = 0; bj < 2; ++bj) { const int c = EPI_COL(u, bj); sf[mm][bj][0] = *(const f32x4*)(sp + c); sf[mm][bj][1] = *(const f32x4*)(sp + c + 4); } }
                asm volatile("" ::: "memory");
#pragma unroll
                for (int mm = 0; mm < 2; ++mm) { const int m = 2 * mh + mm; bf16_t* dp = xs + (size_t)EPI_ROW(u, ai, m) * DM;
#pragma unroll
                    for (int bj = 0; bj < 2; ++bj) ST16(dp + EPI_COL(u, bj), pack8(sf[mm][bj][0] + gv[bj][0] * acc[ai][bj][m][0], sf[mm][bj][1] + gv[bj][1] * acc[ai][bj][m][1])); }
                asm volatile("" ::: "memory"); }
            }
            asm volatile("" ::: "memory");
        }
    }
};
struct EpiRouter {
    float* L;
    DI void operator()(const AccT& acc, const Unit& u, int wr, int wc, int fr, int fq) const {
        if (wc >= 2) return;
#pragma unroll
        for (int ai = 0; ai < 2; ++ai)
#pragma unroll
            for (int m = 0; m < 4; ++m) { float* rp = L + (size_t)EPI_ROW(u, ai, m) * 64 + wc * 32 + fq * 8; *(f32x4*)rp = acc[ai][0][m][0]; *(f32x4*)(rp + 4) = acc[ai][0][m][1]; }
    }
};
DI void st16_sc1(void* p, const u32x4& v) { asm volatile("global_store_dwordx4 %0, %1, off sc1\n\ts_nop 1" :: "v"(p), "v"(v) : "memory"); }
struct EpiGateUp {
    bf16_t* H; unsigned* flag;
    DI void operator()(const AccT& acc, const Unit& u, int wr, int wc, int fr, int fq) const {
#pragma unroll
        for (int ai = 0; ai < 2; ++ai)
#pragma unroll
            for (int m = 0; m < 4; ++m) { f32x4 o[2];
#pragma unroll
                for (int n = 0; n < 2; ++n)
#pragma unroll
                    for (int j = 0; j < 4; ++j) o[n][j] = silu_f(acc[ai][0][m][n][j]) * acc[ai][1][m][n][j];
                st16_sc1(H + (size_t)EPI_ROW(u, ai, m) * 256 + u.pn * 128 + wc * 32 + fq * 8, pack8(o[0], o[1])); }
        asm volatile("s_waitcnt vmcnt(0)" ::: "memory");
        __builtin_amdgcn_s_barrier();
        if ((wr | wc | fr | fq) == 0) (void)xb_add(flag + u.pm, 1u);
    }
};
struct EpiDownSorted {
    bf16_t* Y2; const float* rank_w; const LAS int* tab;
    DI void operator()(const AccT& acc, const Unit& u, int wr, int wc, int fr, int fq) const {
        float wv[2][4];
        const int rk0 = (tab[1 + u.pm] >> 8) * 256, cnt = tab[400 + u.z]; const float* rw = rank_w + (size_t)u.z * T;
#pragma unroll
        for (int ai = 0; ai < 2; ++ai)
#pragma unroll
            for (int m = 0; m < 4; ++m) { const int rank = rk0 + ai * 128 + wr * 64 + m * 16 + fr; wv[ai][m] = rank < cnt ? rw[rank] : 0.f; }
        asm volatile("" ::: "memory");
#pragma unroll
        for (int ai = 0; ai < 2; ++ai)
#pragma unroll
            for (int m = 0; m < 4; ++m) { const int r = EPI_ROW(u, ai, m); const float w = wv[ai][m]; bf16_t* rp = Y2 + (size_t)r * 1024;
#pragma unroll
                for (int bj = 0; bj < 2; ++bj) ST16(rp + EPI_COL(u, bj), pack8(acc[ai][bj][m][0] * w, acc[ai][bj][m][1] * w)); asm volatile("" ::: "memory"); }
    }
};
struct EpiDown {
    bf16_t* Y2; const int* row_dst; const float* row_w;
    DI void operator()(const AccT& acc, const Unit& u, int wr, int wc, int fr, int fq) const {
#pragma unroll
        for (int ai = 0; ai < 2; ++ai)
#pragma unroll
            for (int m = 0; m < 4; ++m) { const int r = EPI_ROW(u, ai, m); const int d = row_dst[r]; const float w = row_w[r];
                if (d >= 0) { bf16_t* rp = Y2 + (size_t)d * 1024;
#pragma unroll
                    for (int bj = 0; bj < 2; ++bj) ST16(rp + EPI_COL(u, bj), pack8(acc[ai][bj][m][0] * w, acc[ai][bj][m][1] * w)); } asm volatile("" ::: "memory"); }
    }
};
struct EpiInproj1 {
    bf16_t *CQ, *CKV, *KR, *BM; float* rowss; const f32x2* rope;
    DI void operator()(const AccT& acc, const Unit& u, int wr, int wc, int fr, int fq) const {
#pragma unroll
        for (int ai = 0; ai < 2; ++ai)
#pragma unroll
            for (int m = 0; m < 4; ++m) { const int r = EPI_ROW(u, ai, m);
                if (u.pn == 0) { float ss = 0.f;
#pragma unroll
                    for (int bj = 0; bj < 2; ++bj) { ST16(CQ + (size_t)r * 256 + bj * 128 + wc * 32 + fq * 8, pack8(acc[ai][bj][m][0], acc[ai][bj][m][1]));
#pragma unroll
                        for (int n = 0; n < 2; ++n)
#pragma unroll
                            for (int j = 0; j < 4; ++j) ss += acc[ai][bj][m][n][j] * acc[ai][bj][m][n][j]; }
                    ss += __shfl_xor(ss, 16); ss += __shfl_xor(ss, 32);
                    if (fq == 0) atomicAdd(rowss + r, ss);
                } else if (u.pn < 3) {
                    const int b = r / LT, pos = r % LT, ch = pos >> 5, j = pos & 31;
#pragma unroll
                    for (int bj = 0; bj < 2; ++bj) { const int uc = (u.pn - 1) * 256 + bj * 128 + wc * 32 + fq * 8; const int g = uc >> 4, hi0 = uc & 15;
                        ST16(BM + ((size_t)g * 1280 + ch * 16 + b) * 768 + j * 16 + hi0, pack8(acc[ai][bj][m][0], acc[ai][bj][m][1])); }
                } else {
                    ST16(CKV + (size_t)r * 128 + wc * 32 + fq * 8, pack8(acc[ai][0][m][0], acc[ai][0][m][1]));
                    float ss = 0.f;
#pragma unroll
                    for (int n = 0; n < 2; ++n)
#pragma unroll
                        for (int j = 0; j < 4; ++j) ss += acc[ai][0][m][n][j] * acc[ai][0][m][n][j];
                    ss += __shfl_xor(ss, 16); ss += __shfl_xor(ss, 32);
                    if (fq == 0) atomicAdd(rowss + T + r, ss);
                    if (wc == 0) {
                        const int pos = r % LT; f32x4 v0 = acc[ai][1][m][0], v1 = acc[ai][1][m][1], p0, p1;
#pragma unroll
                        for (int j = 0; j < 4; ++j) { p0[j] = __shfl_xor(v0[j], 16); p1[j] = __shfl_xor(v1[j], 16); }
                        if (pos >= CTX) { const int g = fq >> 1, s = fq & 1; const f32x2* cp = rope + (size_t)(pos - CTX) * 16 + g * 8;
#pragma unroll
                            for (int j = 0; j < 4; ++j) { const f32x2 c0 = cp[j], c1 = cp[4 + j];
                                v0[j] = s ? (p0[j] * c0.y + v0[j] * c0.x) : (v0[j] * c0.x - p0[j] * c0.y);
                                v1[j] = s ? (p1[j] * c1.y + v1[j] * c1.x) : (v1[j] * c1.x - p1[j] * c1.y); } }
                        ST16(KR + (size_t)r * 32 + fq * 8, pack8(v0, v1)); }
                }
                asm volatile("" ::: "memory");
            }
    }
};
struct EpiQup {
    bf16_t* QM; const f32x2* rope; float qscale;
    DI void operator()(const AccT& acc, const Unit& u, int wr, int wc, int fr, int fq) const {
#pragma unroll
        for (int ai = 0; ai < 2; ++ai)
#pragma unroll
            for (int m = 0; m < 4; ++m) { const int r = EPI_ROW(u, ai, m); bf16_t* rp = QM + (size_t)r * 768;
                if (u.pn < 2) {
#pragma unroll
                    for (int bj = 0; bj < 2; ++bj) { const int v = u.pn * 256 + bj * 128 + wc * 32 + fq * 8; ST16(rp + (v >> 6) * 96 + (v & 63), pack8(acc[ai][bj][m][0] * qscale, acc[ai][bj][m][1] * qscale)); }
                } else {
                    const int pos = r % LT; const int head = 2 * wc + (fq >> 1), g = fq & 1;
                    const f32x2* cp = rope + (size_t)(pos - CTX) * 16 + g * 8;
                    f32x4 o[2][2];
#pragma unroll
                    for (int n = 0; n < 2; ++n)
#pragma unroll
                        for (int j = 0; j < 4; ++j) { const f32x2 cs = cp[4 * n + j]; const float t1 = acc[ai][0][m][n][j], t2 = acc[ai][1][m][n][j]; o[0][n][j] = (t1 * cs.x - t2 * cs.y) * qscale; o[1][n][j] = (t1 * cs.y + t2 * cs.x) * qscale; }
#pragma unroll
                    for (int s = 0; s < 2; ++s) ST16(rp + head * 96 + 64 + 16 * g + 8 * s, pack8(o[s][0], o[s][1]));
                }
                asm volatile("" ::: "memory");
            }
    }
};
struct EpiKVup {
    bf16_t *Kn, *Vm;
    DI void operator()(const AccT& acc, const Unit& u, int wr, int wc, int fr, int fq) const {
        bf16_t* base = u.pn < 2 ? Kn : Vm; const int ct = (u.pn & 1) * 256;
#pragma unroll
        for (int ai = 0; ai < 2; ++ai)
#pragma unroll
            for (int m = 0; m < 4; ++m) { bf16_t* rp = base + (size_t)EPI_ROW(u, ai, m) * 512 + ct + wc * 32 + fq * 8;
#pragma unroll
                for (int bj = 0; bj < 2; ++bj) ST16(rp + bj * 128, pack8(acc[ai][bj][m][0], acc[ai][bj][m][1])); }
    }
};
struct EpiS5G1 {
    float* S;
    DI void operator()(const AccT& acc, const Unit& u, int wr, int wc, int fr, int fq) const {
#pragma unroll
        for (int ai = 0; ai < 2; ++ai)
#pragma unroll
            for (int m = 0; m < 4; ++m) { float* rp = S + ((size_t)u.z * 1280 + EPI_ROW(u, ai, m)) * 256 + wc * 32 + fq * 8;
#pragma unroll
                for (int bj = 0; bj < 2; ++bj) { *(f32x4*)(rp + bj * 128) = acc[ai][bj][m][0]; *(f32x4*)(rp + bj * 128 + 4) = acc[ai][bj][m][1]; } }
    }
};
struct EpiS5G2 {
    bf16_t* Y;
    DI void operator()(const AccT& acc, const Unit& u, int wr, int wc, int fr, int fq) const {
#pragma unroll
        for (int ai = 0; ai < 2; ++ai)
#pragma unroll
            for (int m = 0; m < 4; ++m) { const int rl = EPI_ROW(u, ai, m); const int R = rl >> 4, b = rl & 15;
#pragma unroll
                for (int bj = 0; bj < 2; ++bj) { const int c = EPI_COL(u, bj); const int k = c >> 4, ho0 = c & 15; f32x4 o[2];
#pragma unroll
                    for (int n = 0; n < 2; ++n)
#pragma unroll
                        for (int j = 0; j < 4; ++j) o[n][j] = gelu_tanh(acc[ai][bj][m][n][j]);
                    ST16(Y + (size_t)(b * LT + CTX + 32 * R + k) * 512 + u.z * 16 + ho0, pack8(o[0], o[1])); } asm volatile("" ::: "memory"); }
    }
};
struct EpiGLU {
    const bf16_t* Y; const float* bias; bf16_t* MIX; unsigned* flag;
    DI void operator()(const AccT& acc, const Unit& u, int wr, int wc, int fr, int fq) const {
        f32x4 bv[2][2];
#pragma unroll
        for (int bj = 0; bj < 2; ++bj) { const int c = EPI_COL(u, bj); bv[bj][0] = *(const f32x4*)(bias + c); bv[bj][1] = *(const f32x4*)(bias + c + 4); }
#pragma unroll
        for (int ai = 0; ai < 2; ++ai) { u32x4 gw[4][2];
#pragma unroll
            for (int m = 0; m < 4; ++m)
#pragma unroll
                for (int bj = 0; bj < 2; ++bj) gw[m][bj] = *(const u32x4*)(Y + (size_t)EPI_ROW(u, ai, m) * 512 + EPI_COL(u, bj));
            asm volatile("" ::: "memory");
#pragma unroll
            for (int m = 0; m < 4; ++m) { const int r = EPI_ROW(u, ai, m);
#pragma unroll
                for (int bj = 0; bj < 2; ++bj) { const int c = EPI_COL(u, bj); const u32x4 q = gw[m][bj];
                    const float g[8] = {bflo(q.x), bfhi(q.x), bflo(q.y), bfhi(q.y), bflo(q.z), bfhi(q.z), bflo(q.w), bfhi(q.w)};
                    f32x4 o[2];
#pragma unroll
                    for (int n = 0; n < 2; ++n)
#pragma unroll
                        for (int j = 0; j < 4; ++j) { const float z = acc[ai][bj][m][n][j] + bv[bj][n][j]; o[n][j] = g[4 * n + j] / (1.f + __expf(-z)); }
                    st16_sc1(MIX + (size_t)r * 1024 + 512 + c, pack8(o[0], o[1])); } }
            asm volatile("" ::: "memory"); }
        asm volatile("s_waitcnt vmcnt(0)" ::: "memory");
        __builtin_amdgcn_s_barrier();
        if ((wr | wc | fr | fq) == 0) (void)xb_add(flag + u.pm, 1u);
    }
};
struct Frame {
    LAS unsigned char* lds;
    int tid, lane, wave, gw, NGW;
    float* out; unsigned char* ws; unsigned* ctl;
    DI const float* in_(int i) const { const LAS unsigned* p = (const LAS unsigned*)(lds + PTAB_OFF) + 2 * i; const unsigned lo = __builtin_amdgcn_readfirstlane(p[0]), hi = __builtin_amdgcn_readfirstlane(p[1]); return (const float*)(const GAS float*)(((unsigned long long)hi << 32) | lo); }
};

template <class F>
DI void tr_item(const float* W, int K, int N, bf16_t* WT, LAS float* scr, int item, int lane, F rowmap, const float* kscale = nullptr) {
    const int nblk = N / 32, kb = item / nblk, nb = item % nblk, k0 = 64 * kb, n0 = 32 * nb;
    { f32x4 v[8];
#pragma unroll
      for (int i = 0; i < 8; ++i) v[i] = *(const f32x4*)(W + (size_t)(k0 + 8 * i + (lane >> 3)) * N + n0 + 4 * (lane & 7));
#pragma unroll
      for (int i = 0; i < 8; ++i) { LAS float* d = scr + (8 * i + (lane >> 3)) * 33 + 4 * (lane & 7); d[0] = v[i].x; d[1] = v[i].y; d[2] = v[i].z; d[3] = v[i].w; } }
    LDS_WAIT(); asm volatile("" ::: "memory");
    const int c = lane & 7;
    float ks[8];
#pragma unroll
    for (int e = 0; e < 8; ++e) ks[e] = kscale ? kscale[k0 + 8 * c + e] : 1.f;
#pragma unroll
    for (int j = 0; j < 4; ++j) { const int n = (lane >> 3) + 8 * j; const LAS float* s = scr + (8 * c) * 33 + n;
        u32x4 o; o.x = pk2(s[0 * 33] * ks[0], s[1 * 33] * ks[1]); o.y = pk2(s[2 * 33] * ks[2], s[3 * 33] * ks[3]); o.z = pk2(s[4 * 33] * ks[4], s[5 * 33] * ks[5]); o.w = pk2(s[6 * 33] * ks[6], s[7 * 33] * ks[7]);
        const int row = rowmap(n0 + n);
        if (row >= 0) *(u32x4*)(WT + (size_t)row * K + k0 + 8 * c) = o; }
    LDS_WAIT(); asm volatile("" ::: "memory");
}
DI int map_win0(int col) {
    if (col < 1536) return col;
    const int cp = col - 1536, hs = cp >> 6, d = cp & 63, tile = hs >> 2, wc = hs & 3;
    int bj, fq, r;
    if (hs < 10) { const int g = d >> 5, s = (d >> 4) & 1, i = d & 15; fq = 2 * g + (i >> 3); bj = s; r = i & 7; }
    else { bj = d >> 5; fq = (d >> 3) & 3; r = d & 7; }
    return 1536 + 256 * tile + 128 * bj + 32 * wc + 8 * fq + r;
}
DI int map_win1(int col) { return col < 256 ? col : (col < 384 ? 768 + (col - 256) : (col < 416 ? 896 + (col - 384) : 256 + (col - 416))); }
DI int map_wuq(int col) { const int head = col / 96, dd = col % 96; if (dd < 64) return head * 64 + dd; const int e = dd - 64, g = e >> 4, s = (e >> 3) & 1, i = e & 7; return 512 + 64 * (head >> 1) + 32 * s + 8 * (2 * (head & 1) + g) + i; }
DI int map_wukv(int col) { const int head = col >> 7, dd = col & 127; return dd < 64 ? head * 64 + dd : 512 + head * 64 + (dd - 64); }
DI int map_gate(int col) { return 256 * (col >> 7) + (col & 127); }

struct TrDesc { const float* W; bf16_t* WT; int K, N, item, radd; bool gate; };
DI void tr_load(const TrDesc& d, int lane, f32x4 (&v)[8]) { const int nblk = d.N / 32, kb = d.item / nblk, nb = d.item % nblk, k0 = 64 * kb, n0 = 32 * nb;
#pragma unroll
    for (int i = 0; i < 8; ++i) v[i] = *(const f32x4*)(d.W + (size_t)(k0 + 8 * i + (lane >> 3)) * d.N + n0 + 4 * (lane & 7)); }
DI void tr_finish(const TrDesc& d, LAS float* scr, int lane, const f32x4 (&v)[8]) { const int nblk = d.N / 32, kb = d.item / nblk, nb = d.item % nblk, k0 = 64 * kb, n0 = 32 * nb;
#pragma unroll
    for (int i = 0; i < 8; ++i) { LAS float* q = scr + (8 * i + (lane >> 3)) * 33 + 4 * (lane & 7); q[0] = v[i].x; q[1] = v[i].y; q[2] = v[i].z; q[3] = v[i].w; }
    LDS_WAIT(); asm volatile("" ::: "memory");
    const int c = lane & 7;
#pragma unroll
    for (int j = 0; j < 4; ++j) { const int n = (lane >> 3) + 8 * j; const LAS float* s = scr + (8 * c) * 33 + n;
        u32x4 o; o.x = pk2(s[0 * 33], s[1 * 33]); o.y = pk2(s[2 * 33], s[3 * 33]); o.z = pk2(s[4 * 33], s[5 * 33]); o.w = pk2(s[6 * 33], s[7 * 33]);
        const int col = n0 + n; const int row = d.gate ? map_gate(col) + d.radd : col;
        *(u32x4*)(d.WT + (size_t)row * d.K + k0 + 8 * c) = o; }
    LDS_WAIT(); asm volatile("" ::: "memory"); }
DI void moe_weight_items(Frame& F, int layer, LAS float* scr, int wrank, int nwrank) {
    const float* wg = F.in_(I_WGATE) + (size_t)layer * 32 * 1024 * 256; const float* wu = F.in_(I_WUP) + (size_t)layer * 32 * 1024 * 256; const float* wd = F.in_(I_WDOWN) + (size_t)layer * 32 * 256 * 1024;
    bf16_t* Wgu = (bf16_t*)(F.ws + WS_WGU); bf16_t* Wdn = (bf16_t*)(F.ws + WS_WDN);
    constexpr int IG = 16 * 8, ID = 4 * 32;
    constexpr int NIT = 32 * (2 * IG + ID);
    auto desc = [&](int it) { TrDesc d; const int e = it / (2 * IG + ID); int r = it % (2 * IG + ID);
        if (r < IG) { d.W = wg + (size_t)e * 1024 * 256; d.WT = Wgu + (size_t)e * 512 * 1024; d.K = 1024; d.N = 256; d.item = r; d.radd = 0; d.gate = true; }
        else if (r < 2 * IG) { d.W = wu + (size_t)e * 1024 * 256; d.WT = Wgu + (size_t)e * 512 * 1024; d.K = 1024; d.N = 256; d.item = r - IG; d.radd = 128; d.gate = true; }
        else { d.W = wd + (size_t)e * 256 * 1024; d.WT = Wdn + (size_t)e * 1024 * 256; d.K = 256; d.N = 1024; d.item = r - 2 * IG; d.radd = 0; d.gate = false; }
        return d; };
    int it = wrank; if (it >= NIT) return;
    TrDesc d = desc(it); f32x4 v[8]; tr_load(d, F.lane, v);
    for (;;) {
        const int itn = it + nwrank; const bool more = itn < NIT; TrDesc dn = d; f32x4 vn[8];
        if (more) { dn = desc(itn); tr_load(dn, F.lane, vn); }
        tr_finish(d, scr, F.lane, v);
        if (!more) break;
        d = dn; it = itn;
#pragma unroll
        for (int i = 0; i < 8; ++i) v[i] = vn[i];
    }
}
DI void router_rg_item(Frame& F, int layer) {
    const float* w = F.in_(I_WRG) + (size_t)layer * 1024 * 4; bf16_t* d = (bf16_t*)(F.ws + WS_WR) + (size_t)layer * 256 * 1024;
    for (int e = F.lane; e < 4096; e += 64) { const int k = e >> 2, n = e & 3; d[n * 1024 + k] = (bf16_t)f2bf(w[e]); }
}
DI void dense_weight_items_l0(Frame& F, LAS float* scr, int wrank, int nwrank) {
    constexpr int N0 = 16 * 72, N1 = 16 * 32, N7 = 16;
    constexpr int NIT = N0 + N1 + N7 + 1;
    for (int it = wrank; it < NIT; it += nwrank) {
        int r = it;
        if (r < N0) { tr_item(F.in_(I_EWIN), 1024, 2304, (bf16_t*)(F.ws + WS_WIN0), scr, r, F.lane, [](int c) { return map_win0(c); }); continue; } r -= N0;
        if (r < N1) { tr_item(F.in_(I_EWOUT), 1024, 1024, (bf16_t*)(F.ws + WS_WOUT0), scr, r, F.lane, [](int c) { return c; }); continue; } r -= N1;
        if (r < N7) { tr_item(F.in_(I_WRE), 1024, 32, (bf16_t*)(F.ws + WS_WR), scr, r, F.lane, [](int c) { return 4 + c; }); continue; }
        router_rg_item(F, 0);
    }
}
DI void dense_weight_items_l1(Frame& F, LAS float* scr, int wrank, int nwrank) {
    constexpr int N2 = 16 * 29, N3 = 4 * 24, N4 = 2 * 32, N5 = 8 * 16, N6 = 16 * 32, N8 = 16;
    constexpr int NIT = N2 + N3 + N4 + N5 + N6 + N8 + 1;
    for (int it = wrank; it < NIT; it += nwrank) {
        int r = it;
        if (r < N2) { tr_item(F.in_(I_OWIN), 1024, 928, (bf16_t*)(F.ws + WS_WIN1), scr, r, F.lane, [](int c) { return map_win1(c); }); continue; } r -= N2;
        if (r < N3) { tr_item(F.in_(I_WUQ), 256, 768, (bf16_t*)(F.ws + WS_WUQ), scr, r, F.lane, [](int c) { return map_wuq(c); }, F.in_(I_QNG)); continue; } r -= N3;
        if (r < N4) { tr_item(F.in_(I_WUKV), 128, 1024, (bf16_t*)(F.ws + WS_WUKV), scr, r, F.lane, [](int c) { return map_wukv(c); }, F.in_(I_KVNG)); continue; } r -= N4;
        if (r < N5) { tr_item(F.in_(I_GLUW), 512, 512, (bf16_t*)(F.ws + WS_WGLU), scr, r, F.lane, [](int c) { return c; }); continue; } r -= N5;
        if (r < N6) { tr_item(F.in_(I_OWOUT), 1024, 1024, (bf16_t*)(F.ws + WS_WOUT1), scr, r, F.lane, [](int c) { return c; }); continue; } r -= N6;
        if (r < N8) { tr_item(F.in_(I_WRE) + 1024 * 32, 1024, 32, (bf16_t*)(F.ws + WS_WR) + 256 * 1024, scr, r, F.lane, [](int c) { return 4 + c; }); continue; }
        router_rg_item(F, 1);
    }
}

DI void mod_block(Frame& F) {
    const int bx = bid_(); if (bx >= 192) return;
    const int layer = bx / 96, cg = bx % 96;
    LAS float* sc = (LAS float*)F.lds;
    LAS float* red = (LAS float*)(F.lds + 17 * 1024 * 4);
    const float* W = F.in_(I_WMOD) + (size_t)layer * 1024 * 6144 + cg * 64 + F.lane;
    const int kb = F.wave * 128;
    float wv[32];
#pragma unroll
    for (int j = 0; j < 32; ++j) wv[j] = W[(size_t)(kb + j) * 6144];
    for (int e = F.tid; e < 17 * 1024; e += NTHR) { const int b = e >> 10, k = e & 1023; const float v = b < 16 ? F.in_(I_C)[b * 1024 + k] : F.in_(I_CCTX)[k]; sc[e] = silu_f(v); }
    __syncthreads();
    float acc[17];
#pragma unroll
    for (int b = 0; b < 17; ++b) acc[b] = 0.f;
#pragma unroll 1
    for (int k0 = 0; k0 < 128; k0 += 32) { float wc[32];
#pragma unroll
        for (int j = 0; j < 32; ++j) wc[j] = wv[j];
        if (k0 + 32 < 128) {
#pragma unroll
            for (int j = 0; j < 32; ++j) wv[j] = W[(size_t)(kb + k0 + 32 + j) * 6144]; }
#pragma unroll
        for (int j = 0; j < 32; ++j)
#pragma unroll
            for (int b = 0; b < 17; ++b) acc[b] += sc[b * 1024 + kb + k0 + j] * wc[j]; }
#pragma unroll
    for (int b = 0; b < 17; ++b) red[(F.wave * 17 + b) * 64 + F.lane] = acc[b];
    __syncthreads();
    for (int e = F.tid; e < 17 * 64; e += NTHR) { const int b = e >> 6, l = e & 63; float s = 0.f;
#pragma unroll
        for (int w = 0; w < 8; ++w) s += red[(w * 17 + b) * 64 + l];
        const int col = cg * 64 + l; ((float*)(F.ws + WS_MODV))[((size_t)layer * 17 + b) * 6144 + col] = s + F.in_(I_BMOD)[layer * 6144 + col]; }
    __syncthreads();
}

DI float red2pi(float x) { const float k = rintf(x * 0.15915494309189535f); float r = fmaf(-k, 6.28318548202514648f, x); r = fmaf(-k, -1.7484556e-7f, r); return r * 0.15915494309189535f; }
DI float sin_hw(float x) { return __builtin_amdgcn_sinf(red2pi(x)); }
DI float cos_hw(float x) { return __builtin_amdgcn_cosf(red2pi(x)); }
DI void lds_addf(LAS float* p, float v) { (void)__hip_atomic_fetch_add(p, v, __ATOMIC_RELAXED, __HIP_MEMORY_SCOPE_WORKGROUP); }
DI void hyena_filter_block72(Frame& F) {
    const int bx = bid_(), tg = bx >> 3, cg = bx & 7, tid = F.tid, r = F.wave, hh = tid & 63;
    LAS float* w3s = (LAS float*)F.lds;
    LAS float* w2s = w3s + 16384;
    LAS float* bfs = w2s + 4096;
    LAS float* h1 = bfs + 192;
    LAS float* w1s = h1 + 4608;
    LAS float* zz = w1s + 2112;
    LAS float* h2t = w1s;
    LAS float* ost = w3s;
    LAS float* sums = h1;
    const float* w1 = F.in_(I_HW1); const float* w2 = F.in_(I_HW2); const float* w3 = F.in_(I_HW3);
    { f32x4 a3[8], a2[2], a1[2]; float ab = 0.f;
#pragma unroll
      for (int k = 0; k < 8; ++k) { const int idx = tid + 512 * k; a3[k] = *(const f32x4*)(w3 + (size_t)(idx >> 6) * 2048 + cg * 256 + (idx & 63) * 4); }
#pragma unroll
      for (int k = 0; k < 2; ++k) a2[k] = *(const f32x4*)(w2 + (tid + 512 * k) * 4);
      a1[0] = *(const f32x4*)(w1 + tid * 4); a1[1] = tid < 16 ? *(const f32x4*)(w1 + (512 + tid) * 4) : (f32x4){0.f, 0.f, 0.f, 0.f};
      if (tid < 192) ab = tid < 64 ? F.in_(I_HB1)[tid] : tid < 128 ? F.in_(I_HB2)[tid - 64] : F.in_(I_HFREQ)[tid - 128];
#pragma unroll 1
      for (int e = tid; e < 72 * 33; e += NTHR) { const int tt = e / 33, f = e % 33; const int n = tt < 64 ? 2048 : 256; const float t = (float)(tt < 64 ? tg * 64 + tt : tg * 8 + tt - 64); float v;
          if (f == 0) v = t / (float)(n - 1); else { const int kk = (f - 1) & 15; const float band = 1e-4f + (float)kk * ((15.f - 1e-4f) / 15.f); const float ang = (6.283185307179586f / (float)n) * t * band; v = (f <= 16) ? cos_hw(ang) : sin_hw(ang); }
          zz[tt * 36 + f] = v; }
#pragma unroll
      for (int k = 0; k < 8; ++k) *(LAS f32x4*)(w3s + (tid + 512 * k) * 4) = a3[k];
#pragma unroll
      for (int k = 0; k < 2; ++k) *(LAS f32x4*)(w2s + (tid + 512 * k) * 4) = a2[k];
      *(LAS f32x4*)(w1s + tid * 4) = a1[0]; if (tid < 16) *(LAS f32x4*)(w1s + (512 + tid) * 4) = a1[1];
      if (tid < 192) bfs[tid] = ab; }
    __syncthreads();
    { float s[9];
#pragma unroll
      for (int k = 0; k < 9; ++k) s[k] = bfs[hh];
#pragma unroll 2
      for (int f = 0; f < 32; f += 4) { const float wa = w1s[f * 64 + hh], wb = w1s[(f + 1) * 64 + hh], wc_ = w1s[(f + 2) * 64 + hh], wd = w1s[(f + 3) * 64 + hh];
#pragma unroll
          for (int k = 0; k < 9; ++k) { const f32x4 z = *(const LAS f32x4*)(zz + (r + 8 * k) * 36 + f); s[k] += z.x * wa + z.y * wb + z.z * wc_ + z.w * wd; } }
      { const float w = w1s[32 * 64 + hh];
#pragma unroll
        for (int k = 0; k < 9; ++k) s[k] += zz[(r + 8 * k) * 36 + 32] * w; }
#pragma unroll
      for (int k = 0; k < 9; ++k) h1[(r + 8 * k) * 64 + hh] = s[k];
      const float fq_ = bfs[128 + hh];
#pragma unroll 1
      for (int k = 0; k < 9; ++k) { LAS float* q = h1 + (r + 8 * k) * 64 + hh; *q = sin_hw(fq_ * *q); } }
    __syncthreads();
    { float s[9];
#pragma unroll
      for (int k = 0; k < 9; ++k) s[k] = bfs[64 + hh];
#pragma unroll 2
      for (int f = 0; f < 64; f += 4) { const float wa = w2s[f * 64 + hh], wb = w2s[(f + 1) * 64 + hh], wc_ = w2s[(f + 2) * 64 + hh], wd = w2s[(f + 3) * 64 + hh];
#pragma unroll
          for (int k = 0; k < 9; ++k) { const f32x4 z = *(const LAS f32x4*)(h1 + (r + 8 * k) * 64 + f); s[k] += z.x * wa + z.y * wb + z.z * wc_ + z.w * wd; } }
      __syncthreads();
      const float fq_ = bfs[128 + hh];
#pragma unroll
      for (int k = 0; k < 9; ++k) { const int tt = r + 8 * k; h2t[hh * 96 + (tt / 9) * 12 + tt % 9] = s[k]; }
#pragma unroll 1
      for (int k = 0; k < 9; ++k) { const int tt = r + 8 * k; LAS float* q = h2t + hh * 96 + (tt / 9) * 12 + tt % 9; *q = sin_hw(fq_ * *q); } }
    sums[tid] = 0.f;
    __syncthreads();
    const int c4 = tid & 63;
    f32x4 acc[9];
#pragma unroll
    for (int i = 0; i < 9; ++i) acc[i] = (f32x4){0.f, 0.f, 0.f, 0.f};
#pragma unroll 2
    for (int h = 0; h < 64; ++h) { const f32x4 wv = *(const LAS f32x4*)(w3s + h * 256 + c4 * 4);
        const f32x4 ha = *(const LAS f32x4*)(h2t + h * 96 + r * 12), hb = *(const LAS f32x4*)(h2t + h * 96 + r * 12 + 4); const float hc = h2t[h * 96 + r * 12 + 8];
        acc[0] += wv * ha.x; acc[1] += wv * ha.y; acc[2] += wv * ha.z; acc[3] += wv * ha.w; acc[4] += wv * hb.x; acc[5] += wv * hb.y; acc[6] += wv * hb.z; acc[7] += wv * hb.w; acc[8] += wv * hc; }
    __syncthreads();
    const int dir = cg >> 2, o = (cg >> 1) & 1, cb = (cg & 1) * 256;
    const float dmin = 3.0701134573253945f, dmax = 15.350567286626973f;
    { f32x4 ssl = (f32x4){0.f, 0.f, 0.f, 0.f}, ssc = (f32x4){0.f, 0.f, 0.f, 0.f};
#pragma unroll
      for (int i = 0; i < 9; ++i) { const int tt = r * 9 + i; const bool lat = tt < 64; const int n = lat ? 2048 : 256; const int t = lat ? tg * 64 + tt : tg * 8 + tt - 64; const float tn = (float)t / (float)(n - 1);
          const bool live = !(dir == 1 && t == 0);
#pragma unroll
          for (int q = 0; q < 4; ++q) { const float delta = dmin + (float)(cb + c4 * 4 + q) * ((dmax - dmin) / 511.f); const float v = live ? acc[i][q] * __expf(-tn * delta) : 0.f;
              ost[(c4 * 4 + q) * 73 + tt] = v; if (lat) ssl[q] += v * v; else ssc[q] += v * v; } }
#pragma unroll
      for (int q = 0; q < 4; ++q) { lds_addf(sums + c4 * 4 + q, ssl[q]); if (r == 7) lds_addf(sums + 256 + c4 * 4 + q, ssc[q]); } }
    __syncthreads();
    { float* graw = (float*)(F.ws + WS_GRAW); float* grawc = (float*)(F.ws + WS_GRAWC); const int lane = tid & 63;
#pragma unroll 4
      for (int jj = 0; jj < 32; ++jj) { const int j = r * 32 + jj; const int t = tg * 64 + lane; float* gp = graw + ((size_t)o * 512 + cb + j) * 4096; const float v = ost[j * 73 + lane];
          if (dir == 0) gp[2048 - t] = v; else if (t > 0) gp[2048 + t] = v; }
#pragma unroll
      for (int k = 0; k < 4; ++k) { const int j = r * 32 + k * 8 + (lane >> 3), i = lane & 7; const int t = tg * 8 + i; float* gp = grawc + ((size_t)o * 512 + cb + j) * 512; const float v = ost[j * 73 + 64 + i];
          if (dir == 0) gp[256 - t] = v; else if (t > 0) gp[256 + t] = v; }
      if (tid < 256) ((float*)(F.ws + WS_HYPART))[(size_t)tg * 2048 + cg * 256 + tid] = sums[tid];
      else ((float*)(F.ws + WS_HYPARTC))[(size_t)tg * 2048 + cg * 256 + tid - 256] = sums[tid];
      if (tg == 0 && dir == 0 && tid < 256) { graw[((size_t)o * 512 + cb + tid) * 4096] = 0.f; grawc[((size_t)o * 512 + cb + tid) * 512] = 0.f; } }
    __syncthreads();
}

DI void s5_ktab_block(Frame& F) {
    const int bx = bid_(), g = bx >> 3, d = bx & 1, m0 = ((bx >> 1) & 3) * 8;
    LAS float* par = (LAS float*)F.lds;
    LAS float* bb = par + 256;
    LAS float* cc = bb + 2048;
    LAS float* lam = cc + 2048;
    const int dg = d * 32 + g;
    if (F.tid < 64) { const int p = F.tid; const float are = F.in_(I_SARE)[dg * 64 + p], aim = F.in_(I_SAIM)[dg * 64 + p]; const float dt = __expf(F.in_(I_SLDT)[dg]);
        const float lr = are * dt, th = aim * dt; float sn, cs; sincosf(th, &sn, &cs); const float em1 = expm1f(lr); const float sh = sinf(0.5f * th);
        const float er = em1 * cs - 2.f * sh * sh, ei = (em1 + 1.f) * sn; const float den = are * are + aim * aim;
        const float cor = (er * are + ei * aim) / den, coi = (ei * are - er * aim) / den;
        par[p * 4 + 0] = lr; par[p * 4 + 1] = th; par[p * 4 + 2] = cor; par[p * 4 + 3] = coi;
        if (m0 == 0) *(f32x4*)((float*)(F.ws + WS_S5PAR) + (size_t)(dg * 64 + p) * 4) = (f32x4){lr, th, cor, coi}; }
    __syncthreads();
    for (int e = F.tid; e < 1024; e += NTHR) { const int p = e >> 4, hi = e & 15; const float br = F.in_(I_SBRE)[(size_t)(dg * 64 + p) * 16 + hi], bi = F.in_(I_SBIM)[(size_t)(dg * 64 + p) * 16 + hi];
        const float cor = par[p * 4 + 2], coi = par[p * 4 + 3]; bb[e * 2] = cor * br - coi * bi; bb[e * 2 + 1] = cor * bi + coi * br; }
    for (int e = F.tid; e < 1024; e += NTHR) { const int ho = e >> 6, p = e & 63; cc[e * 2] = F.in_(I_SCRE)[(size_t)(dg * 16 + ho) * 64 + p]; cc[e * 2 + 1] = F.in_(I_SCIM)[(size_t)(dg * 16 + ho) * 64 + p]; }
    { const int ml = F.tid >> 6, p = F.tid & 63; const float m = (float)(m0 + ml); const float mg = __expf(m * par[p * 4]); float sn, cs; sincosf(m * par[p * 4 + 1], &sn, &cs); lam[F.tid * 2] = mg * cs; lam[F.tid * 2 + 1] = mg * sn; }
    __syncthreads();
    float* kt = (float*)(F.ws + WS_KTAB) + ((size_t)dg * 32 + m0) * 256;
    for (int e = F.tid; e < 2048; e += NTHR) { const int ml = e >> 8, ho = (e >> 4) & 15, hi = e & 15; float s = 0.f;
        for (int p = 0; p < 64; ++p) { const float lr = lam[(ml * 64 + p) * 2], li = lam[(ml * 64 + p) * 2 + 1], br = bb[(p * 16 + hi) * 2], bi = bb[(p * 16 + hi) * 2 + 1];
            const float wr_ = lr * br - li * bi, wi_ = lr * bi + li * br; s += cc[(ho * 64 + p) * 2] * wr_ - cc[(ho * 64 + p) * 2 + 1] * wi_; }
        kt[e] = s; }
    __syncthreads();
}

DI void rope_table1(Frame& F, int gt, int NG) {
    f32x2* r1 = (f32x2*)(F.ws + WS_ROPE1);
    for (int e = gt; e < 2048 * 16; e += NG) { const int p = e >> 4, g = (e >> 3) & 1, i = e & 7; const float pos = (float)(g ? (p & 63) : (p >> 6)); const float fr = exp2f(-(float)i * (13.287712379549449f / 8.f)); float sn, cs; sincosf(pos * fr, &sn, &cs); r1[e] = (f32x2){cs, sn}; }
}
DI void rope_tables(Frame& F) {
    const int gt = bid_() * NTHR + F.tid, NG = gdim_() * NTHR;
    f32x2* r0 = (f32x2*)(F.ws + WS_ROPE0);
    for (int e = gt; e < 2048 * 32; e += NG) { const int p = e >> 5, g = (e >> 4) & 1, i = e & 15; const float pos = (float)(g ? (p & 63) : (p >> 6)); const float fr = exp2f(-(float)i * (13.287712379549449f / 16.f)); float sn, cs; sincosf(pos * fr, &sn, &cs); r0[e] = (f32x2){cs, sn}; }
}

DI void p0_compute_part(Frame& F) {
    hyena_filter_block72(F);
#if PROBE_HF > 1
    hyena_filter_block72(F);
#endif
    s5_ktab_block(F);
#if PROBE_KT > 1
    s5_ktab_block(F);
#endif
    rope_tables(F);
}
DI void p0_weight_part(Frame& F) {
    __syncthreads();
    LAS float* scr = (LAS float*)(F.lds + F.wave * 16384);
    dense_weight_items_l0(F, scr, F.gw, F.NGW);
#if !MOE0_IN_P4
    moe_weight_items(F, 0, scr, F.gw, F.NGW);
#endif
    __syncthreads();
}

DI void normf_items(Frame& F, int gt) {
    if (gt < 2048) { const int seg = gt >> 10, oc = gt & 1023; const float* part = (const float*)(F.ws + (seg ? WS_HYPARTC : WS_HYPART)); float s = 0.f;
        for (int b = 0; b < 256; ++b) s += part[(size_t)b * 2048 + oc] + part[(size_t)b * 2048 + 1024 + oc];
        ((float*)(F.ws + WS_NORMF))[gt] = 1.f / sqrtf(s + EPS); }
}
DI void s5_expand(Frame& F, int gt, int NG) {
    const float* ktab = (const float*)(F.ws + WS_KTAB); const f32x4* par = (const f32x4*)(F.ws + WS_S5PAR);
    bf16_t* SA = (bf16_t*)(F.ws + WS_S5A); bf16_t* SW = (bf16_t*)(F.ws + WS_S5W);
    { constexpr int LIM = 32 * 512 * 64; const float* sd = F.in_(I_SD);
      for (int it0 = gt; it0 < LIM; it0 += 4 * NG) { f32x4 a[4][2], b2[4][2]; float ds[4];
#pragma unroll
        for (int q = 0; q < 4; ++q) { const int it = (it0 + q * NG < LIM) ? it0 + q * NG : LIM - 1;
            const int g = it >> 15, row = (it >> 6) & 511, c8 = (it & 63) * 8, j = c8 >> 4, hi0 = c8 & 15, k = row >> 4, ho = row & 15, dlt = k - j, ad = dlt < 0 ? -dlt : dlt;
            const float* kpA = ktab + (((size_t)((dlt >= 0 ? 0 : 32) + g) * 32 + ad) * 16 + ho) * 16 + hi0; const float* kpB = ktab + (((size_t)(32 + g) * 32) * 16 + ho) * 16 + hi0;
            a[q][0] = *(const f32x4*)kpA; a[q][1] = *(const f32x4*)(kpA + 4); b2[q][0] = *(const f32x4*)kpB; b2[q][1] = *(const f32x4*)(kpB + 4); ds[q] = sd[g * 16 + ho]; }
#pragma unroll
        for (int q = 0; q < 4; ++q) { const int it = it0 + q * NG; if (it < LIM) {
            const int g = it >> 15, row = (it >> 6) & 511, c8 = (it & 63) * 8, j = c8 >> 4, hi0 = c8 & 15, k = row >> 4, ho = row & 15;
            float v[8];
#pragma unroll
            for (int e2 = 0; e2 < 8; ++e2) { v[e2] = a[q][e2 >> 2][e2 & 3]; if (k == j) v[e2] += b2[q][e2 >> 2][e2 & 3] + ((hi0 + e2) == ho ? ds[q] : 0.f); }
            u32x4 o; o.x = pk2(v[0], v[1]); o.y = pk2(v[2], v[3]); o.z = pk2(v[4], v[5]); o.w = pk2(v[6], v[7]);
            *(u32x4*)(SA + ((size_t)g * 512 + row) * 768 + c8) = o; } }
      } }
    { constexpr int LIM = 32 * 512 * 32; const float* scre = F.in_(I_SCRE); const float* scim = F.in_(I_SCIM);
      for (int it0 = gt; it0 < LIM; it0 += 2 * NG) { f32x4 prv[2][8], crv[2][2], civ[2][2];
#pragma unroll
        for (int q = 0; q < 2; ++q) { const int it = (it0 + q * NG < LIM) ? it0 + q * NG : LIM - 1;
            const int g = it >> 14, row = (it >> 5) & 511, cc = (it & 31) * 8, d = cc >> 7, p0 = cc & 63, dg = d * 32 + g, ho = row & 15;
#pragma unroll
            for (int e2 = 0; e2 < 8; ++e2) prv[q][e2] = par[dg * 64 + p0 + e2];
            const float* cp = scre + (size_t)(dg * 16 + ho) * 64 + p0; const float* ip = scim + (size_t)(dg * 16 + ho) * 64 + p0;
            crv[q][0] = *(const f32x4*)cp; crv[q][1] = *(const f32x4*)(cp + 4); civ[q][0] = *(const f32x4*)ip; civ[q][1] = *(const f32x4*)(ip + 4); }
#pragma unroll
        for (int q = 0; q < 2; ++q) { const int it = it0 + q * NG; if (it < LIM) {
            const int g = it >> 14, row = (it >> 5) & 511, cc = (it & 31) * 8, d = cc >> 7, im = (cc >> 6) & 1, k = row >> 4; const float pw = d == 0 ? (float)(k + 1) : (float)(32 - k);
            float v[8];
#pragma unroll
            for (int e2 = 0; e2 < 8; ++e2) { const f32x4 pr = prv[q][e2]; const float mg = __expf(pw * pr.x); const float sn = sin_hw(pw * pr.y), cs = cos_hw(pw * pr.y); const float lr = mg * cs, li = mg * sn;
                const float cr = crv[q][e2 >> 2][e2 & 3], ci = civ[q][e2 >> 2][e2 & 3]; v[e2] = im ? -(cr * li + ci * lr) : (cr * lr - ci * li); }
            u32x4 o; o.x = pk2(v[0], v[1]); o.y = pk2(v[2], v[3]); o.z = pk2(v[4], v[5]); o.w = pk2(v[6], v[7]);
            *(u32x4*)(SA + ((size_t)g * 512 + row) * 768 + 512 + cc) = o; } }
      } }
    for (int it0 = gt; it0 < 32 * 256 * 64; it0 += 4 * NG) { u32x4 o[4];
#pragma unroll
      for (int q = 0; q < 4; ++q) { const int it = it0 + q * NG; if (it < 32 * 256 * 64) {
        const int g = it / (256 * 64), rem = it % (256 * 64), n = rem >> 6, c8 = (rem & 63) * 8; const int d = n >> 7, im = (n >> 6) & 1, p = n & 63, j = c8 >> 4, hi0 = c8 & 15; const int dg = d * 32 + g;
        const f32x4 pr = par[dg * 64 + p]; const float pw = d == 0 ? (float)(31 - j) : (float)j; const float mg = __expf(pw * pr.x); const float sn = sin_hw(pw * pr.y), cs = cos_hw(pw * pr.y); const float lr = mg * cs, li = mg * sn;
        float v[8];
#pragma unroll
        for (int e = 0; e < 8; ++e) { const float br = F.in_(I_SBRE)[(size_t)(dg * 64 + p) * 16 + hi0 + e], bi = F.in_(I_SBIM)[(size_t)(dg * 64 + p) * 16 + hi0 + e];
            const float Br = pr.z * br - pr.w * bi, Bi = pr.z * bi + pr.w * br; v[e] = im ? (lr * Bi + li * Br) : (lr * Br - li * Bi); }
        o[q].x = pk2(v[0], v[1]); o[q].y = pk2(v[2], v[3]); o[q].z = pk2(v[4], v[5]); o[q].w = pk2(v[6], v[7]); } }
#pragma unroll
      for (int q = 0; q < 4; ++q) { const int it = it0 + q * NG; if (it < 32 * 256 * 64) { const int g = it / (256 * 64), rem = it % (256 * 64), n = rem >> 6, c8 = (rem & 63) * 8;
        *(u32x4*)(SW + ((size_t)g * 256 + n) * 512 + c8) = o[q]; } }
    }
}
#define MFMA16(a, b, c) __builtin_amdgcn_mfma_f32_16x16x32_bf16((a), (b), (c), 0, 0, 0)
#define MFMA32(a, b, c) __builtin_amdgcn_mfma_f32_32x32x16_bf16((a), (b), (c), 0, 0, 0)
DI int lds_add(LAS int* p, int v) { return __hip_atomic_fetch_add(p, v, __ATOMIC_RELAXED, __HIP_MEMORY_SCOPE_WORKGROUP); }
DI int lat_row(int tl) { return (tl >> 11) * LT + CTX + (tl & 2047); }

DI int xcd_bid() { const int c = bid_(); return (c & 7) * (gdim_() >> 3) + (c >> 3); }
DI int xcd_gw(const Frame& F) { return xcd_bid() * NWAVES + F.wave; }
template <int RPW = 3>
DI void modnorm_phase(Frame& F, int layer, int which, bool lat_only, const float* lat, const float* ctx, bf16_t* H) {
    const float* ng = F.in_(I_NORMG) + (layer * 2 + which) * 1024; const float* mv = (const float*)(F.ws + WS_MODV) + (size_t)layer * 17 * 6144 + (which ? 3072 : 0);
    const int nrows = lat_only ? NB * SEQ : T;
    f32x4 g4[4];
#pragma unroll
    for (int j = 0; j < 4; ++j) g4[j] = *(const f32x4*)(ng + 4 * F.lane + 256 * j);
    const int per = (nrows + F.NGW - 1) / F.NGW, r_lo = xcd_gw(F) * per, r_hi = (r_lo + per < nrows) ? r_lo + per : nrows;
    f32x4 gs[4], sh[4]; int cur = -1;
    f32x4 vn[RPW][4];
#define MN_SRC(i_) ({ const int r_ = lat_only ? lat_row(i_) : (i_); const int b_ = r_ / LT, pos_ = r_ % LT; (pos_ < CTX) ? ctx + (size_t)(b_ * CTX + pos_) * DM : lat + (size_t)(b_ * SEQ + pos_ - CTX) * DM; })
    if (r_lo < r_hi) {
#pragma unroll
        for (int u = 0; u < RPW; ++u) { const int i = (r_lo + u < r_hi) ? r_lo + u : r_hi - 1; const float* src = MN_SRC(i);
#pragma unroll
            for (int j = 0; j < 4; ++j) vn[u][j] = *(const f32x4*)(src + 4 * F.lane + 256 * j); } }
#pragma unroll 1
    for (int i0 = r_lo; i0 < r_hi; i0 += RPW) {
        f32x4 v[RPW][4];
#pragma unroll
        for (int u = 0; u < RPW; ++u)
#pragma unroll
            for (int j = 0; j < 4; ++j) v[u][j] = vn[u][j];
        if (i0 + RPW < r_hi) {
#pragma unroll
            for (int u = 0; u < RPW; ++u) { const int i = (i0 + RPW + u < r_hi) ? i0 + RPW + u : r_hi - 1; const float* src = MN_SRC(i);
#pragma unroll
                for (int j = 0; j < 4; ++j) vn[u][j] = *(const f32x4*)(src + 4 * F.lane + 256 * j); } }
#pragma unroll
        for (int u = 0; u < RPW; ++u) { const int i = i0 + u; if (i < r_hi) {
            const int r = lat_only ? lat_row(i) : i; const int mi = (r % LT) < CTX ? 16 : r / LT;
            if (mi != cur) { cur = mi; const float* mrow = mv + mi * 6144;
#pragma unroll
                for (int j = 0; j < 4; ++j) { sh[j] = *(const f32x4*)(mrow + 4 * F.lane + 256 * j); gs[j] = g4[j] * (*(const f32x4*)(mrow + 1024 + 4 * F.lane + 256 * j) + 1.f); } }
            float ss = 0.f;
#pragma unroll
            for (int j = 0; j < 4; ++j) ss += (v[u][j].x * v[u][j].x + v[u][j].y * v[u][j].y) + (v[u][j].z * v[u][j].z + v[u][j].w * v[u][j].w);
            const float rstd = 1.f / sqrtf(wave_sum(ss) * (1.f / DM) + EPS);
#pragma unroll
            for (int j = 0; j < 4; ++j) { const f32x4 y = v[u][j] * rstd * gs[j] + sh[j];
                *(u32x2*)(H + (size_t)r * DM + 4 * F.lane + 256 * j) = (u32x2){pk2(y.x, y.y), pk2(y.z, y.w)}; } } }
    }
#undef MN_SRC
}

template <bool FINAL>
DI void combine_phase(Frame& F, int layer, bf16_t* XS, float* out, const bf16_t* Y2, bf16_t* H) {
    const float* mvg = (const float*)(F.ws + WS_MODV) + (size_t)layer * 17 * 6144 + 5120;
    const float* mvn = (const float*)(F.ws + WS_MODV) + (size_t)(layer + 1) * 17 * 6144;
    const float* ng = FINAL ? F.in_(I_FINALG) : F.in_(I_NORMG) + ((layer + 1) * 2) * 1024;
    const int nrows = FINAL ? NB * SEQ : T;
    const LAS int* ttab = (const LAS int*)(F.lds + LDS_TAB_OFF);
    const int* tpb = (const int*)(F.ws + WS_TOKPOS);
    f32x4 g4[4];
#pragma unroll
    for (int j = 0; j < 4; ++j) g4[j] = *(const f32x4*)(ng + 4 * F.lane + 256 * j);
    const int per = (nrows + F.NGW - 1) / F.NGW, r_lo = xcd_gw(F) * per, r_hi = (r_lo + per < nrows) ? r_lo + per : nrows;
    if (r_lo >= r_hi) return;
#define CB_ROW(i_) (FINAL ? lat_row(i_) : (i_))
#define CB_CL(i_) ((i_) < r_hi ? (i_) : r_hi - 1)
#define CB_POS(t_) ((size_t)(256 * ttab[432 + ((t_) >> 16)] + ((t_) & 0xffff)))
#define CB_LOAD(X_, A_, B_, i_, t0_, t1_) do { const bf16_t* px_ = XS + (size_t)CB_ROW(CB_CL(i_)) * DM; const bf16_t* pa_ = Y2 + CB_POS(t0_) * DM; const bf16_t* pb_ = Y2 + CB_POS(t1_) * DM; \
        _Pragma("unroll") for (int j = 0; j < 4; ++j) { const int c_ = 4 * F.lane + 256 * j; X_[j] = *(const u32x2*)(px_ + c_); A_[j] = *(const u32x2*)(pa_ + c_); B_[j] = *(const u32x2*)(pb_ + c_); } } while (0)
    f32x4 gg[4], sh[4], gs[4]; int cur = -1;
    u32x2 xn[2][4], an[2][4], bn[2][4]; int tn[2][2];
#pragma unroll
    for (int u = 0; u < 2; ++u) { const int* tp = tpb + (size_t)CB_ROW(CB_CL(r_lo + u)) * 2; const int t0 = tp[0], t1 = tp[1]; CB_LOAD(xn[u], an[u], bn[u], r_lo + u, t0, t1); }
#pragma unroll
    for (int u = 0; u < 2; ++u) { const int* tp = tpb + (size_t)CB_ROW(CB_CL(r_lo + 2 + u)) * 2; tn[u][0] = tp[0]; tn[u][1] = tp[1]; }
#pragma unroll 1
    for (int i0 = r_lo; i0 < r_hi; i0 += 2) {
        u32x2 xv[2][4], ya[2][4], yb[2][4];
#pragma unroll
        for (int u = 0; u < 2; ++u)
#pragma unroll
            for (int j = 0; j < 4; ++j) { xv[u][j] = xn[u][j]; ya[u][j] = an[u][j]; yb[u][j] = bn[u][j]; }
        if (i0 + 2 < r_hi) {
#pragma unroll
            for (int u = 0; u < 2; ++u) CB_LOAD(xn[u], an[u], bn[u], i0 + 2 + u, tn[u][0], tn[u][1]);
#pragma unroll
            for (int u = 0; u < 2; ++u) { const int* tp = tpb + (size_t)CB_ROW(CB_CL(i0 + 4 + u)) * 2; tn[u][0] = tp[0]; tn[u][1] = tp[1]; } }
#pragma unroll
        for (int u = 0; u < 2; ++u) { const int i = i0 + u; if (i < r_hi) {
            const int r = CB_ROW(i); const int mi = (r % LT) < CTX ? 16 : r / LT;
            if (mi != cur) { cur = mi; const float* grow = mvg + mi * 6144; const float* mrow = mvn + mi * 6144;
#pragma unroll
                for (int j = 0; j < 4; ++j) { const int c = 4 * F.lane + 256 * j; gg[j] = *(const f32x4*)(grow + c);
                    if (!FINAL) { sh[j] = *(const f32x4*)(mrow + c); gs[j] = g4[j] * (*(const f32x4*)(mrow + 1024 + c) + 1.f); } } }
            f32x4 v[4]; float ss = 0.f;
#pragma unroll
            for (int j = 0; j < 4; ++j) { const u32x2 a = ya[u][j], bb = yb[u][j], xx = xv[u][j];
                f32x4 m; m.x = bflo(a.x) + bflo(bb.x); m.y = bfhi(a.x) + bfhi(bb.x); m.z = bflo(a.y) + bflo(bb.y); m.w = bfhi(a.y) + bfhi(bb.y);
                const f32x4 x = {bflo(xx.x), bfhi(xx.x), bflo(xx.y), bfhi(xx.y)};
                v[j] = x + gg[j] * m; ss += (v[j].x * v[j].x + v[j].y * v[j].y) + (v[j].z * v[j].z + v[j].w * v[j].w); }
            const float rstd = 1.f / sqrtf(wave_sum(ss) * (1.f / DM) + EPS);
            if (FINAL) { float* orow = out + (size_t)((r / LT) * SEQ + (r % LT) - CTX) * DM;
#pragma unroll
                for (int j = 0; j < 4; ++j) *(f32x4*)(orow + 4 * F.lane + 256 * j) = v[j] * rstd * g4[j];
            } else { bf16_t* px = XS + (size_t)r * DM;
#pragma unroll
                for (int j = 0; j < 4; ++j) { const int c = 4 * F.lane + 256 * j; *(u32x2*)(px + c) = (u32x2){pk2(v[j].x, v[j].y), pk2(v[j].z, v[j].w)};
                    const f32x4 y = v[j] * rstd * gs[j] + sh[j];
                    *(u32x2*)(H + (size_t)r * DM + c) = (u32x2){pk2(y.x, y.y), pk2(y.z, y.w)}; }
            } } }
    }
#undef CB_ROW
#undef CB_CL
#undef CB_POS
#undef CB_LOAD
}

#ifndef PROBE_NOROUTE
#define PROBE_NOROUTE 0
#endif
DI void norm2_route_phase(Frame& F, int layer, bool lat_only, const bf16_t* XS, bf16_t* H, bool dry = false) {
    int tid_ = F.tid; asm volatile("" : "+v"(tid_));
    const int tid = tid_, w = __builtin_amdgcn_readfirstlane(tid_ >> 6), l = tid_ & 63, r16 = l & 15, kq = l >> 4;
    LAS float* ssp = (LAS float*)F.lds;
    LAS float* lgp = ssp + 128;
    LAS float* lgs = lgp + 8 * 16 * 48;
    LAS int* hist = (LAS int*)(lgs + 16 * 49);
    LAS int* rbase = hist + 32;
    LAS int* lk = hist + 64;
    LAS float* lw = (LAS float*)(lk + 320);
    if (tid < 32) hist[tid] = 0;
    const int kb = 128 * w + 4 * kq;
    bf16x8 wf[3][4];
    { const bf16_t* WR = (const bf16_t*)(F.ws + WS_WR) + (size_t)layer * 256 * 1024 + kb;
#pragma unroll
      for (int cb = 0; cb < 3; ++cb)
#pragma unroll
          for (int s2 = 0; s2 < 4; ++s2) { const bf16_t* p = WR + (size_t)(16 * cb + r16) * 1024 + 32 * s2; const u32x2 b0 = *(const u32x2*)p, b1 = *(const u32x2*)(p + 16);
              wf[cb][s2] = __builtin_bit_cast(bf16x8, (u32x4){b0.x, b0.y, b1.x, b1.y}); } }
    f32x4 gq[4][2];
    { const float* ng = F.in_(I_NORMG) + (layer * 2 + 1) * 1024 + kb;
#pragma unroll
      for (int s2 = 0; s2 < 4; ++s2) { gq[s2][0] = *(const f32x4*)(ng + 32 * s2); gq[s2][1] = *(const f32x4*)(ng + 32 * s2 + 16); } }
    const float* mv = (const float*)(F.ws + WS_MODV) + (size_t)layer * 17 * 6144 + 3072 + kb;
    const int ngroups = (lat_only ? NB * SEQ : T) / 16, G = gdim_(), per = (ngroups + G - 1) / G;
    const int g_lo = xcd_bid() * per, g_hi = (g_lo + per < ngroups) ? g_lo + per : ngroups;
    u32x2 xn[4][2], xm[4][2];
    int gi = g_lo;
    if (gi < g_hi) { const int r0 = lat_only ? lat_row(gi * 16) : gi * 16; const bf16_t* xr = XS + (size_t)(r0 + r16) * DM + kb;
#pragma unroll
        for (int s2 = 0; s2 < 4; ++s2) { xn[s2][0] = *(const u32x2*)(xr + 32 * s2); xn[s2][1] = *(const u32x2*)(xr + 32 * s2 + 16); } }
    if (gi + 1 < g_hi) { const int r0 = lat_only ? lat_row((gi + 1) * 16) : (gi + 1) * 16; const bf16_t* xr = XS + (size_t)(r0 + r16) * DM + kb;
#pragma unroll
        for (int s2 = 0; s2 < 4; ++s2) { xm[s2][0] = *(const u32x2*)(xr + 32 * s2); xm[s2][1] = *(const u32x2*)(xr + 32 * s2 + 16); } }
    f32x4 gsv[4][2], shv[4][2]; int cur_m = -1;
    __syncthreads();
#pragma unroll 1
    for (; gi < g_hi; ++gi) {
        const int r0 = lat_only ? lat_row(gi * 16) : gi * 16; const int b = r0 / LT; const bool isc = (r0 % LT) < CTX; const int mi = isc ? 16 : b;
        u32x2 xc[4][2];
#pragma unroll
        for (int s2 = 0; s2 < 4; ++s2) { xc[s2][0] = xn[s2][0]; xc[s2][1] = xn[s2][1]; xn[s2][0] = xm[s2][0]; xn[s2][1] = xm[s2][1]; }
        if (gi + 2 < g_hi) { const int r1 = lat_only ? lat_row((gi + 2) * 16) : (gi + 2) * 16; const bf16_t* xr = XS + (size_t)(r1 + r16) * DM + kb;
#pragma unroll
            for (int s2 = 0; s2 < 4; ++s2) { xm[s2][0] = *(const u32x2*)(xr + 32 * s2); xm[s2][1] = *(const u32x2*)(xr + 32 * s2 + 16); } }
        if (mi != cur_m) { cur_m = mi; const float* mrow = mv + mi * 6144;
#pragma unroll
            for (int s2 = 0; s2 < 4; ++s2)
#pragma unroll
                for (int q = 0; q < 2; ++q) { const f32x4 sc = *(const f32x4*)(mrow + 1024 + 32 * s2 + 16 * q); shv[s2][q] = *(const f32x4*)(mrow + 32 * s2 + 16 * q); gsv[s2][q] = gq[s2][q] * (sc + 1.f); } }
        f32x4 xv[4][2]; float ss = 0.f;
#pragma unroll
        for (int s2 = 0; s2 < 4; ++s2)
#pragma unroll
            for (int q = 0; q < 2; ++q) { const u32x2 v = xc[s2][q]; xv[s2][q] = (f32x4){bflo(v.x), bfhi(v.x), bflo(v.y), bfhi(v.y)};
                ss += (xv[s2][q].x * xv[s2][q].x + xv[s2][q].y * xv[s2][q].y) + (xv[s2][q].z * xv[s2][q].z + xv[s2][q].w * xv[s2][q].w); }
        ss += __shfl_xor(ss, 16); ss += __shfl_xor(ss, 32);
        if (kq == 0) ssp[w * 16 + r16] = ss;
        __syncthreads();
        float tot = 0.f;
#pragma unroll
        for (int q = 0; q < 8; ++q) tot += ssp[q * 16 + r16];
        const float rstd = 1.f / sqrtf(tot * (1.f / DM) + EPS);
        f32x4 acc[3];
#pragma unroll
        for (int cb = 0; cb < 3; ++cb) acc[cb] = (f32x4){0.f, 0.f, 0.f, 0.f};
        bf16_t* hrow = H + (size_t)(r0 + r16) * DM + kb;
#pragma unroll
        for (int s2 = 0; s2 < 4; ++s2) { const int c0 = 32 * s2;
            const f32x4 y0 = xv[s2][0] * rstd * gsv[s2][0] + shv[s2][0], y1 = xv[s2][1] * rstd * gsv[s2][1] + shv[s2][1];
            const u32x4 hv = pack8(y0, y1);
            *(u32x2*)(hrow + c0) = (u32x2){hv.x, hv.y}; *(u32x2*)(hrow + c0 + 16) = (u32x2){hv.z, hv.w};
            const bf16x8 af = __builtin_bit_cast(bf16x8, hv);
#pragma unroll
            for (int cb = 0; cb < 3; ++cb) acc[cb] = MFMA16(af, wf[cb][s2], acc[cb]); }
#pragma unroll
        for (int cb = 0; cb < 3; ++cb)
#pragma unroll
            for (int i = 0; i < 4; ++i) lgp[(w * 16 + 4 * kq + i) * 48 + 16 * cb + r16] = acc[cb][i];
        __syncthreads();
        { const int row = tid >> 5, col = tid & 31; float a0 = 0.f, a1 = 0.f;
#pragma unroll
          for (int q = 0; q < 8; ++q) { a0 += lgp[(q * 16 + row) * 48 + col]; if (col < 4) a1 += lgp[(q * 16 + row) * 48 + 32 + col]; }
          lgs[row * 49 + col] = a0; if (col < 4) lgs[row * 49 + 32 + col] = a1; }
        __syncthreads();
        if (tid < 16 && !(dry && PROBE_NOROUTE)) {
            const int r = r0 + tid; const LAS float* lg = lgs + tid * 49;
            int gidx = 0; float gm = lg[0];
#pragma unroll
            for (int q = 1; q < 4; ++q) if (lg[q] > gm) { gm = lg[q]; gidx = q; }
            const float gp = 1.f / (__expf(lg[0] - gm) + __expf(lg[1] - gm) + __expf(lg[2] - gm) + __expf(lg[3] - gm));
            const LAS float* ev = lg + 4 + 8 * gidx;
            int i1 = 0; float l1 = ev[0];
#pragma unroll
            for (int q = 1; q < 8; ++q) if (ev[q] > l1) { l1 = ev[q]; i1 = q; }
            int i2 = -1; float l2 = -3.0e38f;
#pragma unroll
            for (int q = 0; q < 8; ++q) if (q != i1 && ev[q] > l2) { l2 = ev[q]; i2 = q; }
            const float w1 = 1.f / (1.f + __expf(l2 - l1)), w2 = 1.f - w1;
            int* te = (int*)(F.ws + WS_TOKE) + (size_t)r * 2; float* tw = (float*)(F.ws + WS_TOKW) + (size_t)r * 2;
            if (!dry) { te[0] = 8 * gidx + i1; te[1] = 8 * gidx + i2; tw[0] = gp * w1; tw[1] = gp * w2;
                const int ka = lds_add(&hist[8 * gidx + i1], 1), kb_ = lds_add(&hist[8 * gidx + i2], 1); const int tl = (gi - g_lo) * 16 + tid;
                lk[2 * tl] = (8 * gidx + i1) | (ka << 8); lk[2 * tl + 1] = (8 * gidx + i2) | (kb_ << 8); lw[2 * tl] = gp * w1; lw[2 * tl + 1] = gp * w2; }
        }
    }
    __syncthreads();
    if (!dry && tid < 32) rbase[tid] = hist[tid] ? (int)atomicAdd(F.ctl + CW_CNT + layer * 256 + tid, (unsigned)hist[tid]) : 0;
    __syncthreads();
    if (!dry && g_lo < g_hi) { const int ntl = (g_hi - g_lo) * 16;
        if (tid < 2 * ntl) { const int tl = tid >> 1, k = tid & 1; const int gi_ = g_lo + (tl >> 4); const int r = (lat_only ? lat_row(gi_ * 16) : gi_ * 16) + (tl & 15);
            const int v = lk[tid]; const int e = v & 255, rank = rbase[e] + (v >> 8);
            ((int*)(F.ws + WS_RANKTOK))[(size_t)e * T + rank] = 2 * r + k; ((float*)(F.ws + WS_RANKW))[(size_t)e * T + rank] = lw[tid];
            ((int*)(F.ws + WS_TOKPOS))[(size_t)r * 2 + k] = (e << 16) | rank; } }
    __syncthreads();
}

DI void route_phase(Frame& F, int layer, bool lat_only) {
    LAS int* hist = (LAS int*)F.lds;
    if (F.tid < 32) hist[F.tid] = 0;
    __syncthreads();
    const int gt = bid_() * NTHR + F.tid; const int ntok = lat_only ? NB * SEQ : T;
    if (gt < ntok) {
        const int r = lat_only ? lat_row(gt) : gt; const float* lg = (const float*)(F.ws + WS_LOGIT) + (size_t)r * 64;
        const f32x4 gl = *(const f32x4*)lg; int gi = 0; float gm = gl.x;
        if (gl.y > gm) { gm = gl.y; gi = 1; } if (gl.z > gm) { gm = gl.z; gi = 2; } if (gl.w > gm) { gm = gl.w; gi = 3; }
        const float gp = 1.f / (__expf(gl.x - gm) + __expf(gl.y - gm) + __expf(gl.z - gm) + __expf(gl.w - gm));
        const f32x4 e0 = *(const f32x4*)(lg + 4 + 8 * gi), e1 = *(const f32x4*)(lg + 8 + 8 * gi);
        const float ev[8] = {e0.x, e0.y, e0.z, e0.w, e1.x, e1.y, e1.z, e1.w};
        int i1 = 0; float l1 = ev[0];
#pragma unroll
        for (int i = 1; i < 8; ++i) if (ev[i] > l1) { l1 = ev[i]; i1 = i; }
        int i2 = -1; float l2 = -3.0e38f;
#pragma unroll
        for (int i = 0; i < 8; ++i) if (i != i1 && ev[i] > l2) { l2 = ev[i]; i2 = i; }
        const float w1 = 1.f / (1.f + __expf(l2 - l1)), w2 = 1.f - w1;
        int* te = (int*)(F.ws + WS_TOKE) + (size_t)r * 2; float* tw = (float*)(F.ws + WS_TOKW) + (size_t)r * 2;
        te[0] = 8 * gi + i1; te[1] = 8 * gi + i2; tw[0] = gp * w1; tw[1] = gp * w2;
        lds_add(&hist[8 * gi + i1], 1); lds_add(&hist[8 * gi + i2], 1);
    }
    __syncthreads();
    if (F.tid < 32 && hist[F.tid]) atomicAdd(F.ctl + CW_CNT + layer * 256 + F.tid, (unsigned)hist[F.tid]);
    __syncthreads();
}
DI void assign_phase(Frame& F, int layer, bool lat_only) {
    LAS int* hist = (LAS int*)F.lds; LAS int* offs = hist + 32; LAS int* base = hist + 64; LAS int* cnts = hist + 96;
    unsigned* cnt = F.ctl + CW_CNT + layer * 256; unsigned* cur = cnt + 128;
    if (F.tid < 32) { hist[F.tid] = 0; cnts[F.tid] = (int)__hip_atomic_load(cnt + F.tid, __ATOMIC_RELAXED, __HIP_MEMORY_SCOPE_AGENT); }
    __syncthreads();
    if (F.tid == 0) { int o = 0; for (int e = 0; e < 32; ++e) { offs[e] = o; o += (cnts[e] + 255) & ~255; } }
    const int gt = bid_() * NTHR + F.tid; const int ntok = lat_only ? NB * SEQ : T;
    int r = -1, e0 = 0, e1 = 0, k0 = 0, k1 = 0; float w0 = 0.f, w1 = 0.f;
    if (gt < ntok) { r = lat_only ? lat_row(gt) : gt; const int* te = (const int*)(F.ws + WS_TOKE) + (size_t)r * 2; const float* tw = (const float*)(F.ws + WS_TOKW) + (size_t)r * 2;
        e0 = te[0]; e1 = te[1]; w0 = tw[0]; w1 = tw[1]; k0 = lds_add(&hist[e0], 1); k1 = lds_add(&hist[e1], 1); }
    __syncthreads();
    if (F.tid < 32) base[F.tid] = hist[F.tid] ? (int)atomicAdd(cur + F.tid, (unsigned)hist[F.tid]) : 0;
    __syncthreads();
    int* rt = (int*)(F.ws + WS_ROWTOK); int* rd = (int*)(F.ws + WS_ROWDST); float* rw = (float*)(F.ws + WS_ROWW);
    if (r >= 0) { const int p0 = offs[e0] + base[e0] + k0, p1 = offs[e1] + base[e1] + k1;
        rt[p0] = r; rd[p0] = 2 * r; rw[p0] = w0; rt[p1] = r; rd[p1] = 2 * r + 1; rw[p1] = w1;
        int* tp = (int*)(F.ws + WS_TOKPOS) + (size_t)r * 2; tp[0] = p0; tp[1] = p1; }
    if (bid_() >= 128 && bid_() < 160) { const int e = bid_() - 128; const int lo = offs[e] + cnts[e], hi = offs[e] + ((cnts[e] + 255) & ~255);
        for (int p = lo + F.tid; p < hi; p += NTHR) { rt[p] = 0; rd[p] = -1; rw[p] = 0.f; } }
    __syncthreads();
}
DI const LAS int* moe_tile_table(Frame& F, int layer) {
    LAS int* tab = (LAS int*)(F.lds + LDS_TAB_OFF);
    __syncthreads();
    if (F.tid < 64) {
        const unsigned* cnt = F.ctl + CW_CNT + layer * 256; const int e = F.tid & 31;
        const int c = (int)__hip_atomic_load(cnt + e, __ATOMIC_RELAXED, __HIP_MEMORY_SCOPE_AGENT); const int nt = (c + 255) >> 8;
        int inc = nt;
#pragma unroll
        for (int o = 1; o < 32; o <<= 1) { const int v = __shfl_up(inc, o, 64); if ((F.tid & 31) >= o) inc += v; }
        if (F.tid < 32) { const int start = inc - nt; for (int i = 0; i < nt; ++i) tab[1 + start + i] = e | (i << 8); if (e == 31) tab[0] = inc; tab[400 + e] = c; tab[432 + e] = start; }
    }
    __syncthreads();
    return tab;
}

DI void l1_norm_phase(Frame& F) {
    bf16_t* CQ = (bf16_t*)(F.ws + WS_CQ); bf16_t* CKV = (bf16_t*)(F.ws + WS_CKV); bf16_t* KR = (bf16_t*)(F.ws + WS_KR);
    const f32x4 gq = *(const f32x4*)(F.in_(I_QNG) + 4 * F.lane); const f32x2 gk = *(const f32x2*)(F.in_(I_KVNG) + 2 * F.lane);
    const f32x2* rope = (const f32x2*)(F.ws + WS_ROPE1);
    const int g = (F.lane >> 3) & 1, i = F.lane & 7;
    for (int r0 = F.gw * 4; r0 < T; r0 += F.NGW * 4) {
        u32x2 a[4]; unsigned c[4]; unsigned short k0[4], k1[4];
#pragma unroll
        for (int u = 0; u < 4; ++u) { const int r = r0 + u; a[u] = *((const u32x2*)(CQ + (size_t)r * 256) + F.lane); c[u] = *((const unsigned*)(CKV + (size_t)r * 128) + F.lane);
            const bf16_t* kp = KR + (size_t)r * 32 + 16 * g + i; k0[u] = kp[0]; k1[u] = kp[8]; }
#pragma unroll
        for (int u = 0; u < 4; ++u) { const int r = r0 + u; const int pos = r % LT;
            { const float x0 = bflo(a[u].x), x1 = bfhi(a[u].x), x2 = bflo(a[u].y), x3 = bfhi(a[u].y);
              const float rstd = 1.f / sqrtf(wave_sum(x0 * x0 + x1 * x1 + x2 * x2 + x3 * x3) * (1.f / 256.f) + EPS);
              *((u32x2*)(CQ + (size_t)r * 256) + F.lane) = (u32x2){pk2(x0 * rstd * gq.x, x1 * rstd * gq.y), pk2(x2 * rstd * gq.z, x3 * rstd * gq.w)}; }
            { const float x0 = bflo(c[u]), x1 = bfhi(c[u]);
              const float rstd = 1.f / sqrtf(wave_sum(x0 * x0 + x1 * x1) * (1.f / 128.f) + EPS);
              *((unsigned*)(CKV + (size_t)r * 128) + F.lane) = pk2(x0 * rstd * gk.x, x1 * rstd * gk.y); }
            if (pos >= CTX && F.lane < 16) { bf16_t* kp = KR + (size_t)r * 32 + 16 * g + i;
                const float t1 = bf2f(k0[u]), t2 = bf2f(k1[u]); const f32x2 cs = rope[(size_t)(pos - CTX) * 16 + g * 8 + i];
                kp[0] = (bf16_t)f2bf(t1 * cs.x - t2 * cs.y); kp[8] = (bf16_t)f2bf(t1 * cs.y + t2 * cs.x); } }
    }
}

DI void s5_scan_phase(Frame& F) {
    const int gt = bid_() * NTHR + F.tid; if (gt >= 65536) return;
    const int p = gt & 63, d = (gt >> 6) & 1, b = (gt >> 7) & 15, g = gt >> 11;
    const f32x4 pr = ((const f32x4*)(F.ws + WS_S5PAR))[(d * 32 + g) * 64 + p];
    const float mg = __expf(32.f * pr.x); float sn, cs; sincosf(32.f * pr.y, &sn, &cs); const float lr = mg * cs, li = mg * sn;
    const float* S = (const float*)(F.ws + WS_S5S) + (size_t)g * 1280 * 256 + d * 128 + p; bf16_t* BM = (bf16_t*)(F.ws + WS_BMAT) + (size_t)g * 1280 * 768 + 512 + d * 128 + p;
    float xr = 0.f, xi = 0.f;
#pragma unroll 1
    for (int s0 = 0; s0 < 72; s0 += 24) {
        float sr[24], si[24];
#pragma unroll
        for (int q = 0; q < 24; ++q) { const int s = s0 + q; const int c = d == 0 ? s : (s < 8 ? 7 - s : 79 - s); const float* sp = S + (size_t)(c * 16 + b) * 256; sr[q] = sp[0]; si[q] = sp[64]; }
#pragma unroll
        for (int q = 0; q < 24; ++q) { const int s = s0 + q; const int c = d == 0 ? s : (s < 8 ? 7 - s : 79 - s); bf16_t* bp = BM + (size_t)(c * 16 + b) * 768;
            bp[0] = (bf16_t)f2bf(xr); bp[64] = (bf16_t)f2bf(xi);
            const float nr = lr * xr - li * xi + sr[q], ni = lr * xi + li * xr + si[q]; xr = nr; xi = ni; }
    }
}

template <bool CM, int PM = 0>
DI void hyena_unit(Frame& F, int c0) {
    constexpr int n = CM ? 256 : 2048, UP = n + 8, NCH = n / 8, GC = 2 * n + 8;
    int tid_ = F.tid; asm volatile("" : "+v"(tid_));
    const int w = __builtin_amdgcn_readfirstlane(tid_ >> 6), l = tid_ & 63, c = CM ? c0 + w : c0, seg0 = CM ? 0 : CTX, tw = CM ? 0 : 256 * w;
    LAS bf16_t* U = (LAS bf16_t*)F.lds + (CM ? w * (16 * UP) : 0);
    LAS bf16_t* G = (LAS bf16_t*)(F.lds + (CM ? 8 * 16 * UP * 2 : 16 * UP * 2)) + (CM ? w * (8 * GC) : 0);
    const bf16_t* HyT = (const bf16_t*)(F.ws + WS_HYT); bf16_t* HoT = (bf16_t*)(F.ws + WS_HOT);
    const float* cw = F.in_(I_HCW); const float* cb = F.in_(I_HCB);
    const float* grbase = (const float*)(F.ws + (CM ? WS_GRAWC : WS_GRAW)) + (size_t)c * (2 * n);
    const int j0 = (CM ? l : tid_) * 8;
    f32x4 gq[4];
#define HY_LOAD_FILTER(o_) do { const float* gr_ = grbase + (size_t)(o_) * 512 * (2 * n); \
        _Pragma("unroll") for (int q = 0; q < 4; ++q) { const int jj = (j0 + 4 * q) < 2 * n ? j0 + 4 * q : 0; gq[q] = *(const f32x4*)(gr_ + jj); } } while (0)
    HY_LOAD_FILTER(0);
    { const int ch = 1024 + c; const float w0 = cw[ch], w1 = cw[1536 + ch], w2 = cw[3072 + ch], bs = cb[ch];
      u32x4 raw[8]; unsigned short pvr[8], nvr[8];
#pragma unroll
      for (int i = 0; i < 8; ++i) { const int q = CM ? l + 64 * i : tid_ + 512 * i; const int b = q / NCH, s0 = (q % NCH) * 8;
          const bf16_t* src = HyT + (size_t)ch * T + b * LT + seg0;
          raw[i] = *(const u32x4*)(src + s0); pvr[i] = src[s0 > 0 ? s0 - 1 : 0]; nvr[i] = src[s0 + 8 < n ? s0 + 8 : n - 1]; }
#pragma unroll
      for (int i = 0; i < 8; ++i) { const int q = CM ? l + 64 * i : tid_ + 512 * i; const int b = q / NCH, s0 = (q % NCH) * 8;
          const float pv = s0 > 0 ? bf2f(pvr[i]) : 0.f, nv = s0 + 8 < n ? bf2f(nvr[i]) : 0.f;
          const float v[10] = {pv, bflo(raw[i].x), bfhi(raw[i].x), bflo(raw[i].y), bfhi(raw[i].y), bflo(raw[i].z), bfhi(raw[i].z), bflo(raw[i].w), bfhi(raw[i].w), nv};
          float o[8];
#pragma unroll
          for (int e = 0; e < 8; ++e) o[e] = w0 * v[e] + w1 * v[e + 1] + w2 * v[e + 2] + bs;
          *(LAS u32x4*)(U + b * UP + s0) = (u32x4){pk2(o[0], o[1]), pk2(o[2], o[3]), pk2(o[4], o[5]), pk2(o[6], o[7])}; } }
#pragma unroll 1
    for (int o = 0; o < 2; ++o) {
        int ll = l; asm volatile("" : "+v"(ll));
        const int lb = n + 8 * (ll >> 4) - (ll & 15);
        const int rr = lb & 7, gl = rr * GC + lb - rr;
        const int j0l = CM ? ll * 8 : (w * 64 + ll) * 8;
        if (o == 1) { const float* gr_ = grbase + (size_t)512 * (2 * n);
#pragma unroll
            for (int q = 0; q < 4; ++q) { const int jj = (j0l + 4 * q) < 2 * n ? j0l + 4 * q : 0; gq[q] = *(const f32x4*)(gr_ + jj); } }
        { float nfs = 0.f;
          { const float* part = (const float*)(F.ws + (CM ? WS_HYPARTC : WS_HYPART)) + o * 512 + c;
            nfs = part[(size_t)(ll >> 1) * 2048 + (ll & 1) * 1024]; }
          const float nf = 1.f / sqrtf(wave_sum(nfs) + EPS); float gv[16];
#pragma unroll
          for (int q = 0; q < 4; ++q) { const bool ok = (j0l + 4 * q) < 2 * n; const f32x4 a = ok ? gq[q] : (f32x4){0.f, 0.f, 0.f, 0.f};
              gv[4 * q] = a.x * nf; gv[4 * q + 1] = a.y * nf; gv[4 * q + 2] = a.z * nf; gv[4 * q + 3] = a.w * nf; }
          unsigned pe[8], po[7];
#pragma unroll
          for (int i = 0; i < 8; ++i) pe[i] = pk2(gv[2 * i], gv[2 * i + 1]);
#pragma unroll
          for (int i = 0; i < 7; ++i) po[i] = pk2(gv[2 * i + 1], gv[2 * i + 2]);
#pragma unroll
          for (int r = 0; r < 8; ++r) { const int h2 = r >> 1; const u32x4 val = (r & 1) ? (u32x4){po[h2], po[h2 + 1], po[h2 + 2], po[h2 + 3]} : (u32x4){pe[h2], pe[h2 + 1], pe[h2 + 2], pe[h2 + 3]};
              *(LAS u32x4*)(G + r * GC + j0l) = val; } }
        const int xch = o == 0 ? c : 512 + c;
        const int lq = ll >> 4;
        const int b = ll & 15;
        const bf16_t* xs = HyT + (size_t)xch * T + b * LT + seg0;
        u32x2 xraw[16];
#pragma unroll
        for (int I = 0; I < 16; ++I) xraw[I] = *(const u32x2*)(xs + tw + 16 * I + 4 * lq);
        const unsigned short xe_prev = xs[tw > 0 ? tw - 1 : 0], xe_next = xs[tw + 256 < n ? tw + 256 : n - 1];
        __syncthreads();
        f32x4 acc[16];
#pragma unroll
        for (int I = 0; I < 16; ++I) acc[I] = (f32x4){0.f, 0.f, 0.f, 0.f};
        bf16x8 Fw[16];
        const LAS bf16_t* gb = G + gl - tw;
#pragma unroll
        for (int I = 0; I < 16; ++I) Fw[I] = *(const LAS bf16x8*)(gb - 16 * I);
        const LAS bf16_t* ub = U + (ll & 15) * UP + 8 * (ll >> 4);
        bf16x8 bfr = *(const LAS bf16x8*)ub;
#pragma unroll 1
        for (int K0 = 0; K0 < (PM == 2 ? 256 : n); K0 += 256) {
#pragma unroll
            for (int s = 0; s < 8; ++s) {
                const int k0 = K0 + 32 * s;
                const int kk = (k0 + 32 < n) ? k0 + 32 : k0;
                const bf16x8 bnx = *(const LAS bf16x8*)(ub + kk);
                const bf16x8 n0 = *(const LAS bf16x8*)(gb + kk), n1 = *(const LAS bf16x8*)(gb + kk - 16);
#pragma unroll
                for (int I = 0; I < 16; ++I) acc[I] = MFMA16(Fw[(I - 2 * s) & 15], bfr, acc[I]);
                Fw[(14 - 2 * s) & 15] = n0; Fw[(15 - 2 * s) & 15] = n1; bfr = bnx;
                __builtin_amdgcn_sched_barrier(0);
            }
        }
        __syncthreads();
        const float fb = F.in_(I_HFB)[o * 512 + c];
        const float w0 = cw[xch], w1 = cw[1536 + xch], w2 = cw[3072 + xch], bs = cb[xch];
        unsigned spm1 = (unsigned)xe_prev, sn_cur = (unsigned)__shfl((int)(xraw[0].x & 0xffffu), (ll + 16) & 63);
#pragma unroll
        for (int I = 0; I < 16; ++I) { const int t = tw + 16 * I + 4 * lq;
            const u32x2 raw = xraw[I];
            const unsigned sp_cur = (unsigned)__shfl((int)(raw.y >> 16), (ll - 16) & 63);
            const unsigned sn_next = I < 15 ? (unsigned)__shfl((int)(xraw[I < 15 ? I + 1 : 15].x & 0xffffu), (ll + 16) & 63) : (unsigned)xe_next;
            const unsigned pvb = lq > 0 ? sp_cur : spm1, nvb = lq < 3 ? sn_cur : sn_next;
            spm1 = sp_cur; sn_cur = sn_next;
            const float pv = t > 0 ? bf2f((unsigned short)pvb) : 0.f, nv = t + 4 < n ? bf2f((unsigned short)nvb) : 0.f;
            const float v[6] = {pv, bflo(raw.x), bfhi(raw.x), bflo(raw.y), bfhi(raw.y), nv};
            const u32x2 uu = *(const LAS u32x2*)(U + b * UP + t); const float uf[4] = {bflo(uu.x), bfhi(uu.x), bflo(uu.y), bfhi(uu.y)};
            float r[4];
#pragma unroll
            for (int e = 0; e < 4; ++e) { const float xc = w0 * v[e] + w1 * v[e + 1] + w2 * v[e + 2] + bs; r[e] = xc * (acc[I][e] + uf[e] * fb); }
            if (o == 0) *(LAS u32x2*)(U + b * UP + t) = (u32x2){pk2(r[0], r[1]), pk2(r[2], r[3])};
            else if (PM != 1) *(u32x2*)(HoT + (size_t)c * T + b * LT + seg0 + t) = (u32x2){pk2(r[0], r[1]), pk2(r[2], r[3])};
            if ((I & 3) == 3) __builtin_amdgcn_sched_barrier(0); }
        __syncthreads();
    }
#undef HY_LOAD_FILTER
}

DI void hot_transpose_phase(Frame& F) {
    const bf16_t* HoT = (const bf16_t*)(F.ws + WS_HOT); bf16_t* MIX = (bf16_t*)F.out;
    LAS unsigned* scr = (LAS unsigned*)(F.lds + F.wave * 16384);
    const int l = F.lane, lr = l >> 3, lc = l & 7;
    constexpr int NIT = 8 * (T / 64), NITX = NIT / 8; const int xq_ = bid_() & 7, wl_ = (bid_() >> 3) * NWAVES + F.wave, NWX = (gdim_() >> 3) * NWAVES;
    u32x4 vn[8];
    if (wl_ < NITX) { const int it_ = NITX * xq_ + wl_; const int c0 = (it_ & 7) * 64, t0 = (it_ >> 3) * 64;
#pragma unroll
        for (int i = 0; i < 8; ++i) vn[i] = *(const u32x4*)(HoT + (size_t)(c0 + 8 * i + lr) * T + t0 + 8 * lc); }
    for (int li = wl_; li < NITX; li += NWX) { const int it = NITX * xq_ + li;
        const int c0 = (it & 7) * 64, t0 = (it >> 3) * 64;
        u32x4 v[8];
#pragma unroll
        for (int i = 0; i < 8; ++i) v[i] = vn[i];
        if (li + NWX < NITX) { const int itn = it + NWX; const int c1 = (itn & 7) * 64, t1 = (itn >> 3) * 64;
#pragma unroll
            for (int i = 0; i < 8; ++i) vn[i] = *(const u32x4*)(HoT + (size_t)(c1 + 8 * i + lr) * T + t1 + 8 * lc); }
#pragma unroll
        for (int i = 0; i < 8; ++i) { LAS unsigned* p = scr + (8 * i + lr) * 33 + 4 * lc; p[0] = v[i].x; p[1] = v[i].y; p[2] = v[i].z; p[3] = v[i].w; }
        LDS_WAIT(); asm volatile("" ::: "memory");
#pragma unroll
        for (int i = 0; i < 8; ++i) { const int tt = 8 * i + lr; const LAS unsigned short* q = (const LAS unsigned short*)scr + tt + (8 * lc) * 66;
            unsigned e[8];
#pragma unroll
            for (int k = 0; k < 8; ++k) e[k] = q[k * 66];
            *(u32x4*)(MIX + (size_t)(t0 + tt) * DM + c0 + 8 * lc) = (u32x4){e[0] | (e[1] << 16), e[2] | (e[3] << 16), e[4] | (e[5] << 16), e[6] | (e[7] << 16)}; }
        LDS_WAIT(); asm volatile("" ::: "memory");
    }
}

DI float max3f(float a, float b, float c) { float r; asm("v_max3_f32 %0, %1, %2, %3" : "=v"(r) : "v"(a), "v"(b), "v"(c)); return r; }
typedef short s16x4 __attribute__((ext_vector_type(4)));
DI bf16x8 vtr8(const LAS bf16_t* p0, const LAS bf16_t* p1) {
    const s16x4 a = __builtin_bit_cast(s16x4, __builtin_amdgcn_ds_read_tr16_b64_v4i16((LAS s16x4*)p0)), b = __builtin_bit_cast(s16x4, __builtin_amdgcn_ds_read_tr16_b64_v4i16((LAS s16x4*)p1));
    return (bf16x8){a[0], a[1], a[2], a[3], b[0], b[1], b[2], b[3]};
}
template <int DK, bool MLA, int APM = 0>
DI void attn_unit(Frame& F, const bf16_t* Q, int ldq, int qcol, const bf16_t* Kp, int ldk, int kcol, const bf16_t* KRp, const bf16_t* Vp, int ldv, int vcol,
                  bf16_t* O, int ocol, int qrow0, int krow0, int nkeys) {
    constexpr int KP = DK + 8, VP = 96, KS = DK / 16;
    int tid_ = F.tid; asm volatile("" : "+v"(tid_));
    const int tid = tid_, w = __builtin_amdgcn_readfirstlane(tid_ >> 6), l = tid_ & 63, n = l & 31, h = l >> 5;
    LAS bf16_t* Kb = (LAS bf16_t*)F.lds;
    LAS bf16_t* Vt = Kb + 2 * 64 * KP;
    bf16x8 qf[KS];
    { const bf16_t* qp = Q + (size_t)(qrow0 + 32 * w + n) * ldq + qcol + 8 * h;
#pragma unroll
      for (int ks = 0; ks < KS; ++ks) qf[ks] = *(const bf16x8*)(qp + 16 * ks); }
    const int kkey = tid >> 3, kch = tid & 7, rkey = tid >> 2, rch = tid & 3;
    const bf16_t* kg = Kp + (size_t)(krow0 + kkey) * ldk + kcol + 8 * kch;
    const bf16_t* rg = MLA ? KRp + (size_t)(krow0 + (rkey & 63)) * 32 + 8 * rch : nullptr;
    const bf16_t* vg = Vp + (size_t)(krow0 + kkey) * ldv + vcol + 8 * kch;
    const int pim = 16 * (n >> 4) + 8 * ((n >> 2) & 1) + 4 * ((n >> 3) & 1) + (n & 3);
    const int nt = nkeys >> 6;
    const int vtr_off = (8 * h + ((l >> 2) & 3)) * VP + 16 * ((l >> 4) & 1) + 4 * (l & 3);
    u32x4 kA, rA = (u32x4){0, 0, 0, 0}, vA, kB, rB = (u32x4){0, 0, 0, 0}, vB;
#define ATT_LOAD(KR_, RR_, VR_, tile) do { const size_t ko_ = (size_t)(tile) * 64; KR_ = *(const u32x4*)(kg + ko_ * ldk); if (MLA && tid < 256) RR_ = *(const u32x4*)(rg + ko_ * 32); VR_ = *(const u32x4*)(vg + ko_ * ldv); } while (0)
#define ATT_STAGE(buf, KR_, RR_, VR_) do { \
        *(LAS u32x4*)(Kb + (buf) * 64 * KP + kkey * KP + 8 * kch) = KR_; \
        if (MLA && tid < 256) *(LAS u32x4*)(Kb + (buf) * 64 * KP + rkey * KP + 64 + 8 * rch) = RR_; \
        *(LAS u32x4*)(Vt + (buf) * 64 * VP + kkey * VP + 8 * kch) = VR_; } while (0)
    ATT_LOAD(kA, rA, vA, 0);
    if (nt > 1) ATT_LOAD(kB, rB, vB, 1);
    __syncthreads();
    ATT_STAGE(0, kA, rA, vA);
    __syncthreads();
    if (w >= 4) __builtin_amdgcn_s_setprio(1);
    f32x16 O0, O1, negm;
#pragma unroll
    for (int i = 0; i < 16; ++i) { O0[i] = 0.f; O1[i] = 0.f; negm[i] = 0.f; }
    float lrun = 0.f;
#define ATT_TILE(buf) do { \
        f32x16 S0, S1; \
        const LAS bf16_t* kb0 = Kb + (buf) * 64 * KP + pim * KP + 8 * h; \
        bf16x8 ka[KS], kc[KS];                   \
        _Pragma("unroll") for (int ks = 0; ks < KS; ++ks) { ka[ks] = *(const LAS bf16x8*)(kb0 + 16 * ks); kc[ks] = *(const LAS bf16x8*)(kb0 + 32 * KP + 16 * ks); } \
        const LAS bf16_t* vb = Vt + (buf) * 64 * VP + vtr_off; \
        bf16x8 va[2][2], vc[2][2];               \
        _Pragma("unroll") for (int kb = 0; kb < 2; ++kb) \
            _Pragma("unroll") for (int s = 0; s < 2; ++s) { const LAS bf16_t* vq = vb + (32 * kb + 16 * s) * VP; va[kb][s] = vtr8(vq, vq + 4 * VP); vc[kb][s] = vtr8(vq + 32, vq + 4 * VP + 32); } \
        __builtin_amdgcn_sched_barrier(0); \
        if (APM != 2) { S0 = MFMA32(ka[0], qf[0], negm); S1 = MFMA32(kc[0], qf[0], negm); \
        _Pragma("unroll") for (int ks = 1; ks < KS; ++ks) { S0 = MFMA32(ka[ks], qf[ks], S0); S1 = MFMA32(kc[ks], qf[ks], S1); } } \
        else { _Pragma("unroll") for (int i = 0; i < 16; ++i) { S0[i] = __builtin_bit_cast(float, (unsigned)ka[i % KS][0] & 0x3f800000u); S1[i] = __builtin_bit_cast(float, (unsigned)kc[i % KS][1] & 0x3f800000u); } } \
        asm volatile("s_nop 15\n\ts_nop 15" : "+v"(S0), "+v"(S1));       \
        if (APM != 1) { \
        float mx = max3f(S0[0], S1[0], S0[1]), mx2 = max3f(S1[1], S0[2], S1[2]); \
        _Pragma("unroll") for (int i = 3; i < 15; i += 2) { mx = max3f(mx, S0[i], S1[i]); mx2 = max3f(mx2, S0[i + 1], S1[i + 1]); } \
        mx = max3f(mx, S0[15], S1[15]); mx = max3f(mx, mx2, __shfl_xor(max3f(mx, mx2, mx2), 32)); \
        if (__any(mx > 8.f || mx < -24.f)) { \
            const float sc = __builtin_amdgcn_exp2f(-mx); \
            _Pragma("unroll") for (int i = 0; i < 16; ++i) { S0[i] -= mx; S1[i] -= mx; O0[i] *= sc; O1[i] *= sc; negm[i] -= mx; } \
            lrun *= sc; \
        } \
        float rs = 0.f; \
        _Pragma("unroll") for (int i = 0; i < 16; ++i) { S0[i] = __builtin_amdgcn_exp2f(S0[i]); S1[i] = __builtin_amdgcn_exp2f(S1[i]); rs += S0[i] + S1[i]; } \
        lrun += rs; } \
        bf16x8 pf[2][2]; \
        _Pragma("unroll") for (int s = 0; s < 2; ++s) { \
            pf[0][s] = __builtin_bit_cast(bf16x8, (u32x4){pk2(S0[8 * s], S0[8 * s + 1]), pk2(S0[8 * s + 2], S0[8 * s + 3]), pk2(S0[8 * s + 4], S0[8 * s + 5]), pk2(S0[8 * s + 6], S0[8 * s + 7])}); \
            pf[1][s] = __builtin_bit_cast(bf16x8, (u32x4){pk2(S1[8 * s], S1[8 * s + 1]), pk2(S1[8 * s + 2], S1[8 * s + 3]), pk2(S1[8 * s + 4], S1[8 * s + 5]), pk2(S1[8 * s + 6], S1[8 * s + 7])}); } \
        _Pragma("unroll") for (int kb = 0; kb < 2; ++kb) \
            _Pragma("unroll") for (int s = 0; s < 2; ++s) { if (APM != 2) { O0 = MFMA32(va[kb][s], pf[kb][s], O0); O1 = MFMA32(vc[kb][s], pf[kb][s], O1); } else { O0[kb * 2 + s] += __builtin_bit_cast(float, (unsigned)(va[kb][s][0] ^ pf[kb][s][1]) & 0x3f800000u); O1[kb * 2 + s] += __builtin_bit_cast(float, (unsigned)(vc[kb][s][0] ^ pf[kb][s][2]) & 0x3f800000u); } } \
    } while (0)
#pragma unroll 1
    for (int t = 0; t < nt; t += 2) {
        if (t + 2 < nt) ATT_LOAD(kA, rA, vA, t + 2);
        ATT_TILE(0);
        ATT_STAGE(1, kB, rB, vB);
        __syncthreads();
        if (t + 3 < nt) ATT_LOAD(kB, rB, vB, t + 3);
        ATT_TILE(1);
        if (t + 2 < nt) ATT_STAGE(0, kA, rA, vA);
        __syncthreads();
    }
#undef ATT_LOAD
#undef ATT_STAGE
#undef ATT_TILE
    __builtin_amdgcn_s_setprio(0);
    const float inv = 1.f / (lrun + __shfl_xor(lrun, 32));
    if (APM != 0 && inv != 12345.678f) return;
    bf16_t* op = O + (size_t)(qrow0 + 32 * w + n) * DM + ocol + 4 * h;
#pragma unroll
    for (int jj = 0; jj < 4; ++jj) {
        *(u32x2*)(op + 8 * jj) = (u32x2){pk2(O0[4 * jj] * inv, O0[4 * jj + 1] * inv), pk2(O0[4 * jj + 2] * inv, O0[4 * jj + 3] * inv)};
        *(u32x2*)(op + 32 + 8 * jj) = (u32x2){pk2(O1[4 * jj] * inv, O1[4 * jj + 1] * inv), pk2(O1[4 * jj + 2] * inv, O1[4 * jj + 3] * inv)}; }
}

template <int K, int NCH, int SKP = 0, class Epi>
DI void skinny_unit(Frame& F, int tid_in, const bf16_t* Arow0, int lda, const bf16_t* Bg, const Epi& epi) {
    int tid = tid_in; asm volatile("" : "+v"(tid));
    constexpr int KPD = K + 8, CH = 64, BSZ = CH * KPD, NS = K / 32, NPC = (CH * K / 8) / NTHR;
    const int w = __builtin_amdgcn_readfirstlane(tid >> 6), l = tid & 63, r16 = l & 15, fq = l >> 4;
    LAS bf16_t* Bs = (LAS bf16_t*)F.lds;
    int s_goff[NPC], s_loff[NPC];
#pragma unroll
    for (int j = 0; j < NPC; ++j) { const int e = tid + NTHR * j, cc = e / (K / 8), kc = e % (K / 8); const int rho = 16 * (2 * (cc >> 5) + ((cc >> 2) & 1)) + 4 * ((cc >> 3) & 3) + (cc & 3);
        s_goff[j] = cc * K + 8 * kc; s_loff[j] = rho * KPD + 8 * kc; }
    bf16x8 af[2][NS];
#pragma unroll
    for (int rb = 0; rb < 2; ++rb) { const bf16_t* ap = Arow0 + (size_t)(32 * w + 16 * rb + r16) * lda + 8 * fq;
#pragma unroll
        for (int s2 = 0; s2 < NS; ++s2) af[rb][s2] = *(const bf16x8*)(ap + 32 * s2); }
    u32x4 st[2][NPC];
#define SK_LOAD(set, chunk) do { _Pragma("unroll") for (int j = 0; j < NPC; ++j) st[set][j] = *(const u32x4*)(Bg + (size_t)(chunk) * CH * K + s_goff[j]); } while (0)
#define SK_STAGE(set, buf_) do { _Pragma("unroll") for (int j = 0; j < NPC; ++j) *(LAS u32x4*)(Bs + (buf_) * BSZ + s_loff[j]) = st[set][j]; } while (0)
    SK_LOAD(0, 0); SK_LOAD(1, 1);
    __syncthreads();
    SK_STAGE(0, 0); if (2 < NCH) SK_LOAD(0, 2);
    __syncthreads();
#define SK_STEP(ch, nset) do { \
        const int buf = (ch) & 1; \
        f32x4 acc[2][4]; \
        _Pragma("unroll") for (int rb = 0; rb < 2; ++rb) _Pragma("unroll") for (int cg = 0; cg < 4; ++cg) acc[rb][cg] = (f32x4){0.f, 0.f, 0.f, 0.f}; \
        const LAS bf16_t* bb = Bs + buf * BSZ + r16 * KPD + 8 * fq; \
        if (SKP != 1 && SKP != 3) { constexpr int NG = 4 * (NS / 4); bf16x8 bfr[2][4];            \
          _Pragma("unroll") for (int s2 = 0; s2 < 4; ++s2) bfr[0][s2] = *(const LAS bf16x8*)(bb + 32 * s2); \
          _Pragma("unroll") for (int g = 0; g < NG; ++g) { const int cg = g / (NS / 4), sh = 4 * (g % (NS / 4)); \
            if (g + 1 < NG) { const int cg1 = (g + 1) / (NS / 4), sh1 = 4 * ((g + 1) % (NS / 4)); \
                _Pragma("unroll") for (int s2 = 0; s2 < 4; ++s2) bfr[(g + 1) & 1][s2] = *(const LAS bf16x8*)(bb + (16 * cg1) * KPD + 32 * (sh1 + s2)); } \
            __builtin_amdgcn_sched_barrier(0); \
            _Pragma("unroll") for (int s2 = 0; s2 < 4; ++s2) { acc[0][cg] = MFMA16(bfr[g & 1][s2], af[0][sh + s2], acc[0][cg]); acc[1][cg] = MFMA16(bfr[g & 1][s2], af[1][sh + s2], acc[1][cg]); } \
            __builtin_amdgcn_sched_barrier(0); } } \
        if (SKP != 2 && SKP != 3) { _Pragma("unroll") for (int rb = 0; rb < 2; ++rb) _Pragma("unroll") for (int cp = 0; cp < 2; ++cp) epi(rb, (ch), cp, acc[rb][2 * cp], acc[rb][2 * cp + 1]); } \
        else { float sx_ = 0.f; _Pragma("unroll") for (int rb = 0; rb < 2; ++rb) _Pragma("unroll") for (int cg = 0; cg < 4; ++cg) sx_ += acc[rb][cg][0] + acc[rb][cg][1] + acc[rb][cg][2] + acc[rb][cg][3]; if (sx_ == 12345.678f) epi(0, (ch), 0, acc[0][0], acc[0][1]); } \
        if ((ch) + 1 < NCH) { SK_STAGE(nset, buf ^ 1); if ((ch) + 3 < NCH) SK_LOAD(nset, (ch) + 3); } \
        __syncthreads(); \
    } while (0)
#pragma unroll 1
    for (int c2 = 0; c2 < NCH; c2 += 2) { SK_STEP(c2, 1); SK_STEP(c2 + 1, 0); }
#undef SK_LOAD
#undef SK_STAGE
#undef SK_STEP
}
template <int SKP = 0>
DI void moe_down_phase(Frame& F, int layer, const LAS int* tab) {
    int tid_ = F.tid; asm volatile("" : "+v"(tid_));
    const int tid = tid_, w = __builtin_amdgcn_readfirstlane(tid_ >> 6), r16 = tid_ & 15, fq = (tid_ & 63) >> 4;
    const bf16_t* HID = (const bf16_t*)(F.ws + WS_HID); const bf16_t* WDN = (const bf16_t*)(F.ws + WS_WDN); bf16_t* Y2 = (bf16_t*)(F.ws + WS_Y2);
    const float* row_w = (const float*)(F.ws + WS_ROWW);
    const int nunits = 2 * tab[0]; (void)layer;
#pragma unroll 1
    for (int u = bid_(); u < nunits; u += gdim_()) {
        const int tile = u >> 1, nh = u & 1, e = tab[1 + tile];
        float wg[2];
#pragma unroll
        for (int rb = 0; rb < 2; ++rb) { const int r = tile * 256 + 32 * w + 16 * rb + r16; wg[rb] = row_w[r]; }
        auto epi = [&](int rb, int ch, int cp, const f32x4& v0, const f32x4& v1) {
            *(u32x4*)(Y2 + (size_t)(tile * 256 + 32 * w + 16 * rb + r16) * 1024 + 512 * nh + 64 * ch + 32 * cp + 8 * fq) = pack8(v0 * wg[rb], v1 * wg[rb]); };
        skinny_unit<256, 8, SKP>(F, tid, HID + (size_t)tile * 256 * 256, 256, WDN + (size_t)e * 1024 * 256 + (size_t)(512 * nh) * 256, epi);
    }
}
DI int queue_next(Frame& F, unsigned* qw) {
    LAS int* slot = (LAS int*)(F.lds + MISC_OFF + 64);
    __syncthreads();
    if (F.tid == 0) *slot = (int)atomicAdd(qw, 1u);
    __syncthreads();
    return *slot;
}
DI void l1_upproj_phase(Frame& F) {
    int tid_ = F.tid; asm volatile("" : "+v"(tid_));
    const int tid = tid_, w = __builtin_amdgcn_readfirstlane(tid_ >> 6), r16 = tid_ & 15, fq = (tid_ & 63) >> 4;
    const bf16_t* CQ = (const bf16_t*)(F.ws + WS_CQ); const bf16_t* CKV = (const bf16_t*)(F.ws + WS_CKV);
    bf16_t* QM = (bf16_t*)(F.ws + WS_QM); bf16_t* KN = (bf16_t*)(F.ws + WS_KN); bf16_t* VM = (bf16_t*)(F.ws + WS_VM);
    const f32x2* rope = (const f32x2*)(F.ws + WS_ROPE1); const float qs = 0.10206207261596575f * LOG2E;
    const float* rowss = (const float*)(F.ctl + CW_ROWSS);
    constexpr int NQ = 128 * 3, NKV = NPAN * 2;
    const int c_ = bid_(); const bool bal_ = gdim_() == 256; const int u0_ = !bal_ ? c_ : (c_ < 160 ? c_ : 320 + (c_ - 160)), us_ = !bal_ ? gdim_() : (c_ < 160 ? 160 : 96), ue_ = !bal_ ? NQ + NKV : (c_ < 160 ? 320 : NQ + NKV);
#pragma unroll 1
    for (int u = u0_; u < ue_; u += us_) {
        if (u < NQ) {
            const int pl = u / 3, nt3 = u % 3, panel = (pl >> 3) * 9 + 1 + (pl & 7), row0 = panel * 256;
            float rq[2];
#pragma unroll
            for (int rb = 0; rb < 2; ++rb) rq[rb] = qs / sqrtf(rowss[row0 + 32 * w + 16 * rb + r16] * (1.f / 256.f) + EPS);
            auto epi = [&](int rb, int ch, int cp, const f32x4& v0, const f32x4& v1) {
                const int r = row0 + 32 * w + 16 * rb + r16; bf16_t* rp = QM + (size_t)r * 768;
                if (nt3 < 2) { const int v = nt3 * 256 + 64 * ch + 32 * cp + 8 * fq; *(u32x4*)(rp + (v >> 6) * 96 + (v & 63)) = pack8(v0 * rq[rb], v1 * rq[rb]); }
                else { (void)v0; (void)v1; } };
            if (nt3 < 2) skinny_unit<256, 4>(F, tid, CQ + (size_t)row0 * 256, 256, (const bf16_t*)(F.ws + WS_WUQ) + (size_t)(nt3 * 256) * 256, epi);
            else {
                f32x4 keep[2][2];
                auto epr = [&](int rb, int ch, int cp, const f32x4& v0, const f32x4& v1) {
                    if (cp == 0) { keep[rb][0] = v0; keep[rb][1] = v1; return; }
                    const int r = row0 + 32 * w + 16 * rb + r16, pos = r % LT; const int head = 2 * ch + (fq >> 1), g = fq & 1;
                    const f32x2* cpn = rope + (size_t)(pos - CTX) * 16 + g * 8; f32x4 o[2][2];
#pragma unroll
                    for (int j = 0; j < 8; ++j) { const f32x2 cs = cpn[j]; const float t1 = keep[rb][j >> 2][j & 3], t2 = (j < 4 ? v0 : v1)[j & 3];
                        o[0][j >> 2][j & 3] = (t1 * cs.x - t2 * cs.y) * rq[rb]; o[1][j >> 2][j & 3] = (t1 * cs.y + t2 * cs.x) * rq[rb]; }
                    bf16_t* rp = QM + (size_t)r * 768 + head * 96 + 64 + 16 * g;
                    *(u32x4*)rp = pack8(o[0][0], o[0][1]); *(u32x4*)(rp + 8) = pack8(o[1][0], o[1][1]); };
                skinny_unit<256, 4>(F, tid, CQ + (size_t)row0 * 256, 256, (const bf16_t*)(F.ws + WS_WUQ) + (size_t)512 * 256, epr);
            }
        } else {
            const int uu = u - NQ, panel = uu >> 1, nh = uu & 1, row0 = panel * 256; bf16_t* base = nh ? VM : KN;
            float rk[2];
#pragma unroll
            for (int rb = 0; rb < 2; ++rb) rk[rb] = 1.f / sqrtf(rowss[T + row0 + 32 * w + 16 * rb + r16] * (1.f / 128.f) + EPS);
            auto epi = [&](int rb, int ch, int cp, const f32x4& v0, const f32x4& v1) {
                *(u32x4*)(base + (size_t)(row0 + 32 * w + 16 * rb + r16) * 512 + 64 * ch + 32 * cp + 8 * fq) = pack8(v0 * rk[rb], v1 * rk[rb]); };
            skinny_unit<128, 8>(F, tid, CKV + (size_t)row0 * 128, 128, (const bf16_t*)(F.ws + WS_WUKV) + (size_t)(512 * nh) * 128, epi);
        }
    }
}

struct Args { const float* in[N_IN]; float* out; unsigned char* ws; int ph_lo, ph_hi, li, pad; };
static_assert(sizeof(Args) == N_IN * 8 + 16 + 16, "Args has no padding holes");
constexpr int NPH = 26;
#ifndef REP_P0
#define REP_P0 1
#endif
#ifndef REP_P1
#define REP_P1 1
#endif
#ifndef REP_P2
#define REP_P2 1
#endif
#ifndef REP_P12
#define REP_P12 1
#endif
#ifndef REP_P14
#define REP_P14 1
#endif
#ifndef REP_P17
#define REP_P17 1
#endif
#ifndef REP_OUT
#define REP_OUT 1
#endif
#ifndef REP_NORM
#define REP_NORM 1
#endif
#ifndef REP_ROUTER
#define REP_ROUTER 1
#endif
#ifndef REP_UP
#define REP_UP 1
#endif
#ifndef REP_DOWN
#define REP_DOWN 1
#endif
#ifndef PROBE_HY_MODE
#define PROBE_HY_MODE 0
#endif
#ifndef PROBE_EXTRA_HY
#define PROBE_EXTRA_HY 0
#endif
#ifndef PROBE_APM
#define PROBE_APM 3
#endif
#ifndef PROBE_NK
#define PROBE_NK LT
#endif
#ifndef PROBE_GEMM
#define PROBE_GEMM 0
#endif
#ifndef SKPV
#define SKPV 0
#endif
#ifndef DOWN_SKINNY_PROBE
#define DOWN_SKINNY_PROBE 0
#endif
#ifndef DOWN_SKINNY
#define DOWN_SKINNY 0
#endif
#ifndef PROBE_P1C
#define PROBE_P1C 1
#endif
#ifndef PROBE_P1W
#define PROBE_P1W 1
#endif
#ifndef QKV_WGM
#define QKV_WGM 8
#endif
#ifndef FILLER_FIRST
#define FILLER_FIRST 1
#endif
#ifndef S5X_HI
#define S5X_HI 3
#endif
#ifndef S5X_LO
#define S5X_LO 1
#endif
#ifndef DESYNC_OUT
#define DESYNC_OUT 0
#endif
#ifndef DESYNC_DOWN
#define DESYNC_DOWN 127
#endif
#ifndef DESYNC_GROUPS
#define DESYNC_GROUPS 2
#endif
#ifndef PROBE_XBAR
#define PROBE_XBAR 0
#endif
#ifndef REP_P3
#define REP_P3 1
#endif
#ifndef REP_P16
#define REP_P16 1
#endif

DI bool ph_in(int k, int lo, int hi) { asm volatile("" : "+s"(lo), "+s"(hi)); return lo <= k && k < hi; }
__global__ void __launch_bounds__(NTHR, 2) mega_fwd(Args args) {
    extern __shared__ __attribute__((aligned(16))) unsigned char lds_raw[];
    Frame F;
    F.lds = (LAS unsigned char*)lds_raw;
    F.tid = threadIdx.x; F.lane = F.tid & 63; F.wave = __builtin_amdgcn_readfirstlane(F.tid >> 6); const int wave0 = F.wave;
    F.gw = bid_() * NWAVES + F.wave; F.NGW = gdim_() * NWAVES;
    F.out = args.out; F.ws = args.ws; F.ctl = (unsigned*)(args.ws + WS_CTL);
    volatile LAS unsigned* MISC = (volatile LAS unsigned*)(F.lds + MISC_OFF);
    if (F.tid < 32) MISC[F.tid] = 0u;
    if (F.tid == 64) { LAS unsigned long long* pt = (LAS unsigned long long*)(F.lds + PTAB_OFF);
#pragma unroll
        for (int i = 0; i < N_IN; ++i) pt[i] = (unsigned long long)args.in[i]; }
    __syncthreads();
    XcdBarrier bar = xcd_barrier_post(F.ctl + CW_BAR + args.li * XCD_BAR_WORDS, MISC + 8);
    const int lo = args.ph_lo, hi = args.ph_hi;
    const unsigned ws_lo0 = __builtin_amdgcn_readfirstlane((unsigned)(unsigned long long)args.ws), ws_hi0 = __builtin_amdgcn_readfirstlane((unsigned)((unsigned long long)args.ws >> 32));
    const unsigned out_lo0 = __builtin_amdgcn_readfirstlane((unsigned)(unsigned long long)args.out), out_hi0 = __builtin_amdgcn_readfirstlane((unsigned)((unsigned long long)args.out >> 32));
#ifndef PHMASK
#define PHMASK 0xFFFFFFFFu
#endif
#define IN(k) (((PHMASK >> (k)) & 1u) && ph_in((k), lo, hi))
#define PB() do { F.lane = lane_id(); asm volatile("" : "+v"(F.lane)); { int w_ = wave0; asm volatile("" : "+s"(w_)); F.wave = w_; } F.tid = F.wave * 64 + F.lane; F.gw = bid_() * NWAVES + F.wave; { unsigned lo_ = ws_lo0, hi_ = ws_hi0, ol_ = out_lo0, oh_ = out_hi0; asm volatile("" : "+s"(lo_), "+s"(hi_), "+s"(ol_), "+s"(oh_)); F.ws = (unsigned char*)(GAS unsigned char*)(((unsigned long long)hi_ << 32) | lo_); F.out = (float*)(GAS float*)(((unsigned long long)oh_ << 32) | ol_); } F.ctl = (unsigned*)F.ws; ws = F.ws; } while (0)
#define SEAM(k) do { if (IN(k) && IN((k) + 1)) { XcdBarrier bb_ = bar; asm volatile("" : "+s"(bb_.x)); asm volatile("" : "+s"(bb_.bar)); xcd_barrier(bb_, wave0 * 64 + lane_id()); } } while (0)
    unsigned char* ws = F.ws;
#define H ((bf16_t*)(ws + WS_H))
#define MIX ((bf16_t*)F.out)
#define XS ((bf16_t*)(ws + WS_XS))
#define MODV ((const float*)(ws + WS_MODV))

    if (IN(0)) { PB(); mod_block(F); }
    SEAM(0);
    if (IN(1)) { PB();
        if (bid_() & 1) { for (int r_ = 0; r_ < PROBE_P1C; ++r_) { p0_compute_part(F); PB(); __syncthreads(); } for (int r_ = 0; r_ < PROBE_P1W; ++r_) { p0_weight_part(F); PB(); } modnorm_phase(F, 0, 0, false, F.in_(I_X), F.in_(I_CTX), H); }
        else { modnorm_phase(F, 0, 0, false, F.in_(I_X), F.in_(I_CTX), H); PB(); for (int r_ = 0; r_ < PROBE_P1W; ++r_) { p0_weight_part(F); PB(); } for (int r_ = 0; r_ < PROBE_P1C; ++r_) { __syncthreads(); p0_compute_part(F); PB(); } }
#if PROBE_P1ALL > 1
        __syncthreads(); PB();
        if (bid_() & 1) { p0_compute_part(F); PB(); __syncthreads(); p0_weight_part(F); PB(); modnorm_phase(F, 0, 0, false, F.in_(I_X), F.in_(I_CTX), H); }
        else { modnorm_phase(F, 0, 0, false, F.in_(I_X), F.in_(I_CTX), H); PB(); p0_weight_part(F); PB(); __syncthreads(); p0_compute_part(F); PB(); }
#endif
    }
    SEAM(1);
    for (int xb_ = 0; xb_ < PROBE_XBAR; ++xb_) { XcdBarrier bb_ = bar; asm volatile("" : "+s"(bb_.x)); asm volatile("" : "+s"(bb_.bar)); xcd_barrier(bb_, wave0 * 64 + lane_id()); }
#pragma unroll 1
    for (int layer = 0; layer < 2; ++layer) {
        if (layer == 0) {
            if (IN(2)) { PB(); for (int rep_ = 0; rep_ < REP_P2; ++rep_) {
                { ProbDense p; p.init((const bf16_t*)(ws + WS_WIN0), 1024, 6, H, 1024, NPAN, 1024, 0); EpiStore e{(bf16_t*)(ws + WS_HYT), (size_t)T}; pg8::gemm_phase(F.lds, F.tid, p, e); }
#if PROBE_GEMM == 1
                { ProbDense p; p.init((const bf16_t*)(ws + WS_WIN0), 1024, 6, H, 1024, NPAN, 1024, 0); EpiStore e{(bf16_t*)(ws + WS_HYT), (size_t)T}; pg8::gemm_phase(F.lds, F.tid, p, e); }
#elif PROBE_GEMM == 3
                { ProbDense p; p.init((const bf16_t*)(ws + WS_WIN0), 1024, 6, H, 1024, NPAN, 1024, 0); EpiStoreNT e{(bf16_t*)(ws + WS_HYT), (size_t)T}; pg8::gemm_phase(F.lds, F.tid, p, e); }
#elif PROBE_GEMM == 2
                { ProbDense p; p.init((const bf16_t*)(ws + WS_WIN0), 1024, 6, H, 1024, NPAN, 1024, 0); EpiNull e{(float*)(ws + WS_HYT)}; pg8::gemm_phase(F.lds, F.tid, p, e); }
#endif
#if PROBE_GEMM == 5
                if (rep_ > 0) { ProbDense p; p.init(H, 1024, NPAN, (const bf16_t*)(ws + WS_WIN0) + 1536 * 1024, 1024, 3, 1024, 0); EpiNull e{(float*)(ws + WS_HYT)}; pg8::gemm_phase(F.lds, F.tid, p, e); } else
#endif
                { ProbDense p; p.init(H, 1024, NPAN, (const bf16_t*)(ws + WS_WIN0) + 1536 * 1024, 1024, 3, 1024, 0, QKV_WGM);
                  EpiQKV e{(bf16_t*)(ws + WS_Q0), (bf16_t*)(ws + WS_K0), (bf16_t*)(ws + WS_V0), F.in_(I_QKG), (const f32x2*)(ws + WS_ROPE0), 0.125f * LOG2E}; pg8::gemm_phase(F.lds, F.tid, p, e); }
#if PROBE_GEMM == 4
                { ProbDense p; p.init(H, 1024, NPAN, (const bf16_t*)(ws + WS_WIN0) + 1536 * 1024, 1024, 3, 1024, 0);
                  EpiQKV e{(bf16_t*)(ws + WS_Q0), (bf16_t*)(ws + WS_K0), (bf16_t*)(ws + WS_V0), F.in_(I_QKG), (const f32x2*)(ws + WS_ROPE0), 0.125f * LOG2E}; pg8::gemm_phase(F.lds, F.tid, p, e); }
#endif
            }
                { const int c_ = bid_(); if (c_ >= 96) { PB(); const int rk = c_ - 96; dense_weight_items_l1(F, (LAS float*)(F.lds + F.wave * 16384), rk * NWAVES + F.wave, 160 * NWAVES); rope_table1(F, rk * NTHR + F.tid, 160 * NTHR);
                    const int s0_ = c_ < 176 ? S5X_LO * (c_ - 96) : 80 * S5X_LO + S5X_HI * (c_ - 176), ns_ = c_ < 176 ? S5X_LO : S5X_HI;
#pragma unroll 1
                    for (int s_ = s0_; s_ < s0_ + ns_; ++s_) s5_expand(F, s_ * NTHR + F.tid, (80 * S5X_LO + 80 * S5X_HI) * NTHR); } }
            }
            SEAM(2);
            if (IN(3)) { PB();
                const bf16_t* Q0 = (const bf16_t*)(ws + WS_Q0); const bf16_t* K0 = (const bf16_t*)(ws + WS_K0); const bf16_t* V0 = (const bf16_t*)(ws + WS_V0);
                for (int rep_ = 0; rep_ < REP_P3; ++rep_)
                for (;;) { int item = queue_next(F, F.ctl + CW_QUEUE + 128 * rep_); if (item >= 1728 + PROBE_EXTRA_HY) break; if (item >= 1728) { hyena_unit<false, PROBE_HY_MODE>(F, item - 1728); continue; }
                    if (item >= 1024 && item < 1536) hyena_unit<false>(F, item - 1024);
                    else if (item < 1664) { int b, head, qrow0, nk;
                        if (item < 1024) { const int idx = item; b = idx >> 6; head = (idx >> 3) & 7; qrow0 = b * LT + CTX + 256 * (idx & 7); nk = LT; }
                        else { const int idx = item - 1536; b = idx >> 3; head = idx & 7; qrow0 = b * LT; nk = CTX; }
                        attn_unit<64, false>(F, Q0, 512, head * 64, K0, 128, (head >> 2) * 64, nullptr, V0, 128, (head >> 2) * 64, MIX, 512 + head * 64, qrow0, b * LT, nk); }
                    else hyena_unit<true>(F, (item - 1664) * 8); }
            }
            SEAM(3);
        } else {
            if (IN(12)) { PB();
#if FILLER_FIRST
                const bool ff_ = bid_() >= 64 && ((bid_() >> 3) & 1);
                if (ff_) { moe_weight_items(F, 1, (LAS float*)(F.lds + F.wave * 16384), (bid_() - 64) * NWAVES + F.wave, 192 * NWAVES); __syncthreads(); PB(); }
#else
                const bool ff_ = false;
#endif
                for (int rep_ = 0; rep_ < REP_P12; ++rep_) { ProbDense p; p.init(H, 1024, NPAN, (const bf16_t*)(ws + WS_WIN1), 1024, 4, 1024, 0);
                EpiInproj1 e{(bf16_t*)(ws + WS_CQ), (bf16_t*)(ws + WS_CKV), (bf16_t*)(ws + WS_KR), (bf16_t*)(ws + WS_BMAT), (float*)(F.ctl + CW_ROWSS), (const f32x2*)(ws + WS_ROPE1)}; pg8::gemm_phase(F.lds, F.tid, p, e); }
                { const int c_ = bid_(); if (c_ >= 64 && !ff_) { PB(); moe_weight_items(F, 1, (LAS float*)(F.lds + F.wave * 16384), (c_ - 64) * NWAVES + F.wave, 192 * NWAVES); } } }
            SEAM(12);
            if (IN(14)) { PB(); for (int rep_ = 0; rep_ < REP_P14; ++rep_) {
                l1_upproj_phase(F); PB();
                { ProbS5 p{512, (const bf16_t*)(ws + WS_BMAT), (const bf16_t*)(ws + WS_S5W), (size_t)1280 * 768, (size_t)256 * 512, 768, 512, 5, 1, 0, gdim_(), bid_()};
                  EpiS5G1 e{(float*)(ws + WS_S5S)}; pg8::gemm_phase(F.lds, F.tid, p, e); }
            } }
            SEAM(14);
            if (IN(15)) { PB(); s5_scan_phase(F); }
            SEAM(15);
            if (IN(16)) { PB();
                { ProbS5 p{768, (const bf16_t*)(ws + WS_BMAT), (const bf16_t*)(ws + WS_S5A), (size_t)1280 * 768, (size_t)512 * 768, 768, 768, 4, 2, 128, gdim_(), bid_()};
                  EpiS5G2 e{(bf16_t*)(ws + WS_Y)}; pg8::gemm_phase(F.lds, F.tid, p, e); }
                const bf16_t* QM = (const bf16_t*)(ws + WS_QM); const bf16_t* KN = (const bf16_t*)(ws + WS_KN); const bf16_t* KR = (const bf16_t*)(ws + WS_KR); const bf16_t* VM = (const bf16_t*)(ws + WS_VM);
                for (int rep_ = 0; rep_ < REP_P16; ++rep_)
                for (int ri_ = 0; ri_ < 4; ++ri_) { const int c_ = bid_(), grp_ = (c_ & 7) * 16 + ri_ * 4 + (c_ >> 6); const int b = grp_ >> 3, head = grp_ & 7, qb = (c_ >> 3) & 7;
                    if (rep_ == 0) attn_unit<96, true>(F, QM, 768, head * 96, KN, 512, head * 64, KR, VM, 512, head * 64, MIX, head * 64, b * LT + CTX + 256 * qb, b * LT, LT);
                    else attn_unit<96, true, PROBE_APM>(F, QM, 768, head * 96, KN, 512, head * 64, KR, VM, 512, head * 64, MIX, head * 64, b * LT + CTX + 256 * qb, b * LT, PROBE_NK); }
            }
            SEAM(16);
            if (IN(17)) { PB(); for (int rep_ = 0; rep_ < REP_P17; ++rep_) { ProbDense p; p.init((const bf16_t*)(ws + WS_Y), 512, 128, (const bf16_t*)(ws + WS_WGLU), 512, 2, 512, 1);
                EpiGLU e{(const bf16_t*)(ws + WS_Y), F.in_(I_GLUB), MIX, F.ctl + CW_TFLAG + 1024}; pg8::gemm_phase(F.lds, F.tid, p, e); } }
        }
        const int tb = layer == 0 ? 4 : 18;
        const bool lat_only = layer == 1;
        if (IN(tb)) { PB();
            if (layer == 0) { hot_transpose_phase(F); XcdBarrier bb_ = bar; asm volatile("" : "+s"(bb_.x)); asm volatile("" : "+s"(bb_.bar)); xcd_barrier(bb_, wave0 * 64 + lane_id()); PB(); }
            if (layer == 1 && ((bid_() >> 3) & 1)) { for (int s_ = 0; s_ < DESYNC_OUT; ++s_) __builtin_amdgcn_s_sleep(127); }
#if MOE0_IN_P4 && FILLER_FIRST
            const bool ff_ = layer == 0 && bid_() >= 64 && ((bid_() >> 3) & 1);
            if (ff_) { PB(); moe_weight_items(F, 0, (LAS float*)(F.lds + F.wave * 16384), (bid_() - 64) * NWAVES + F.wave, 192 * NWAVES); __syncthreads(); PB(); }
#else
            const bool ff_ = false;
#endif
            for (int rep_ = 0; rep_ < (layer == 0 ? REP_OUT : 1); ++rep_) { ProbDense p; p.init(MIX, 1024, lat_only ? 128 : NPAN, (const bf16_t*)(ws + (layer ? WS_WOUT1 : WS_WOUT0)), 1024, 4, 1024, layer); if (layer == 1) { p.wflag = F.ctl + CW_TFLAG + 1024; p.wneed = 2u; }
            EpiRes e{F.in_(I_X), F.in_(I_CTX), XS, MODV + (size_t)layer * 17 * 6144 + 2048, layer}; pg8::gemm_phase(F.lds, F.tid, p, e); }
#if MOE0_IN_P4
            if (layer == 0 && !ff_) { const int c_ = bid_(); if (c_ >= 64) { PB(); moe_weight_items(F, 0, (LAS float*)(F.lds + F.wave * 16384), (c_ - 64) * NWAVES + F.wave, 192 * NWAVES); } }
#endif
        }
        SEAM(tb);
        if (IN(tb + 1)) { PB(); norm2_route_phase(F, layer, lat_only, XS, (bf16_t*)(ws + WS_H)); if (REP_NORM > 1) { __syncthreads(); PB(); norm2_route_phase(F, layer, lat_only, XS, (bf16_t*)(ws + WS_H), true); } }
        SEAM(tb + 1);
        if (IN(tb + 5)) { PB(); for (int rep_ = 0; rep_ < REP_UP; ++rep_) { const LAS int* tab = moe_tile_table(F, layer);
            ProbMoeUp p{1024, H, (const bf16_t*)(ws + WS_WGU), (const int*)(ws + WS_RANKTOK), tab}; EpiGateUp e{(bf16_t*)(ws + WS_HID), F.ctl + CW_TFLAG + layer * 512}; pg8::gemm_phase(F.lds, F.tid, p, e); } }
        if (IN(tb + 6)) { PB(); for (int rep_ = 0; rep_ < REP_DOWN; ++rep_) { const LAS int* tab = (const LAS int*)(F.lds + LDS_TAB_OFF);
#if DOWN_SKINNY
            moe_down_phase(F, layer, tab);
#elif DOWN_SKINNY_PROBE
            if (rep_ == 0) { ProbMoeDown p{256, (const bf16_t*)(ws + WS_HID), (const bf16_t*)(ws + WS_WDN), tab}; EpiDownSorted e{(bf16_t*)(ws + WS_Y2), (const float*)(ws + WS_RANKW), tab}; pg8::gemm_phase(F.lds, F.tid, p, e); }
            else moe_down_phase<SKPV>(F, layer, tab);
#else
            { ProbMoeDown p{256, (const bf16_t*)(ws + WS_HID), (const bf16_t*)(ws + WS_WDN), tab, F.ctl + CW_TFLAG + layer * 512}; p.init(); EpiDownSorted e{(bf16_t*)(ws + WS_Y2), (const float*)(ws + WS_RANKW), tab}; pg8::gemm_phase(F.lds, F.tid, p, e); }
#endif
            } }
        SEAM(tb + 6);
        if (IN(tb + 7)) { PB();
            if (layer == 0) { combine_phase<false>(F, 0, XS, F.out, (const bf16_t*)(ws + WS_Y2), H); }
            else combine_phase<true>(F, 1, XS, F.out, (const bf16_t*)(ws + WS_Y2), H);
        }
        if (layer == 0) SEAM(11);
    }
#undef IN
#undef SEAM
#undef PB
#undef H
#undef MIX
#undef XS
#undef MODV
}

#ifndef MK_CUTS
#define MK_CUTS {0, NPH}
#endif
extern "C" void kernel_launch(void* const* d_in, const int* in_sizes, int n_in, void* d_out, int out_size, void* d_ws, size_t ws_size, hipStream_t stream) {
    static int grid = 0;
    if (grid == 0) {
        if (n_in != N_IN || out_size != NB * SEQ * DM || ws_size < WS_END) { fprintf(stderr, "kernel_launch: unexpected shapes (n_in %d, out %d, ws %zu); nothing launched\n", n_in, out_size, ws_size); grid = -1; return; }
        int dev = 0, cus = 0, per_cu = 0;
        if (hipGetDevice(&dev) != hipSuccess || hipDeviceGetAttribute(&cus, hipDeviceAttributeMultiprocessorCount, dev) != hipSuccess) { grid = -1; return; }
        if (hipFuncSetAttribute((const void*)mega_fwd, hipFuncAttributeMaxDynamicSharedMemorySize, LDS_BYTES) != hipSuccess) { fprintf(stderr, "kernel_launch: hipFuncSetAttribute failed\n"); grid = -1; return; }
        if (hipOccupancyMaxActiveBlocksPerMultiprocessor(&per_cu, (const void*)mega_fwd, NTHR, LDS_BYTES) != hipSuccess || per_cu < 1) fprintf(stderr, "kernel_launch: occupancy query says %d\n", per_cu);
        (void)hipGetLastError();
        grid = cus;
    }
    if (grid < 0) return;
    (void)in_sizes;
    if (hipMemsetAsync((char*)d_ws + WS_CTL, 0, CTL_ZERO_BYTES, stream) != hipSuccess) return;
    Args a{};
    for (int i = 0; i < N_IN; ++i) a.in[i] = (const float*)d_in[i];
    a.out = (float*)d_out; a.ws = (unsigned char*)d_ws; a.pad = 0;
    const int cuts[] = MK_CUTS; const int nl = (int)(sizeof(cuts) / sizeof(int)) - 1;
    for (int li = 0; li < nl; ++li) {
        a.ph_lo = cuts[li]; a.ph_hi = cuts[li + 1]; a.li = li;
        hipLaunchKernelGGL(mega_fwd, dim3(grid), dim3(NTHR), LDS_BYTES, stream, a);
        if (hipPeekAtLastError() != hipSuccess) { fprintf(stderr, "kernel_launch: launch %d failed\n", li); break; }
    }
}
```
